# Optimizing an MI355X kernel written in HIP

```python
import jax, jax.numpy as jnp
from jax import lax
import numpy as np

D_MODEL = 2048
BATCH = 2
SEQ = 8192
DEPTH = 1

HEAD_DIM = 64
ATTN_WIDTH = D_MODEL // 2
ATTN_HEADS = ATTN_WIDTH // HEAD_DIM
ATTN_KV_HEADS = ATTN_HEADS // 4
KV_WIDTH = ATTN_KV_HEADS * HEAD_DIM
WINDOW = 128
BLOCK = 128

POOL_WINDOWS = (2, 4, 8, 16)
POOL_GROUPS = len(POOL_WINDOWS)
POOL_WIDTH = D_MODEL // 2
POOL_GROUP_DIM = POOL_WIDTH // POOL_GROUPS

N_BRANCHES = 2
Q_END = ATTN_WIDTH
K_END = Q_END + KV_WIDTH
V_END = K_END + KV_WIDTH
U_END = V_END + POOL_WIDTH
IN_WIDTH = U_END + N_BRANCHES * D_MODEL

N_GROUPS = 4
EXPERTS_PER_GROUP = 4
N_EXPERTS = N_GROUPS * EXPERTS_PER_GROUP
TOP_K = 2
EXPERT_FF = D_MODEL // 4

N_ADA = 6
NORM_EPS = 1e-6
MASK_VALUE = -1e30

kernel_name = "hybrid_swa_sink_pool_hmoe_adaln"


def rms_norm(x, g):
    xf = x.astype(jnp.float32)
    xf = xf * lax.rsqrt(jnp.mean(xf * xf, axis=-1, keepdims=True) + NORM_EPS)
    return (xf * g.astype(jnp.float32)).astype(x.dtype)


def sliding_window_sink_attention(q, k, v, sinks):
    b, s = q.shape[0], q.shape[1]
    nb = s // BLOCK
    grp = ATTN_HEADS // ATTN_KV_HEADS
    qb = q.reshape(b, nb, BLOCK, ATTN_KV_HEADS, grp, HEAD_DIM)
    pad = jnp.zeros((b, BLOCK, ATTN_KV_HEADS, HEAD_DIM), k.dtype)
    kp = jnp.concatenate([pad, k], axis=1).reshape(b, nb + 1, BLOCK, ATTN_KV_HEADS, HEAD_DIM)
    vp = jnp.concatenate([pad, v], axis=1).reshape(b, nb + 1, BLOCK, ATTN_KV_HEADS, HEAD_DIM)
    k_band = jnp.concatenate([kp[:, :-1], kp[:, 1:]], axis=2)
    v_band = jnp.concatenate([vp[:, :-1], vp[:, 1:]], axis=2)
    logits = jnp.einsum('bnqkgd,bnjkd->bnkgqj', qb, k_band,
                        preferred_element_type=jnp.float32) * (HEAD_DIM ** -0.5)
    r = jnp.arange(BLOCK)[:, None]
    j = jnp.arange(2 * BLOCK)[None, :]
    rel = r + BLOCK - j
    band = (rel >= 0) & (rel < WINDOW)
    blk = jnp.arange(nb)[:, None, None]
    valid = band[None] & ((blk > 0) | (j[None] >= BLOCK))
    logits = jnp.where(valid[None, :, None, None], logits, MASK_VALUE)
    sink = jnp.broadcast_to(
        sinks.astype(jnp.float32).reshape(ATTN_KV_HEADS, grp)[None, None, :, :, None, None],
        logits.shape[:-1] + (1,))
    probs = jax.nn.softmax(jnp.concatenate([logits, sink], axis=-1), axis=-1)[..., :-1]
    out = jnp.einsum('bnkgqj,bnjkd->bnqkgd', probs.astype(v.dtype), v_band)
    return out.reshape(b, s, ATTN_WIDTH)


def multiscale_pool(u, w_pool, pool_scale):
    b, s = u.shape[0], u.shape[1]
    ug = u.reshape(b, s, POOL_GROUPS, POOL_GROUP_DIM)
    pos = jnp.arange(s)
    outs = []
    for gi, w in enumerate(POOL_WINDOWS):
        xg = ug[:, :, gi].astype(jnp.float32)
        cs = jnp.cumsum(xg, axis=1)
        cs_prev = jnp.pad(cs, ((0, 0), (w, 0), (0, 0)))[:, :s]
        count = jnp.minimum(pos + 1, w).astype(jnp.float32)[None, :, None]
        outs.append((cs - cs_prev) / count - xg)
    pooled = jnp.stack(outs, axis=2).astype(u.dtype)
    mixed = jnp.einsum('bsgc,gcd->bsgd', pooled, w_pool).reshape(b, s, POOL_WIDTH)
    return mixed * pool_scale


def hierarchical_moe(h, w_router_group, b_router_group, w_router_expert, b_router_expert,
                     w_e_gate, w_e_up, w_e_down):
    t = h.shape[0]
    g_logits = jnp.matmul(h, w_router_group).astype(jnp.float32) + b_router_group.astype(jnp.float32)
    g_prob = jax.nn.softmax(g_logits, axis=-1)
    g_top_p, g_idx = lax.top_k(g_prob, 1)
    e_logits = (jnp.matmul(h, w_router_expert).astype(jnp.float32)
                + b_router_expert.astype(jnp.float32)).reshape(t, N_GROUPS, EXPERTS_PER_GROUP)
    e_sel = jnp.take_along_axis(e_logits, g_idx[:, :, None], axis=1)[:, 0]
    e_prob = jax.nn.softmax(e_sel, axis=-1)
    e_top_p, e_idx = lax.top_k(e_prob, TOP_K)
    e_top_p = e_top_p / jnp.sum(e_top_p, axis=-1, keepdims=True)
    weights = g_top_p * e_top_p
    global_idx = g_idx * EXPERTS_PER_GROUP + e_idx
    combine = jnp.sum(jax.nn.one_hot(global_idx, N_EXPERTS, dtype=jnp.float32)
                      * weights[..., None], axis=1)
    gate = jnp.einsum('td,edf->tef', h, w_e_gate)
    up = jnp.einsum('td,edf->tef', h, w_e_up)
    act = jax.nn.silu(gate) * up * combine[:, :, None].astype(h.dtype)
    return jnp.einsum('tef,efd->td', act, w_e_down)


def setup_inputs(seed: int = 0) -> dict:
    key = jax.random.key(seed)
    ks = jax.random.split(key, 22)
    n = jax.random.normal
    f32 = jnp.float32
    L, D = DEPTH, D_MODEL
    return {
        "x": n(ks[0], (BATCH, SEQ, D), f32),
        "c": n(ks[1], (BATCH, D), f32),
        "w_ada": n(ks[2], (L, D, N_ADA * D), f32) * (0.5 * D ** -0.5),
        "b_ada": n(ks[3], (L, N_ADA * D), f32) * 0.02,
        "norm1_g": 1.0 + 0.02 * n(ks[4], (L, D), f32),
        "w_in": n(ks[5], (L, D, IN_WIDTH), f32) * D ** -0.5,
        "sinks": n(ks[6], (L, ATTN_HEADS), f32),
        "w_pool": n(ks[7], (L, POOL_GROUPS, POOL_GROUP_DIM, POOL_GROUP_DIM), f32) * POOL_GROUP_DIM ** -0.5,
        "pool_scale": 1.0 + 0.1 * n(ks[8], (L, POOL_WIDTH), f32),
        "w_attn_branch": n(ks[9], (L, ATTN_WIDTH, D), f32) * ATTN_WIDTH ** -0.5,
        "w_pool_branch": n(ks[10], (L, POOL_WIDTH, D), f32) * POOL_WIDTH ** -0.5,
        "w_out": n(ks[11], (L, D, D), f32) * D ** -0.5,
        "norm2_g": 1.0 + 0.02 * n(ks[12], (L, D), f32),
        "w_router_group": n(ks[13], (L, D, N_GROUPS), f32) * D ** -0.5,
        "b_router_group": n(ks[14], (L, N_GROUPS), f32) * 0.01,
        "w_router_expert": n(ks[15], (L, D, N_EXPERTS), f32) * D ** -0.5,
        "b_router_expert": n(ks[16], (L, N_EXPERTS), f32) * 0.01,
        "w_e_gate": n(ks[17], (L, N_EXPERTS, D, EXPERT_FF), f32) * D ** -0.5,
        "w_e_up": n(ks[18], (L, N_EXPERTS, D, EXPERT_FF), f32) * D ** -0.5,
        "w_e_down": n(ks[19], (L, N_EXPERTS, EXPERT_FF, D), f32) * EXPERT_FF ** -0.5,
        "final_g": 1.0 + 0.02 * n(ks[20], (D,), f32),
    }


def reference(x, c, w_ada, b_ada, norm1_g, w_in, sinks, w_pool, pool_scale, w_attn_branch,
              w_pool_branch, w_out, norm2_g, w_router_group, b_router_group, w_router_expert,
              b_router_expert, w_e_gate, w_e_up, w_e_down, final_g):
    b, s, d = x.shape
    for l in range(DEPTH):
        ada = (jnp.matmul(c, w_ada[l]) + b_ada[l])[:, None, :]
        shift1, scale1, gate1, shift2, scale2, gate2 = jnp.split(ada, N_ADA, axis=-1)

        h = rms_norm(x, norm1_g[l]) * (1.0 + scale1) + shift1
        proj = jnp.matmul(h, w_in[l])
        q, k, v, u, gate_logits = jnp.split(proj, [Q_END, K_END, V_END, U_END], axis=-1)
        attn = sliding_window_sink_attention(
            q.reshape(b, s, ATTN_HEADS, HEAD_DIM),
            k.reshape(b, s, ATTN_KV_HEADS, HEAD_DIM),
            v.reshape(b, s, ATTN_KV_HEADS, HEAD_DIM),
            sinks[l])
        pool = multiscale_pool(u, w_pool[l], pool_scale[l])
        gate_a, gate_p = jnp.split(jax.nn.sigmoid(gate_logits), N_BRANCHES, axis=-1)
        merged = (gate_a * jnp.matmul(attn, w_attn_branch[l])
                  + gate_p * jnp.matmul(pool, w_pool_branch[l]))
        x = x + gate1 * jnp.matmul(merged, w_out[l])

        h2 = rms_norm(x, norm2_g[l]) * (1.0 + scale2) + shift2
        y = hierarchical_moe(h2.reshape(b * s, d), w_router_group[l], b_router_group[l],
                             w_router_expert[l], b_router_expert[l],
                             w_e_gate[l], w_e_up[l], w_e_down[l]).reshape(b, s, d)
        x = x + gate2 * y
    return rms_norm(x, final_g)
```

```cpp
#include <hip/hip_runtime.h>
#include <stdint.h>
#include <cstdio>

constexpr int D = 2048, BATCH = 2, SEQ = 8192, T = BATCH * SEQ;
constexpr int NPROJ = 6656;
constexpr int C_Q = 0, C_K = 1024, C_V = 1280, C_U = 1536, C_GA = 2560, C_GP = 4608;
constexpr int NADA = 6 * D;
constexpr int NEXP = 16, FF = 512;
constexpr int MAXSLOT = 2 * T + NEXP * 256;
constexpr float EPS = 1e-6f;
constexpr float LOG2E = 1.4426950408889634f;
constexpr float C2 = 0.125f * LOG2E;

typedef unsigned short bf16;

constexpr size_t MiB = 1u << 20;
constexpr size_t WS_CTL = 0;
constexpr size_t WS_ADA = 1 * MiB;
constexpr size_t WS_ADAP = WS_ADA + 128 * 1024;
constexpr size_t WS_SSQ = 2 * MiB;
constexpr size_t WS_W = 4 * MiB;
constexpr size_t WS_PROJ = 144 * MiB;
constexpr size_t WS_ACT = 144 * MiB;
constexpr size_t WS_Y = 180 * MiB;
constexpr size_t WS_B = 352 * MiB;
constexpr size_t WS_C = 416 * MiB;
constexpr size_t WS_RT = 480 * MiB;
constexpr size_t WS_END = 482 * MiB;
constexpr size_t RT_TOKE = 0;
constexpr size_t RT_TOKW = RT_TOKE + (size_t)T * 2 * 4;
constexpr size_t RT_LRANK = RT_TOKW + (size_t)T * 2 * 4;
constexpr size_t RT_TOKSLOT = RT_LRANK + (size_t)T * 2 * 4;
constexpr size_t RT_BLKCNT = RT_TOKSLOT + (size_t)T * 2 * 4;
constexpr size_t RT_BLKBASE = RT_BLKCNT + 256 * 16 * 4;
constexpr size_t RT_SLOTTOK = RT_BLKBASE + 256 * 16 * 4;
constexpr size_t RT_SLOTW = RT_SLOTTOK + (size_t)MAXSLOT * 4;
constexpr size_t RT_META = RT_SLOTW + (size_t)MAXSLOT * 4;
static_assert(RT_META + 1024 * 4 <= 2 * MiB, "routing arrays");

__device__ __forceinline__ unsigned f2bf(float f) { unsigned u = __builtin_bit_cast(unsigned, f); return (u + 0x7fffu + ((u >> 16) & 1u)) >> 16; }
__device__ __forceinline__ float bf2f(unsigned h) { return __builtin_bit_cast(float, h << 16); }
__device__ __forceinline__ float wave_sum(float v) {
#pragma unroll
    for (int o = 1; o < 64; o <<= 1) v += __shfl_xor(v, o);
    return v;
}
__device__ __forceinline__ float sigmoidf_(float v) { return 1.0f / (1.0f + __expf(-v)); }

namespace nv {

__global__ __launch_bounds__(256) void ada_part(const float* __restrict__ c, const float* __restrict__ W, float* __restrict__ adap) {
    const int j = blockIdx.x * 256 + threadIdx.x, ks = blockIdx.y;
    float a0 = 0.f, a1 = 0.f;
    for (int k = ks * 256; k < ks * 256 + 256; ++k) { const float w = W[(size_t)k * NADA + j]; a0 += c[k] * w; a1 += c[D + k] * w; }
    adap[((size_t)ks * 2 + 0) * NADA + j] = a0; adap[((size_t)ks * 2 + 1) * NADA + j] = a1;
}
__global__ __launch_bounds__(256) void ada_sum(const float* __restrict__ adap, const float* __restrict__ bias, float* __restrict__ ada) {
    const int i = blockIdx.x * 256 + threadIdx.x;
    const int b = i / NADA, j = i % NADA; float s = bias[j];
    for (int ks = 0; ks < 8; ++ks) s += adap[((size_t)ks * 2 + b) * NADA + j];
    ada[i] = s;
}
__global__ __launch_bounds__(256) void h1(const float* __restrict__ x, const float* __restrict__ g1, const float* __restrict__ ada, bf16* __restrict__ H1) {
    const int lane = threadIdx.x & 63, row = blockIdx.x * 4 + (threadIdx.x >> 6), b = row / SEQ;
    const float4* xr = (const float4*)(x + (size_t)row * D) + lane;
    float4 v[8]; float ss = 0.f;
#pragma unroll
    for (int j = 0; j < 8; ++j) { v[j] = xr[64 * j]; ss += v[j].x * v[j].x + v[j].y * v[j].y + v[j].z * v[j].z + v[j].w * v[j].w; }
    const float rstd = rsqrtf(wave_sum(ss) * (1.0f / D) + EPS);
    const float* sh = ada + (size_t)b * NADA + 0 * D; const float* sc = ada + (size_t)b * NADA + 1 * D;
#pragma unroll
    for (int j = 0; j < 8; ++j) { const int d = 4 * lane + 256 * j;
        const float4 g = *(const float4*)(g1 + d), s = *(const float4*)(sc + d), h = *(const float4*)(sh + d);
        const float o0 = v[j].x * rstd * g.x * (1.f + s.x) + h.x, o1 = v[j].y * rstd * g.y * (1.f + s.y) + h.y;
        const float o2 = v[j].z * rstd * g.z * (1.f + s.z) + h.z, o3 = v[j].w * rstd * g.w * (1.f + s.w) + h.w;
        uint2 w; w.x = f2bf(o0) | (f2bf(o1) << 16); w.y = f2bf(o2) | (f2bf(o3) << 16);
        *(uint2*)(H1 + (size_t)row * D + d) = w; }
}

struct ABf16 { const bf16* A; long long lda; long long koff;
    __device__ bool init(int bm) { return true; }
    __device__ const bf16* rowptr(int m) const { return A + (size_t)m * lda + koff; } };
struct AGather { const bf16* A; long long lda; const int* slot_tok; const int* meta;
    __device__ bool init(int bm) { return bm < meta[17]; }
    __device__ const bf16* rowptr(int m) const { return A + (size_t)slot_tok[m] * lda; } };
struct ASlot { const bf16* A; long long lda; const int* meta;
    __device__ bool init(int bm) { return bm < meta[17]; }
    __device__ const bf16* rowptr(int m) const { return A + (size_t)m * lda; } };
struct WPlain { const float* W; long long ldw;
    __device__ const float* base(int bm) const { return W; } };
struct WExpert { const float* W; long long ldw; size_t estride; const int* meta;
    __device__ const float* base(int bm) const { return W + (size_t)meta[32 + (bm >> 8)] * estride; } };

template <bool DUAL, class AL, class WL, class EP>
__global__ __launch_bounds__(256) void gemm(AL al, WL wl, WL wl2, EP ep, long long K_) {
    const int K = (int)K_;
    __shared__ float As[16][68]; __shared__ float Ws[16][64]; __shared__ float Ws2[DUAL ? 16 : 1][64];
    const int tid = threadIdx.x, tx = tid & 15, ty = tid >> 4, bm = blockIdx.y * 64, bn = blockIdx.x * 64;
    if (!al.init(bm)) return;
    const float* Wb = wl.base(bm); const float* Wb2 = DUAL ? wl2.base(bm) : nullptr;
    const bf16* arow = al.rowptr(bm + (tid >> 2)); const int ak = (tid & 3) * 4;
    float acc[4][4], acc2[4][4];
#pragma unroll
    for (int i = 0; i < 4; ++i)
#pragma unroll
        for (int j = 0; j < 4; ++j) { acc[i][j] = 0.f; acc2[i][j] = 0.f; }
    for (int k0 = 0; k0 < K; k0 += 16) {
        const uint2 a = *(const uint2*)(arow + k0 + ak);
        As[ak + 0][tid >> 2] = bf2f(a.x & 0xffffu); As[ak + 1][tid >> 2] = bf2f(a.x >> 16); As[ak + 2][tid >> 2] = bf2f(a.y & 0xffffu); As[ak + 3][tid >> 2] = bf2f(a.y >> 16);
        *(float4*)&Ws[ty][tx * 4] = *(const float4*)(Wb + (size_t)(k0 + ty) * wl.ldw + bn + tx * 4);
        if (DUAL) *(float4*)&Ws2[ty][tx * 4] = *(const float4*)(Wb2 + (size_t)(k0 + ty) * wl.ldw + bn + tx * 4);
        __syncthreads();
#pragma unroll
        for (int kk = 0; kk < 16; ++kk) {
            const float4 av = *(const float4*)&As[kk][ty * 4]; const float4 wv = *(const float4*)&Ws[kk][tx * 4];
            const float a4[4] = {av.x, av.y, av.z, av.w}, w4[4] = {wv.x, wv.y, wv.z, wv.w};
#pragma unroll
            for (int i = 0; i < 4; ++i)
#pragma unroll
                for (int j = 0; j < 4; ++j) acc[i][j] += a4[i] * w4[j];
            if (DUAL) { const float4 wv2 = *(const float4*)&Ws2[kk][tx * 4]; const float u4[4] = {wv2.x, wv2.y, wv2.z, wv2.w};
#pragma unroll
                for (int i = 0; i < 4; ++i)
#pragma unroll
                    for (int j = 0; j < 4; ++j) acc2[i][j] += a4[i] * u4[j]; }
        }
        __syncthreads();
    }
#pragma unroll
    for (int i = 0; i < 4; ++i)
#pragma unroll
        for (int j = 0; j < 4; ++j) ep(bm + ty * 4 + i, bn + tx * 4 + j, acc[i][j], acc2[i][j]);
}

struct EpProj { bf16* P;
    __device__ void operator()(int m, int n, float v, float) const {
        if (n < C_K) v *= C2; else if (n >= C_GA) v = sigmoidf_(v);
        P[(size_t)m * NPROJ + n] = (bf16)f2bf(v); } };
struct EpPool { bf16* AP; const float* pool_scale; long long g;
    __device__ void operator()(int m, int n, float v, float) const { AP[(size_t)m * D + g * 256 + n] = (bf16)f2bf(v * pool_scale[g * 256 + n]); } };
struct EpT1 { bf16* T1; const bf16* P;
    __device__ void operator()(int m, int n, float v, float) const { T1[(size_t)m * D + n] = (bf16)f2bf(v * bf2f(P[(size_t)m * NPROJ + C_GP + n])); } };
struct EpMerged { bf16* T1; const bf16* P;
    __device__ void operator()(int m, int n, float v, float) const { const size_t o = (size_t)m * D + n; T1[o] = (bf16)f2bf(v * bf2f(P[(size_t)m * NPROJ + C_GA + n]) + bf2f(T1[o])); } };
struct EpX1 { float* X1; const float* x; const float* ada;
    __device__ void operator()(int m, int n, float v, float) const { const size_t o = (size_t)m * D + n; X1[o] = x[o] + ada[(size_t)(m / SEQ) * NADA + 2 * D + n] * v; } };
struct EpAct { bf16* ACT; const float* slot_w;
    __device__ void operator()(int m, int n, float g, float u) const { ACT[(size_t)m * FF + n] = (bf16)f2bf(g * sigmoidf_(g) * u * slot_w[m]); } };
struct EpY { bf16* Y;
    __device__ void operator()(int m, int n, float v, float) const { Y[(size_t)m * D + n] = (bf16)f2bf(v); } };

__global__ __launch_bounds__(256) void attn(const bf16* __restrict__ P, const float* __restrict__ sinks, bf16* __restrict__ AP) {
    __shared__ float Ps[16][129];
    const int tid = threadIdx.x, r = tid >> 4, part = tid & 15, h = blockIdx.y, b = blockIdx.z, kvh = h >> 2;
    const int t = blockIdx.x * 16 + r; const size_t rowq = (size_t)b * SEQ + t;
    uint4 q4[8];
#pragma unroll
    for (int c = 0; c < 8; ++c) q4[c] = *(const uint4*)(P + rowq * NPROJ + C_Q + h * 64 + c * 8);
    float s[8]; float mx = sinks[h] * LOG2E;
#pragma unroll
    for (int jj = 0; jj < 8; ++jj) { const int w = part + 16 * jj, kp = t - w; float dot = -1e30f;
        if (kp >= 0) { const bf16* kr = P + ((size_t)b * SEQ + kp) * NPROJ + C_K + kvh * 64; dot = 0.f;
#pragma unroll
            for (int c = 0; c < 8; ++c) { const uint4 k4 = *(const uint4*)(kr + c * 8);
                dot += bf2f(q4[c].x & 0xffffu) * bf2f(k4.x & 0xffffu) + bf2f(q4[c].x >> 16) * bf2f(k4.x >> 16) + bf2f(q4[c].y & 0xffffu) * bf2f(k4.y & 0xffffu) + bf2f(q4[c].y >> 16) * bf2f(k4.y >> 16)
                     + bf2f(q4[c].z & 0xffffu) * bf2f(k4.z & 0xffffu) + bf2f(q4[c].z >> 16) * bf2f(k4.z >> 16) + bf2f(q4[c].w & 0xffffu) * bf2f(k4.w & 0xffffu) + bf2f(q4[c].w >> 16) * bf2f(k4.w >> 16); } }
        s[jj] = dot; mx = fmaxf(mx, dot); }
    mx = fmaxf(mx, __shfl_xor(mx, 1)); mx = fmaxf(mx, __shfl_xor(mx, 2)); mx = fmaxf(mx, __shfl_xor(mx, 4)); mx = fmaxf(mx, __shfl_xor(mx, 8));
    float sum = 0.f;
#pragma unroll
    for (int jj = 0; jj < 8; ++jj) { const float p = exp2f(s[jj] - mx); sum += p; Ps[r][part + 16 * jj] = p; }
    sum += __shfl_xor(sum, 1); sum += __shfl_xor(sum, 2); sum += __shfl_xor(sum, 4); sum += __shfl_xor(sum, 8);
    sum += exp2f(sinks[h] * LOG2E - mx);
    __syncthreads();
    float o[4] = {0.f, 0.f, 0.f, 0.f};
    const int wmax = t < 127 ? t : 127;
    for (int w = 0; w <= wmax; ++w) { const float p = Ps[r][w]; const uint2 v2 = *(const uint2*)(P + ((size_t)b * SEQ + (t - w)) * NPROJ + C_V + kvh * 64 + part * 4);
        o[0] += p * bf2f(v2.x & 0xffffu); o[1] += p * bf2f(v2.x >> 16); o[2] += p * bf2f(v2.y & 0xffffu); o[3] += p * bf2f(v2.y >> 16); }
    const float inv = 1.0f / sum; uint2 w2; w2.x = f2bf(o[0] * inv) | (f2bf(o[1] * inv) << 16); w2.y = f2bf(o[2] * inv) | (f2bf(o[3] * inv) << 16);
    *(uint2*)(AP + rowq * D + 1024 + h * 64 + part * 4) = w2;
}
__global__ __launch_bounds__(256) void pooled(const bf16* __restrict__ P, bf16* __restrict__ PO) {
    const size_t idx = (size_t)blockIdx.x * 256 + threadIdx.x; const int row = (int)(idx >> 10), ch = (int)(idx & 1023), t = row % SEQ, g = ch >> 8, w = 2 << g;
    const int cnt = (t + 1) < w ? (t + 1) : w; float s = 0.f;
    for (int i = 0; i < cnt; ++i) s += bf2f(P[(size_t)(row - i) * NPROJ + C_U + ch]);
    PO[(size_t)row * 1024 + ch] = (bf16)f2bf(s / (float)cnt - bf2f(P[(size_t)row * NPROJ + C_U + ch]));
}
__global__ __launch_bounds__(256) void ssq(const float* __restrict__ X1, float* __restrict__ SSQ) {
    const int lane = threadIdx.x & 63, row = blockIdx.x * 4 + (threadIdx.x >> 6);
    const float* xr = X1 + (size_t)row * D;
    for (int p = 0; p < 32; ++p) { const float v = xr[64 * p + lane]; const float s = wave_sum(v * v); if (lane == 0) SSQ[(size_t)row * 32 + p] = s; }
}
__global__ __launch_bounds__(256) void route(const float* __restrict__ X1, const float* __restrict__ SSQ, const float* __restrict__ g2, const float* __restrict__ ada,
                                             const float* __restrict__ wrg, const float* __restrict__ brg, const float* __restrict__ wre, const float* __restrict__ bre,
                                             bf16* __restrict__ H2, int* __restrict__ toke, float* __restrict__ tokw) {
    const int lane = threadIdx.x & 63, row = blockIdx.x * 4 + (threadIdx.x >> 6), b = row / SEQ;
    const float part = lane < 32 ? SSQ[(size_t)row * 32 + lane] : 0.f;
    const float rstd = rsqrtf(wave_sum(part) * (1.0f / D) + EPS);
    const float* sh = ada + (size_t)b * NADA + 3 * D; const float* sc = ada + (size_t)b * NADA + 4 * D;
    float acc[20];
#pragma unroll
    for (int o = 0; o < 20; ++o) acc[o] = 0.f;
#pragma unroll
    for (int j = 0; j < 8; ++j) { const int d = 4 * lane + 256 * j;
        const float4 xv = *(const float4*)(X1 + (size_t)row * D + d), g = *(const float4*)(g2 + d), s = *(const float4*)(sc + d), h = *(const float4*)(sh + d);
        const float hv[4] = {xv.x * rstd * g.x * (1.f + s.x) + h.x, xv.y * rstd * g.y * (1.f + s.y) + h.y, xv.z * rstd * g.z * (1.f + s.z) + h.z, xv.w * rstd * g.w * (1.f + s.w) + h.w};
        uint2 w; w.x = f2bf(hv[0]) | (f2bf(hv[1]) << 16); w.y = f2bf(hv[2]) | (f2bf(hv[3]) << 16);
        *(uint2*)(H2 + (size_t)row * D + d) = w;
#pragma unroll
        for (int e = 0; e < 4; ++e) { const float4 wg = *(const float4*)(wrg + (size_t)(d + e) * 4);
            acc[0] += hv[e] * wg.x; acc[1] += hv[e] * wg.y; acc[2] += hv[e] * wg.z; acc[3] += hv[e] * wg.w;
#pragma unroll
            for (int q = 0; q < 4; ++q) { const float4 we = *(const float4*)(wre + (size_t)(d + e) * 16 + q * 4);
                acc[4 + 4 * q] += hv[e] * we.x; acc[5 + 4 * q] += hv[e] * we.y; acc[6 + 4 * q] += hv[e] * we.z; acc[7 + 4 * q] += hv[e] * we.w; } } }
#pragma unroll
    for (int o = 0; o < 20; ++o) acc[o] = wave_sum(acc[o]);
    if (lane == 0) {
        float gl[4]; int gi = 0;
#pragma unroll
        for (int o = 0; o < 4; ++o) gl[o] = acc[o] + brg[o];
#pragma unroll
        for (int o = 1; o < 4; ++o) if (gl[o] > gl[gi]) gi = o;
        float gsum = 0.f;
#pragma unroll
        for (int o = 0; o < 4; ++o) gsum += __expf(gl[o] - gl[gi]);
        const float gp = 1.0f / gsum;
        float el[4];
#pragma unroll
        for (int o = 0; o < 4; ++o) { float v = 0.f;
#pragma unroll
            for (int g = 0; g < 4; ++g) v = (g == gi) ? acc[4 + 4 * g + o] + bre[4 * g + o] : v;
            el[o] = v; }
        int i1 = 0;
#pragma unroll
        for (int o = 1; o < 4; ++o) if (el[o] > el[i1]) i1 = o;
        int i2 = (i1 == 0) ? 1 : 0;
#pragma unroll
        for (int o = 0; o < 4; ++o) if (o != i1 && el[o] > el[i2]) i2 = o;
        const float r = __expf(el[i2] - el[i1]);
        const float w1 = gp / (1.0f + r), w2 = gp * r / (1.0f + r);
        toke[row * 2 + 0] = gi * 4 + i1; toke[row * 2 + 1] = gi * 4 + i2; tokw[row * 2 + 0] = w1; tokw[row * 2 + 1] = w2;
    }
}
__global__ __launch_bounds__(64) void hist(const int* __restrict__ toke, int* __restrict__ blkcnt, int* __restrict__ lrank) {
    const int lane = threadIdx.x, tkn = blockIdx.x * 64 + lane; const int e1 = toke[tkn * 2], e2 = toke[tkn * 2 + 1];
    const unsigned long long lt = (1ull << lane) - 1ull; int r1 = 0, r2 = 0;
    for (int e = 0; e < NEXP; ++e) { const unsigned long long m1 = __ballot(e1 == e), m2 = __ballot(e2 == e);
        if (e1 == e) r1 = __popcll(m1 & lt); if (e2 == e) r2 = __popcll(m1) + __popcll(m2 & lt);
        if (lane == 0) blkcnt[blockIdx.x * 16 + e] = __popcll(m1) + __popcll(m2); }
    lrank[tkn * 2] = r1; lrank[tkn * 2 + 1] = r2;
}
__global__ __launch_bounds__(256) void scan(const int* __restrict__ blkcnt, int* __restrict__ blkbase, int* __restrict__ meta, int* __restrict__ slot_tok, float* __restrict__ slot_w) {
    __shared__ int cnt[16], off[17];
    const int tid = threadIdx.x;
    if (tid < 16) { int base = 0; for (int b = 0; b < 256; ++b) { blkbase[b * 16 + tid] = base; base += blkcnt[b * 16 + tid]; } cnt[tid] = base; }
    __syncthreads();
    if (tid == 0) { int o = 0, nt = 0; for (int e = 0; e < 16; ++e) { off[e] = o; meta[e] = o; const int tl = (cnt[e] + 255) >> 8; for (int i = 0; i < tl; ++i) meta[32 + nt++] = e; o += tl * 256; } off[16] = o; meta[16] = o; meta[17] = o; meta[18] = nt; }
    __syncthreads();
    for (int e = 0; e < 16; ++e) for (int s = off[e] + cnt[e] + tid; s < off[e + 1]; s += 256) { slot_tok[s] = 0; slot_w[s] = 0.f; }
}
__global__ __launch_bounds__(256) void fill(const int* __restrict__ toke, const float* __restrict__ tokw, const int* __restrict__ lrank, const int* __restrict__ blkbase, const int* __restrict__ meta,
                                            int* __restrict__ slot_tok, float* __restrict__ slot_w, int* __restrict__ tokslot) {
    const int i = blockIdx.x * 256 + threadIdx.x;
    const int tkn = i >> 1, e = toke[i], slot = meta[e] + blkbase[(tkn >> 6) * 16 + e] + lrank[i];
    slot_tok[slot] = tkn; slot_w[slot] = tokw[i]; tokslot[i] = slot;
}
__global__ __launch_bounds__(256) void final_(float* __restrict__ X1, const bf16* __restrict__ Y, const int* __restrict__ tokslot, const float* __restrict__ ada, const float* __restrict__ fg) {
    const int lane = threadIdx.x & 63, row = blockIdx.x * 4 + (threadIdx.x >> 6), b = row / SEQ;
    const int s1 = tokslot[row * 2], s2 = tokslot[row * 2 + 1]; const float* g2 = ada + (size_t)b * NADA + 5 * D;
    float4 v[8]; float ss = 0.f;
#pragma unroll
    for (int j = 0; j < 8; ++j) { const int d = 4 * lane + 256 * j; const float4 xv = *(const float4*)(X1 + (size_t)row * D + d), g = *(const float4*)(g2 + d);
        const uint2 a = *(const uint2*)(Y + (size_t)s1 * D + d), c = *(const uint2*)(Y + (size_t)s2 * D + d);
        v[j].x = xv.x + g.x * (bf2f(a.x & 0xffffu) + bf2f(c.x & 0xffffu)); v[j].y = xv.y + g.y * (bf2f(a.x >> 16) + bf2f(c.x >> 16));
        v[j].z = xv.z + g.z * (bf2f(a.y & 0xffffu) + bf2f(c.y & 0xffffu)); v[j].w = xv.w + g.w * (bf2f(a.y >> 16) + bf2f(c.y >> 16));
        ss += v[j].x * v[j].x + v[j].y * v[j].y + v[j].z * v[j].z + v[j].w * v[j].w; }
    const float rstd = rsqrtf(wave_sum(ss) * (1.0f / D) + EPS);
#pragma unroll
    for (int j = 0; j < 8; ++j) { const int d = 4 * lane + 256 * j; const float4 g = *(const float4*)(fg + d);
        *(float4*)(X1 + (size_t)row * D + d) = make_float4(v[j].x * rstd * g.x, v[j].y * rstd * g.y, v[j].z * rstd * g.z, v[j].w * rstd * g.w); }
}
}

extern "C" void kernel_launch(void* const* d_in, const int* in_sizes, int n_in, void* d_out, int out_size, void* d_ws, size_t ws_size, hipStream_t stream) {
    if (n_in != 21 || out_size != T * D || ws_size < WS_END) { fprintf(stderr, "kernel_launch: unexpected shapes (n_in %d out %d ws %zu)\n", n_in, out_size, ws_size); return; }
    const float* x = (const float*)d_in[0]; const float* c = (const float*)d_in[1]; const float* w_ada = (const float*)d_in[2]; const float* b_ada = (const float*)d_in[3];
    const float* norm1_g = (const float*)d_in[4]; const float* w_in = (const float*)d_in[5]; const float* sinks = (const float*)d_in[6]; const float* w_pool = (const float*)d_in[7];
    const float* pool_scale = (const float*)d_in[8]; const float* w_ab = (const float*)d_in[9]; const float* w_pb = (const float*)d_in[10]; const float* w_out = (const float*)d_in[11];
    const float* norm2_g = (const float*)d_in[12]; const float* w_rg = (const float*)d_in[13]; const float* b_rg = (const float*)d_in[14]; const float* w_re = (const float*)d_in[15];
    const float* b_re = (const float*)d_in[16]; const float* w_eg = (const float*)d_in[17]; const float* w_eu = (const float*)d_in[18]; const float* w_ed = (const float*)d_in[19];
    const float* final_g = (const float*)d_in[20];
    unsigned char* ws = (unsigned char*)d_ws; float* out = (float*)d_out;
    float* ADA = (float*)(ws + WS_ADA); float* ADAP = (float*)(ws + WS_ADAP); float* SSQ = (float*)(ws + WS_SSQ);
    bf16* PROJ = (bf16*)(ws + WS_PROJ); bf16* ACT = (bf16*)(ws + WS_ACT); bf16* Y = (bf16*)(ws + WS_Y);
    bf16* BUFB = (bf16*)(ws + WS_B); bf16* BUFC = (bf16*)(ws + WS_C);
    unsigned char* rt = ws + WS_RT;
    int* TOKE = (int*)(rt + RT_TOKE); float* TOKW = (float*)(rt + RT_TOKW); int* LRANK = (int*)(rt + RT_LRANK); int* TOKSLOT = (int*)(rt + RT_TOKSLOT);
    int* BLKCNT = (int*)(rt + RT_BLKCNT); int* BLKBASE = (int*)(rt + RT_BLKBASE); int* SLOTTOK = (int*)(rt + RT_SLOTTOK); float* SLOTW = (float*)(rt + RT_SLOTW); int* META = (int*)(rt + RT_META);

    nv::ada_part<<<dim3(NADA / 256, 8), 256, 0, stream>>>(c, w_ada, ADAP);
    nv::ada_sum<<<2 * NADA / 256, 256, 0, stream>>>(ADAP, b_ada, ADA);
    nv::h1<<<T / 4, 256, 0, stream>>>(x, norm1_g, ADA, BUFB);
    nv::gemm<false><<<dim3(NPROJ / 64, T / 64), 256, 0, stream>>>(nv::ABf16{BUFB, D, 0}, nv::WPlain{w_in, NPROJ}, nv::WPlain{w_in, NPROJ}, nv::EpProj{PROJ}, D);
    nv::attn<<<dim3(SEQ / 16, 16, BATCH), 256, 0, stream>>>(PROJ, sinks, BUFB);
    nv::pooled<<<(unsigned)((size_t)T * 1024 / 256), 256, 0, stream>>>(PROJ, BUFC);
    for (int g = 0; g < 4; ++g)
        nv::gemm<false><<<dim3(256 / 64, T / 64), 256, 0, stream>>>(nv::ABf16{BUFC, 1024, g * 256}, nv::WPlain{w_pool + (size_t)g * 256 * 256, 256}, nv::WPlain{w_pool, 256}, nv::EpPool{BUFB, pool_scale, g}, 256);
    nv::gemm<false><<<dim3(D / 64, T / 64), 256, 0, stream>>>(nv::ABf16{BUFB, D, 0}, nv::WPlain{w_pb, D}, nv::WPlain{w_pb, D}, nv::EpT1{BUFC, PROJ}, 1024);
    nv::gemm<false><<<dim3(D / 64, T / 64), 256, 0, stream>>>(nv::ABf16{BUFB, D, 1024}, nv::WPlain{w_ab, D}, nv::WPlain{w_ab, D}, nv::EpMerged{BUFC, PROJ}, 1024);
    nv::gemm<false><<<dim3(D / 64, T / 64), 256, 0, stream>>>(nv::ABf16{BUFC, D, 0}, nv::WPlain{w_out, D}, nv::WPlain{w_out, D}, nv::EpX1{out, x, ADA}, D);
    nv::ssq<<<T / 4, 256, 0, stream>>>(out, SSQ);
    nv::route<<<T / 4, 256, 0, stream>>>(out, SSQ, norm2_g, ADA, w_rg, b_rg, w_re, b_re, BUFB, TOKE, TOKW);
    nv::hist<<<256, 64, 0, stream>>>(TOKE, BLKCNT, LRANK);
    nv::scan<<<1, 256, 0, stream>>>(BLKCNT, BLKBASE, META, SLOTTOK, SLOTW);
    nv::fill<<<2 * T / 256, 256, 0, stream>>>(TOKE, TOKW, LRANK, BLKBASE, META, SLOTTOK, SLOTW, TOKSLOT);
    nv::gemm<true><<<dim3(FF / 64, MAXSLOT / 64), 256, 0, stream>>>(nv::AGather{BUFB, D, SLOTTOK, META}, nv::WExpert{w_eg, FF, (size_t)D * FF, META}, nv::WExpert{w_eu, FF, (size_t)D * FF, META}, nv::EpAct{ACT, SLOTW}, D);
    nv::gemm<false><<<dim3(D / 64, MAXSLOT / 64), 256, 0, stream>>>(nv::ASlot{ACT, FF, META}, nv::WExpert{w_ed, D, (size_t)FF * D, META}, nv::WExpert{w_ed, D, (size_t)FF * D, META}, nv::EpY{Y}, FF);
    nv::final_<<<T / 4, 256, 0, stream>>>(out, Y, TOKSLOT, ADA, final_g);
}
```

```cpp
#include <hip/hip_runtime.h>
#include <stdint.h>
#include <cstdio>

constexpr int D = 2048, BATCH = 2, SEQ = 8192, T = BATCH * SEQ;
constexpr int NPROJ = 6656;
constexpr int C_Q = 0, C_K = 1024, C_V = 1280, C_U = 1536, C_GA = 2560, C_GP = 4608;
constexpr int NADA = 6 * D;
constexpr int NEXP = 16, FF = 512;
constexpr int MAXSLOT = 2 * T + NEXP * 256;
constexpr int ADA_SL = 16;
constexpr float EPS = 1e-6f;
constexpr float LOG2E = 1.4426950408889634f;
constexpr float C2 = 0.125f * LOG2E;

typedef unsigned short bf16;

constexpr size_t MiB = 1u << 20;
constexpr size_t WS_CTL = 0;
constexpr size_t WS_ADA = 1 * MiB;
constexpr size_t WS_ADAP = 2 * MiB;
constexpr size_t WS_WIN = 4 * MiB;
constexpr size_t WS_WPB = 30 * MiB;
constexpr size_t WS_WAB = 34 * MiB;
constexpr size_t WS_WOUT = 38 * MiB;
constexpr size_t WS_WPOOL = 46 * MiB;
constexpr size_t WS_WGU = 47 * MiB;
constexpr size_t WS_WDN = 111 * MiB;
constexpr size_t WS_PROJ = 144 * MiB;
constexpr size_t WS_ACT = 144 * MiB;
constexpr size_t WS_Y = 180 * MiB;
constexpr size_t WS_B = 352 * MiB;
constexpr size_t WS_C = 416 * MiB;
constexpr size_t WS_RT = 480 * MiB;
constexpr size_t WS_SSQ = 482 * MiB;
constexpr size_t WS_END = 484 * MiB;
constexpr size_t RT_TOKE = 0;
constexpr size_t RT_TOKW = RT_TOKE + (size_t)T * 2 * 4;
constexpr size_t RT_LRANK = RT_TOKW + (size_t)T * 2 * 4;
constexpr size_t RT_TOKSLOT = RT_LRANK + (size_t)T * 2 * 4;
constexpr size_t RT_BLKCNT = RT_TOKSLOT + (size_t)T * 2 * 4;
constexpr size_t RT_BLKBASE = RT_BLKCNT + 256 * 16 * 4;
constexpr size_t RT_SLOTTOK = RT_BLKBASE + 256 * 16 * 4;
constexpr size_t RT_SLOTW = RT_SLOTTOK + (size_t)MAXSLOT * 4;
constexpr size_t RT_META = RT_SLOTW + (size_t)MAXSLOT * 4;
static_assert(RT_META + 1024 * 4 <= 2 * MiB, "routing arrays");

__device__ __forceinline__ unsigned f2bf(float f) { unsigned u = __builtin_bit_cast(unsigned, f); return (u + 0x7fffu + ((u >> 16) & 1u)) >> 16; }
__device__ __forceinline__ float bf2f(unsigned h) { return __builtin_bit_cast(float, h << 16); }
__device__ __forceinline__ float bflo(unsigned w) { return __builtin_bit_cast(float, w << 16); }
__device__ __forceinline__ float bfhi(unsigned w) { return __builtin_bit_cast(float, w & 0xffff0000u); }
__device__ __forceinline__ float wave_sum(float v) {
#pragma unroll
    for (int o = 1; o < 64; o <<= 1) v += __shfl_xor(v, o);
    return v;
}
__device__ __forceinline__ float sigmoidf_(float v) { return 1.0f / (1.0f + __expf(-v)); }
__device__ __forceinline__ float sigmoid_fast(float v) { return __builtin_amdgcn_rcpf(1.0f + __builtin_amdgcn_exp2f(-LOG2E * v)); }

namespace nv {
__global__ __launch_bounds__(256) void ada_part(const float* __restrict__ c, const float* __restrict__ W, float* __restrict__ adap) {
    const int j = blockIdx.x * 256 + threadIdx.x, ks = blockIdx.y; constexpr int KS = D / ADA_SL;
    float a0 = 0.f, a1 = 0.f;
    for (int k = ks * KS; k < ks * KS + KS; ++k) { const float w = W[(size_t)k * NADA + j]; a0 += c[k] * w; a1 += c[D + k] * w; }
    adap[((size_t)ks * 2 + 0) * NADA + j] = a0; adap[((size_t)ks * 2 + 1) * NADA + j] = a1;
}
__global__ __launch_bounds__(256) void ada_sum(const float* __restrict__ adap, const float* __restrict__ bias, float* __restrict__ ada) {
    const int i = blockIdx.x * 256 + threadIdx.x;
    const int b = i / NADA, j = i % NADA; float s = bias[j];
    for (int ks = 0; ks < ADA_SL; ++ks) s += adap[((size_t)ks * 2 + b) * NADA + j];
    ada[i] = s;
}
__global__ __launch_bounds__(256) void h1(const float* __restrict__ x, const float* __restrict__ g1, const float* __restrict__ ada, bf16* __restrict__ H1) {
    const int lane = threadIdx.x & 63, row = blockIdx.x * 4 + (threadIdx.x >> 6), b = row / SEQ;
    const float4* xr = (const float4*)(x + (size_t)row * D) + lane;
    float4 v[8]; float ss = 0.f;
#pragma unroll
    for (int j = 0; j < 8; ++j) { v[j] = xr[64 * j]; ss += v[j].x * v[j].x + v[j].y * v[j].y + v[j].z * v[j].z + v[j].w * v[j].w; }
    const float rstd = rsqrtf(wave_sum(ss) * (1.0f / D) + EPS);
    const float* sh = ada + (size_t)b * NADA + 0 * D; const float* sc = ada + (size_t)b * NADA + 1 * D;
#pragma unroll
    for (int j = 0; j < 8; ++j) { const int d = 4 * lane + 256 * j;
        const float4 g = *(const float4*)(g1 + d), s = *(const float4*)(sc + d), h = *(const float4*)(sh + d);
        const float o0 = v[j].x * rstd * g.x * (1.f + s.x) + h.x, o1 = v[j].y * rstd * g.y * (1.f + s.y) + h.y;
        const float o2 = v[j].z * rstd * g.z * (1.f + s.z) + h.z, o3 = v[j].w * rstd * g.w * (1.f + s.w) + h.w;
        uint2 w; w.x = f2bf(o0) | (f2bf(o1) << 16); w.y = f2bf(o2) | (f2bf(o3) << 16);
        *(uint2*)(H1 + (size_t)row * D + d) = w; }
}
struct ABf16 { const bf16* A; long long lda; long long koff;
    __device__ bool init(int bm) { return true; }
    __device__ const bf16* rowptr(int m) const { return A + (size_t)m * lda + koff; } };
struct AGather { const bf16* A; long long lda; const int* slot_tok; const int* meta;
    __device__ bool init(int bm) { return bm < meta[17]; }
    __device__ const bf16* rowptr(int m) const { return A + (size_t)slot_tok[m] * lda; } };
struct ASlot { const bf16* A; long long lda; const int* meta;
    __device__ bool init(int bm) { return bm < meta[17]; }
    __device__ const bf16* rowptr(int m) const { return A + (size_t)m * lda; } };
struct WPlain { const float* W; long long ldw;
    __device__ const float* base(int bm) const { return W; } };
struct WExpert { const float* W; long long ldw; size_t estride; const int* meta;
    __device__ const float* base(int bm) const { return W + (size_t)meta[32 + (bm >> 8)] * estride; } };

template <bool DUAL, class AL, class WL, class EP>
__global__ __launch_bounds__(256) void gemm(AL al, WL wl, WL wl2, EP ep, long long K_) {
    const int K = (int)K_;
    __shared__ float As[16][68]; __shared__ float Ws[16][64]; __shared__ float Ws2[DUAL ? 16 : 1][64];
    const int tid = threadIdx.x, tx = tid & 15, ty = tid >> 4, bm = blockIdx.y * 64, bn = blockIdx.x * 64;
    if (!al.init(bm)) return;
    const float* Wb = wl.base(bm); const float* Wb2 = DUAL ? wl2.base(bm) : nullptr;
    const bf16* arow = al.rowptr(bm + (tid >> 2)); const int ak = (tid & 3) * 4;
    float acc[4][4], acc2[4][4];
#pragma unroll
    for (int i = 0; i < 4; ++i)
#pragma unroll
        for (int j = 0; j < 4; ++j) { acc[i][j] = 0.f; acc2[i][j] = 0.f; }
    for (int k0 = 0; k0 < K; k0 += 16) {
        const uint2 a = *(const uint2*)(arow + k0 + ak);
        As[ak + 0][tid >> 2] = bf2f(a.x & 0xffffu); As[ak + 1][tid >> 2] = bf2f(a.x >> 16); As[ak + 2][tid >> 2] = bf2f(a.y & 0xffffu); As[ak + 3][tid >> 2] = bf2f(a.y >> 16);
        *(float4*)&Ws[ty][tx * 4] = *(const float4*)(Wb + (size_t)(k0 + ty) * wl.ldw + bn + tx * 4);
        if (DUAL) *(float4*)&Ws2[ty][tx * 4] = *(const float4*)(Wb2 + (size_t)(k0 + ty) * wl.ldw + bn + tx * 4);
        __syncthreads();
#pragma unroll
        for (int kk = 0; kk < 16; ++kk) {
            const float4 av = *(const float4*)&As[kk][ty * 4]; const float4 wv = *(const float4*)&Ws[kk][tx * 4];
            const float a4[4] = {av.x, av.y, av.z, av.w}, w4[4] = {wv.x, wv.y, wv.z, wv.w};
#pragma unroll
            for (int i = 0; i < 4; ++i)
#pragma unroll
                for (int j = 0; j < 4; ++j) acc[i][j] += a4[i] * w4[j];
            if (DUAL) { const float4 wv2 = *(const float4*)&Ws2[kk][tx * 4]; const float u4[4] = {wv2.x, wv2.y, wv2.z, wv2.w};
#pragma unroll
                for (int i = 0; i < 4; ++i)
#pragma unroll
                    for (int j = 0; j < 4; ++j) acc2[i][j] += a4[i] * u4[j]; }
        }
        __syncthreads();
    }
#pragma unroll
    for (int i = 0; i < 4; ++i)
#pragma unroll
        for (int j = 0; j < 4; ++j) ep(bm + ty * 4 + i, bn + tx * 4 + j, acc[i][j], acc2[i][j]);
}
struct EpProj { bf16* P;
    __device__ void operator()(int m, int n, float v, float) const {
        if (n < C_K) v *= C2; else if (n >= C_GA) v = sigmoidf_(v);
        P[(size_t)m * NPROJ + n] = (bf16)f2bf(v); } };
struct EpPool { bf16* AP; const float* pool_scale; long long g;
    __device__ void operator()(int m, int n, float v, float) const { AP[(size_t)m * D + g * 256 + n] = (bf16)f2bf(v * pool_scale[g * 256 + n]); } };
struct EpT1 { bf16* T1; const bf16* P;
    __device__ void operator()(int m, int n, float v, float) const { T1[(size_t)m * D + n] = (bf16)f2bf(v * bf2f(P[(size_t)m * NPROJ + C_GP + n])); } };
struct EpMerged { bf16* T1; const bf16* P;
    __device__ void operator()(int m, int n, float v, float) const { const size_t o = (size_t)m * D + n; T1[o] = (bf16)f2bf(v * bf2f(P[(size_t)m * NPROJ + C_GA + n]) + bf2f(T1[o])); } };
struct EpX1 { float* X1; const float* x; const float* ada;
    __device__ void operator()(int m, int n, float v, float) const { const size_t o = (size_t)m * D + n; X1[o] = x[o] + ada[(size_t)(m / SEQ) * NADA + 2 * D + n] * v; } };
struct EpAct { bf16* ACT; const float* slot_w;
    __device__ void operator()(int m, int n, float g, float u) const { ACT[(size_t)m * FF + n] = (bf16)f2bf(g * sigmoidf_(g) * u * slot_w[m]); } };
struct EpY { bf16* Y;
    __device__ void operator()(int m, int n, float v, float) const { Y[(size_t)m * D + n] = (bf16)f2bf(v); } };

__global__ __launch_bounds__(256) void attn(const bf16* __restrict__ P, const float* __restrict__ sinks, bf16* __restrict__ AP) {
    __shared__ float Ps[16][129];
    const int tid = threadIdx.x, r = tid >> 4, part = tid & 15, h = blockIdx.y, b = blockIdx.z, kvh = h >> 2;
    const int t = blockIdx.x * 16 + r; const size_t rowq = (size_t)b * SEQ + t;
    uint4 q4[8];
#pragma unroll
    for (int c = 0; c < 8; ++c) q4[c] = *(const uint4*)(P + rowq * NPROJ + C_Q + h * 64 + c * 8);
    float s[8]; float mx = sinks[h] * LOG2E;
#pragma unroll
    for (int jj = 0; jj < 8; ++jj) { const int w = part + 16 * jj, kp = t - w; float dot = -1e30f;
        if (kp >= 0) { const bf16* kr = P + ((size_t)b * SEQ + kp) * NPROJ + C_K + kvh * 64; dot = 0.f;
#pragma unroll
            for (int c = 0; c < 8; ++c) { const uint4 k4 = *(const uint4*)(kr + c * 8);
                dot += bflo(q4[c].x) * bflo(k4.x) + bfhi(q4[c].x) * bfhi(k4.x) + bflo(q4[c].y) * bflo(k4.y) + bfhi(q4[c].y) * bfhi(k4.y)
                     + bflo(q4[c].z) * bflo(k4.z) + bfhi(q4[c].z) * bfhi(k4.z) + bflo(q4[c].w) * bflo(k4.w) + bfhi(q4[c].w) * bfhi(k4.w); } }
        s[jj] = dot; mx = fmaxf(mx, dot); }
    mx = fmaxf(mx, __shfl_xor(mx, 1)); mx = fmaxf(mx, __shfl_xor(mx, 2)); mx = fmaxf(mx, __shfl_xor(mx, 4)); mx = fmaxf(mx, __shfl_xor(mx, 8));
    float sum = 0.f;
#pragma unroll
    for (int jj = 0; jj < 8; ++jj) { const float p = exp2f(s[jj] - mx); sum += p; Ps[r][part + 16 * jj] = p; }
    sum += __shfl_xor(sum, 1); sum += __shfl_xor(sum, 2); sum += __shfl_xor(sum, 4); sum += __shfl_xor(sum, 8);
    sum += exp2f(sinks[h] * LOG2E - mx);
    __syncthreads();
    float o[4] = {0.f, 0.f, 0.f, 0.f};
    const int wmax = t < 127 ? t : 127;
    for (int w = 0; w <= wmax; ++w) { const float p = Ps[r][w]; const uint2 v2 = *(const uint2*)(P + ((size_t)b * SEQ + (t - w)) * NPROJ + C_V + kvh * 64 + part * 4);
        o[0] += p * bflo(v2.x); o[1] += p * bfhi(v2.x); o[2] += p * bflo(v2.y); o[3] += p * bfhi(v2.y); }
    const float inv = 1.0f / sum; uint2 w2; w2.x = f2bf(o[0] * inv) | (f2bf(o[1] * inv) << 16); w2.y = f2bf(o[2] * inv) | (f2bf(o[3] * inv) << 16);
    *(uint2*)(AP + rowq * D + 1024 + h * 64 + part * 4) = w2;
}
__global__ __launch_bounds__(256) void pooled(const bf16* __restrict__ P, bf16* __restrict__ PO) {
    const size_t idx = (size_t)blockIdx.x * 256 + threadIdx.x; const int row = (int)(idx >> 10), ch = (int)(idx & 1023), t = row % SEQ, g = ch >> 8, w = 2 << g;
    const int cnt = (t + 1) < w ? (t + 1) : w; float s = 0.f;
    for (int i = 0; i < cnt; ++i) s += bf2f(P[(size_t)(row - i) * NPROJ + C_U + ch]);
    PO[(size_t)row * 1024 + ch] = (bf16)f2bf(s / (float)cnt - bf2f(P[(size_t)row * NPROJ + C_U + ch]));
}
__global__ __launch_bounds__(256) void ssq(const float* __restrict__ X1, float* __restrict__ SSQ) {
    const int lane = threadIdx.x & 63, row = blockIdx.x * 4 + (threadIdx.x >> 6);
    const float* xr = X1 + (size_t)row * D;
    for (int p = 0; p < 32; ++p) { const float v = xr[64 * p + lane]; const float s = wave_sum(v * v); if (lane == 0) SSQ[(size_t)row * 32 + p] = s; }
}
}

__device__ __forceinline__ int route_row(const float* __restrict__ X1, const float* __restrict__ SSQ, const float* __restrict__ g2, const float* __restrict__ ada,
                                         const float* __restrict__ wrg, const float* __restrict__ brg, const float* __restrict__ wre, const float* __restrict__ bre,
                                         bf16* __restrict__ H2, int row, int lane, float& w1, float& w2) {
    const int b = row / SEQ;
    const float part = lane < 32 ? SSQ[(size_t)row * 32 + lane] : 0.f;
    const float rstd = rsqrtf(wave_sum(part) * (1.0f / D) + EPS);
    const float* sh = ada + (size_t)b * NADA + 3 * D; const float* sc = ada + (size_t)b * NADA + 4 * D;
    float acc[20];
#pragma unroll
    for (int o = 0; o < 20; ++o) acc[o] = 0.f;
#pragma unroll
    for (int j = 0; j < 8; ++j) { const int d = 4 * lane + 256 * j;
        const float4 xv = *(const float4*)(X1 + (size_t)row * D + d), g = *(const float4*)(g2 + d), s = *(const float4*)(sc + d), h = *(const float4*)(sh + d);
        const float hv[4] = {xv.x * rstd * g.x * (1.f + s.x) + h.x, xv.y * rstd * g.y * (1.f + s.y) + h.y, xv.z * rstd * g.z * (1.f + s.z) + h.z, xv.w * rstd * g.w * (1.f + s.w) + h.w};
        uint2 w; w.x = f2bf(hv[0]) | (f2bf(hv[1]) << 16); w.y = f2bf(hv[2]) | (f2bf(hv[3]) << 16);
        *(uint2*)(H2 + (size_t)row * D + d) = w;
#pragma unroll
        for (int e = 0; e < 4; ++e) { const float4 wg = *(const float4*)(wrg + (size_t)(d + e) * 4);
            acc[0] += hv[e] * wg.x; acc[1] += hv[e] * wg.y; acc[2] += hv[e] * wg.z; acc[3] += hv[e] * wg.w;
#pragma unroll
            for (int q = 0; q < 4; ++q) { const float4 we = *(const float4*)(wre + (size_t)(d + e) * 16 + q * 4);
                acc[4 + 4 * q] += hv[e] * we.x; acc[5 + 4 * q] += hv[e] * we.y; acc[6 + 4 * q] += hv[e] * we.z; acc[7 + 4 * q] += hv[e] * we.w; } } }
#pragma unroll
    for (int o = 0; o < 20; ++o) acc[o] = wave_sum(acc[o]);
    float gl[4]; int gi = 0;
#pragma unroll
    for (int o = 0; o < 4; ++o) gl[o] = acc[o] + brg[o];
#pragma unroll
    for (int o = 1; o < 4; ++o) if (gl[o] > gl[gi]) gi = o;
    float gsum = 0.f;
#pragma unroll
    for (int o = 0; o < 4; ++o) gsum += __expf(gl[o] - gl[gi]);
    const float gp = 1.0f / gsum;
    float el[4];
#pragma unroll
    for (int o = 0; o < 4; ++o) { float v = 0.f;
#pragma unroll
        for (int g = 0; g < 4; ++g) v = (g == gi) ? acc[4 + 4 * g + o] + bre[4 * g + o] : v;
        el[o] = v; }
    int i1 = 0;
#pragma unroll
    for (int o = 1; o < 4; ++o) if (el[o] > el[i1]) i1 = o;
    int i2 = (i1 == 0) ? 1 : 0;
#pragma unroll
    for (int o = 0; o < 4; ++o) if (o != i1 && el[o] > el[i2]) i2 = o;
    const float r = __expf(el[i2] - el[i1]);
    w1 = gp / (1.0f + r); w2 = gp * r / (1.0f + r);
    return (gi * 4 + i1) | ((gi * 4 + i2) << 8);
}
__device__ __forceinline__ void hist_wave(int e1, int e2, int lane, int blk, int* __restrict__ blkcnt, int& r1, int& r2) {
    const unsigned long long lt = (1ull << lane) - 1ull; r1 = 0; r2 = 0;
    for (int e = 0; e < NEXP; ++e) { const unsigned long long m1 = __ballot(e1 == e), m2 = __ballot(e2 == e);
        if (e1 == e) r1 = __popcll(m1 & lt); if (e2 == e) r2 = __popcll(m1) + __popcll(m2 & lt);
        if (lane == 0) blkcnt[blk * 16 + e] = __popcll(m1) + __popcll(m2); }
}
__device__ __forceinline__ void final_row(float* __restrict__ X1, const bf16* __restrict__ Y, const int* __restrict__ tokslot, const float* __restrict__ ada, const float* __restrict__ fg, int row, int lane) {
    const int b = row / SEQ;
    const int s1 = tokslot[row * 2], s2 = tokslot[row * 2 + 1]; const float* g2 = ada + (size_t)b * NADA + 5 * D;
    float4 v[8]; float ss = 0.f;
#pragma unroll
    for (int j = 0; j < 8; ++j) { const int d = 4 * lane + 256 * j; const float4 xv = *(const float4*)(X1 + (size_t)row * D + d), g = *(const float4*)(g2 + d);
        const uint2 a = *(const uint2*)(Y + (size_t)s1 * D + d), c = *(const uint2*)(Y + (size_t)s2 * D + d);
        v[j].x = xv.x + g.x * (bflo(a.x) + bflo(c.x)); v[j].y = xv.y + g.y * (bfhi(a.x) + bfhi(c.x));
        v[j].z = xv.z + g.z * (bflo(a.y) + bflo(c.y)); v[j].w = xv.w + g.w * (bfhi(a.y) + bfhi(c.y));
        ss += v[j].x * v[j].x + v[j].y * v[j].y + v[j].z * v[j].z + v[j].w * v[j].w; }
    const float rstd = rsqrtf(wave_sum(ss) * (1.0f / D) + EPS);
#pragma unroll
    for (int j = 0; j < 8; ++j) { const int d = 4 * lane + 256 * j; const float4 g = *(const float4*)(fg + d);
        *(float4*)(X1 + (size_t)row * D + d) = make_float4(v[j].x * rstd * g.x, v[j].y * rstd * g.y, v[j].z * rstd * g.z, v[j].w * rstd * g.w); }
}
namespace nv {
__global__ __launch_bounds__(256) void route(const float* X1, const float* SSQ, const float* g2, const float* ada, const float* wrg, const float* brg, const float* wre, const float* bre,
                                             bf16* H2, int* __restrict__ toke, float* __restrict__ tokw) {
    const int lane = threadIdx.x & 63, row = blockIdx.x * 4 + (threadIdx.x >> 6); float w1, w2;
    const int ee = route_row(X1, SSQ, g2, ada, wrg, brg, wre, bre, H2, row, lane, w1, w2);
    if (lane == 0) { toke[row * 2] = ee & 255; toke[row * 2 + 1] = ee >> 8; tokw[row * 2] = w1; tokw[row * 2 + 1] = w2; }
}
__global__ __launch_bounds__(64) void hist(const int* __restrict__ toke, int* __restrict__ blkcnt, int* __restrict__ lrank) {
    const int lane = threadIdx.x, tkn = blockIdx.x * 64 + lane; int r1, r2;
    hist_wave(toke[tkn * 2], toke[tkn * 2 + 1], lane, blockIdx.x, blkcnt, r1, r2);
    lrank[tkn * 2] = r1; lrank[tkn * 2 + 1] = r2;
}
__global__ __launch_bounds__(256) void scan(const int* __restrict__ blkcnt, int* __restrict__ blkbase, int* __restrict__ meta, int* __restrict__ slot_tok, float* __restrict__ slot_w) {
    __shared__ int cnt[16], off[17];
    const int tid = threadIdx.x;
    if (tid < 16) { int base = 0; for (int b = 0; b < 256; ++b) { blkbase[b * 16 + tid] = base; base += blkcnt[b * 16 + tid]; } cnt[tid] = base; }
    __syncthreads();
    if (tid == 0) { int o = 0, nt = 0; for (int e = 0; e < 16; ++e) { off[e] = o; meta[e] = o; const int tl = (cnt[e] + 255) >> 8; for (int i = 0; i < tl; ++i) meta[32 + nt++] = e; o += tl * 256; } off[16] = o; meta[16] = o; meta[17] = o; meta[18] = nt; }
    __syncthreads();
    for (int e = 0; e < 16; ++e) for (int s = off[e] + cnt[e] + tid; s < off[e + 1]; s += 256) { slot_tok[s] = 0; slot_w[s] = 0.f; }
}
__global__ __launch_bounds__(256) void fill(const int* __restrict__ toke, const float* __restrict__ tokw, const int* __restrict__ lrank, const int* __restrict__ blkbase, const int* __restrict__ meta,
                                            int* __restrict__ slot_tok, float* __restrict__ slot_w, int* __restrict__ tokslot) {
    const int i = blockIdx.x * 256 + threadIdx.x;
    const int tkn = i >> 1, e = toke[i], slot = meta[e] + blkbase[(tkn >> 6) * 16 + e] + lrank[i];
    slot_tok[slot] = tkn; slot_w[slot] = tokw[i]; tokslot[i] = slot;
}
__global__ __launch_bounds__(256) void final_(float* X1, const bf16* Y, const int* tokslot, const float* ada, const float* fg) {
    final_row(X1, Y, tokslot, ada, fg, blockIdx.x * 4 + (threadIdx.x >> 6), threadIdx.x & 63);
}
}

namespace pg8 {
#define PG8_LAS __attribute__((address_space(3)))
typedef unsigned short bf16_t;
typedef short bf16x8 __attribute__((ext_vector_type(8)));
typedef float f32x4 __attribute__((ext_vector_type(4)));
typedef unsigned u32x4 __attribute__((ext_vector_type(4)));
constexpr int BM = 256, BK = 64, HALF = 128, HTB = HALF * BK * 2, STAGE_BYTES = 8 * HTB, NXCD = 8, WGM = 8;
__host__ __device__ __forceinline__ int lds_byte(int r, int c) { const int st = (r >> 4) * 2 + (c >> 5), rr = r & 15, cc = c & 31, ob = rr * 64 + cc * 2; return st * 1024 + (ob ^ (((ob >> 9) & 1) << 5)); }
__host__ __device__ __forceinline__ void stage_rc(int b, int& R, int& C) { const int st = b / 1024, sb = b % 1024, swz = sb ^ (((sb >> 9) & 1) << 5); R = (st >> 1) * 16 + swz / 64; C = (st & 1) * 32 + (swz % 64) / 2; }
__host__ __device__ __forceinline__ int perm32(int rho) { const int n = rho >> 4, i = rho & 15; return 8 * (i >> 2) + 4 * n + (i & 3); }

struct Unit { int pm, pn, be; };
struct Gemm { const bf16_t* A; const bf16_t* Bt; int lda, ldb, K; size_t bstride; const int* rowidx; };

struct StaticOrder {
    int nM, nN, nwg, G, c;
    __device__ void init(int M, int N, int G_, int c_) { nM = M / BM; nN = N / BM; nwg = nM * nN; G = G_; c = c_; }
    __device__ bool next(int i, Unit& u) const {
        const long L = (long)i * G + c; if (L >= nwg) return false;
        int wgid = (int)L; { const int q = nwg / NXCD, r = nwg % NXCD, xcd = wgid % NXCD, off = wgid / NXCD; wgid = (xcd < r ? xcd * (q + 1) : r * (q + 1) + (xcd - r) * q) + off; }
        const int nig = WGM * nN, gid = wgid / nig, fm = gid * WGM, gsz = (nM - fm) < WGM ? (nM - fm) : WGM;
        u.pm = fm + ((wgid % nig) % gsz); u.pn = (wgid % nig) / gsz; u.be = 0; return true;
    }
};
struct OneUnit { Unit u0; __device__ bool next(int i, Unit& u) const { if (i) return false; u = u0; return true; } };
struct DynOrder { int nunits, nN, G, c; const PG8_LAS int* tile_e;
    __device__ bool next(int i, Unit& u) const { const int L = i * G + c; if (L >= nunits) return false; u.pm = L / nN; u.pn = L % nN; u.be = tile_e[u.pm]; return true; } };

__device__ __forceinline__ unsigned cvt_pk_bf16(float lo, float hi) { unsigned r; asm volatile("v_cvt_pk_bf16_f32 %0, %1, %2" : "=v"(r) : "v"(lo), "v"(hi)); return r; }
__device__ __forceinline__ u32x4 pack8(f32x4 v0, f32x4 v1) { u32x4 w; w.x = cvt_pk_bf16(v0[0], v0[1]); w.y = cvt_pk_bf16(v0[2], v0[3]); w.z = cvt_pk_bf16(v1[0], v1[1]); w.w = cvt_pk_bf16(v1[2], v1[3]); return w; }

struct EpProj { static constexpr bool PERM = true; bf16_t* O;
    __device__ __forceinline__ void operator()(const f32x4 (&acc)[2][2][4][2], const Unit& u, int wr, int wc, int fr, int fq) const {
        const int row0 = u.pm * BM + wr * 64 + fr, col0 = u.pn * BM + wc * 32 + 8 * fq; const int mode = u.pn < 4 ? 0 : (u.pn < 10 ? 1 : 2);
#pragma unroll
        for (int ai = 0; ai < 2; ++ai)
#pragma unroll
            for (int m = 0; m < 4; ++m) { bf16_t* rowp = O + (size_t)(row0 + ai * HALF + m * 16) * NPROJ + col0;
#pragma unroll
                for (int bj = 0; bj < 2; ++bj) { f32x4 v0 = acc[ai][bj][m][0], v1 = acc[ai][bj][m][1];
                    if (mode == 0) { v0 = v0 * C2; v1 = v1 * C2; }
                    else if (mode == 2) {
#pragma unroll
                        for (int i = 0; i < 4; ++i) { v0[i] = sigmoid_fast(v0[i]); v1[i] = sigmoid_fast(v1[i]); } }
                    *(u32x4*)(rowp + bj * HALF) = pack8(v0, v1); } }
    } };
struct EpPoolMix { static constexpr bool PERM = true; bf16_t* O; const float* pool_scale;
    __device__ __forceinline__ void operator()(const f32x4 (&acc)[2][2][4][2], const Unit& u, int wr, int wc, int fr, int fq) const {
        const int row0 = u.pm * BM + wr * 64 + fr, col0 = u.be * 256 + wc * 32 + 8 * fq;
        f32x4 sc[2][2];
#pragma unroll
        for (int bj = 0; bj < 2; ++bj)
#pragma unroll
            for (int n = 0; n < 2; ++n) sc[bj][n] = *(const f32x4*)(pool_scale + col0 + bj * HALF + 4 * n);
#pragma unroll
        for (int ai = 0; ai < 2; ++ai)
#pragma unroll
            for (int m = 0; m < 4; ++m) { bf16_t* rowp = O + (size_t)(row0 + ai * HALF + m * 16) * D + col0;
#pragma unroll
                for (int bj = 0; bj < 2; ++bj) *(u32x4*)(rowp + bj * HALF) = pack8(acc[ai][bj][m][0] * sc[bj][0], acc[ai][bj][m][1] * sc[bj][1]); }
    } };
__device__ __forceinline__ void unpack8(u32x4 w, f32x4& a, f32x4& b) { a[0] = bflo(w.x); a[1] = bfhi(w.x); a[2] = bflo(w.y); a[3] = bfhi(w.y); b[0] = bflo(w.z); b[1] = bfhi(w.z); b[2] = bflo(w.w); b[3] = bfhi(w.w); }
struct EpT1 { static constexpr bool PERM = true; bf16_t* T1; const bf16_t* P;
    __device__ __forceinline__ void operator()(const f32x4 (&acc)[2][2][4][2], const Unit& u, int wr, int wc, int fr, int fq) const {
        const int row0 = u.pm * BM + wr * 64 + fr, col0 = u.pn * BM + wc * 32 + 8 * fq;
#pragma unroll
        for (int ai = 0; ai < 2; ++ai)
#pragma unroll
            for (int m = 0; m < 4; ++m) { const size_t r = (size_t)(row0 + ai * HALF + m * 16);
#pragma unroll
                for (int bj = 0; bj < 2; ++bj) { const u32x4 gw = *(const u32x4*)(P + r * NPROJ + C_GP + col0 + bj * HALF); f32x4 g0, g1; unpack8(gw, g0, g1);
                    *(u32x4*)(T1 + r * D + col0 + bj * HALF) = pack8(acc[ai][bj][m][0] * g0, acc[ai][bj][m][1] * g1); } }
    } };
struct EpMerged { static constexpr bool PERM = true; bf16_t* T1; const bf16_t* P;
    __device__ __forceinline__ void operator()(const f32x4 (&acc)[2][2][4][2], const Unit& u, int wr, int wc, int fr, int fq) const {
        const int row0 = u.pm * BM + wr * 64 + fr, col0 = u.pn * BM + wc * 32 + 8 * fq;
#pragma unroll
        for (int ai = 0; ai < 2; ++ai)
#pragma unroll
            for (int m = 0; m < 4; ++m) { const size_t r = (size_t)(row0 + ai * HALF + m * 16);
#pragma unroll
                for (int bj = 0; bj < 2; ++bj) { const u32x4 gw = *(const u32x4*)(P + r * NPROJ + C_GA + col0 + bj * HALF); f32x4 g0, g1; unpack8(gw, g0, g1);
                    bf16_t* tp = T1 + r * D + col0 + bj * HALF; const u32x4 tw = *(const u32x4*)tp; f32x4 t0, t1; unpack8(tw, t0, t1);
                    *(u32x4*)tp = pack8(acc[ai][bj][m][0] * g0 + t0, acc[ai][bj][m][1] * g1 + t1); } }
    } };
struct EpX1 { static constexpr bool PERM = false; const float* x; float* X1; const float* ada; float* SSQ;
    __device__ __forceinline__ void operator()(const f32x4 (&acc)[2][2][4][2], const Unit& u, int wr, int wc, int fr, int fq) const {
        const int row0 = u.pm * BM + wr * 64 + fr, col0 = u.pn * BM + wc * 32 + 4 * fq; const float* g1 = ada + (size_t)(u.pm >> 5) * NADA + 2 * D;
        f32x4 gv[2][2];
#pragma unroll
        for (int bj = 0; bj < 2; ++bj)
#pragma unroll
            for (int n = 0; n < 2; ++n) gv[bj][n] = *(const f32x4*)(g1 + col0 + bj * HALF + n * 16);
#pragma unroll
        for (int ai = 0; ai < 2; ++ai)
#pragma unroll
            for (int m = 0; m < 4; ++m) { const size_t r = (size_t)(row0 + ai * HALF + m * 16); float s = 0.f;
#pragma unroll
                for (int bj = 0; bj < 2; ++bj)
#pragma unroll
                    for (int n = 0; n < 2; ++n) { const size_t o = r * D + col0 + bj * HALF + n * 16; const f32x4 xv = *(const f32x4*)(x + o); const f32x4 v = xv + gv[bj][n] * acc[ai][bj][m][n];
                        *(f32x4*)(X1 + o) = v; s += (v[0] * v[0] + v[1] * v[1]) + (v[2] * v[2] + v[3] * v[3]); }
                s += __shfl_xor(s, 16); s += __shfl_xor(s, 32);
                if (fq == 0) SSQ[r * 32 + u.pn * 4 + wc] = s; }
    } };
struct EpAct { static constexpr bool PERM = true; bf16_t* ACT; const float* slot_w;
    __device__ __forceinline__ void operator()(const f32x4 (&acc)[2][2][4][2], const Unit& u, int wr, int wc, int fr, int fq) const {
        const int row0 = u.pm * BM + wr * 64 + fr, col0 = u.pn * HALF + wc * 32 + 8 * fq;
#pragma unroll
        for (int ai = 0; ai < 2; ++ai)
#pragma unroll
            for (int m = 0; m < 4; ++m) { const size_t r = (size_t)(row0 + ai * HALF + m * 16); const float w = slot_w[r]; f32x4 o[2];
#pragma unroll
                for (int n = 0; n < 2; ++n)
#pragma unroll
                    for (int i = 0; i < 4; ++i) { const float g = acc[ai][0][m][n][i], uu = acc[ai][1][m][n][i]; o[n][i] = g * sigmoid_fast(g) * uu * w; }
                *(u32x4*)(ACT + r * FF + col0) = pack8(o[0], o[1]); }
    } };
struct EpY { static constexpr bool PERM = true; bf16_t* Y;
    __device__ __forceinline__ void operator()(const f32x4 (&acc)[2][2][4][2], const Unit& u, int wr, int wc, int fr, int fq) const {
        const int row0 = u.pm * BM + wr * 64 + fr, col0 = u.pn * BM + wc * 32 + 8 * fq;
#pragma unroll
        for (int ai = 0; ai < 2; ++ai)
#pragma unroll
            for (int m = 0; m < 4; ++m) { bf16_t* rowp = Y + (size_t)(row0 + ai * HALF + m * 16) * D + col0;
#pragma unroll
                for (int bj = 0; bj < 2; ++bj) *(u32x4*)(rowp + bj * HALF) = pack8(acc[ai][bj][m][0], acc[ai][bj][m][1]); }
    } };

template <class Epi, class Sched, bool GATHER>
__device__ __forceinline__ void gemm_phase(PG8_LAS unsigned char* lds, const Gemm g, const Sched& S, const Epi& E) {
    const int tid = threadIdx.x, wid = __builtin_amdgcn_readfirstlane(tid >> 6), lane = tid & 63, wr = wid >> 2, wc = wid & 3, fr = lane & 15, fq = lane >> 4;
    int K = g.K; asm volatile("" : "+s"(K));
    const int nt = K / BK;
    int sR[2], sC[2]; unsigned voB[2], voA[2][2], voN[2][2];
#pragma unroll
    for (int i = 0; i < 2; ++i) { int R, C; stage_rc(tid * 16 + i * 8192, R, C); sR[i] = R; sC[i] = C; const int Rb = Epi::PERM ? ((R & ~31) + perm32(R & 31)) : R;
        voB[i] = (unsigned)(Rb * g.ldb + C) * 2u;
#pragma unroll
        for (int h = 0; h < 2; ++h) { voA[h][i] = (unsigned)((h * HALF + R) * g.lda + C) * 2u; voN[h][i] = voA[h][i]; } }
    const size_t kstep = (size_t)(BK * 2);
    const size_t hstepB = (size_t)HALF * g.ldb * 2, tstepA = (size_t)BM * g.lda * 2, tstepB = (size_t)BM * g.ldb * 2;
    const unsigned ldsw = (unsigned)wid * 1024u;
    const int aoff = lds_byte(wr * 64 + fr, fq * 8), boff = lds_byte(wc * 32 + fr, fq * 8);
#define PG8_SA(b, h) (((b) * 2 + (h)) * HTB)
#define PG8_SB(b, h) ((4 + (b) * 2 + (h)) * HTB)
#define PG8_STAGE(bufoff, gbase, voff) do { _Pragma("unroll") for (int _i = 0; _i < 2; ++_i) \
        __builtin_amdgcn_global_load_lds((const unsigned*)((const char*)(gbase) + (voff)[_i]), (PG8_LAS unsigned*)(lds + (bufoff) + ldsw + _i * 8192), 16, 0, 0); } while (0)
#define PG8_LDA(dst, b, h) do { _Pragma("unroll") for (int m = 0; m < 4; ++m) _Pragma("unroll") for (int k = 0; k < 2; ++k) dst[m][k] = *(const PG8_LAS bf16x8*)(lds + PG8_SA(b, h) + aoff + m * 2048 + k * 1024); } while (0)
#define PG8_LDB(dst, b, h) do { _Pragma("unroll") for (int n = 0; n < 2; ++n) _Pragma("unroll") for (int k = 0; k < 2; ++k) dst[n][k] = *(const PG8_LAS bf16x8*)(lds + PG8_SB(b, h) + boff + n * 2048 + k * 1024); } while (0)
#define PG8_MMA(ai, bj, At, Bt) do { __builtin_amdgcn_s_setprio(1); _Pragma("unroll") for (int m = 0; m < 4; ++m) _Pragma("unroll") for (int n = 0; n < 2; ++n) _Pragma("unroll") for (int k = 0; k < 2; ++k) \
        acc[ai][bj][m][n] = __builtin_amdgcn_mfma_f32_16x16x32_bf16(Bt[n][k], At[m][k], acc[ai][bj][m][n], 0, 0, 0); __builtin_amdgcn_s_setprio(0); } while (0)
#define PG8_WAIT_V(n) asm volatile("s_waitcnt vmcnt(" #n ")" ::: "memory")
#define PG8_WAIT_L(n) asm volatile("s_waitcnt lgkmcnt(" #n ")" ::: "memory")
#define PG8_BAR __builtin_amdgcn_s_barrier()
#define PG8_SCHED __builtin_amdgcn_sched_barrier(0)
#define PG8_GATHER_OFFS(dst, pm_) do { _Pragma("unroll") for (int _h = 0; _h < 2; ++_h) _Pragma("unroll") for (int _i = 0; _i < 2; ++_i) \
        dst[_h][_i] = (unsigned)(g.rowidx[(pm_) * BM + _h * HALF + sR[_i]] * g.lda + sC[_i]) * 2u; \
        __builtin_amdgcn_s_waitcnt(0x0F70); _Pragma("unroll") for (int _h = 0; _h < 2; ++_h) _Pragma("unroll") for (int _i = 0; _i < 2; ++_i) asm volatile("" : "+v"(dst[_h][_i])); } while (0)
    Unit cur, nxt; int ui = 0;
    if (!S.next(0, cur)) return;
    f32x4 acc[2][2][4][2];
#pragma unroll
    for (int a = 0; a < 2; ++a)
#pragma unroll
        for (int b = 0; b < 2; ++b)
#pragma unroll
            for (int m = 0; m < 4; ++m)
#pragma unroll
                for (int n = 0; n < 2; ++n) acc[a][b][m][n] = (f32x4){0.f, 0.f, 0.f, 0.f};
    bf16x8 At[4][2], B0[2][2], B1[2][2];
    const char* cA = (const char*)g.A + (GATHER ? (size_t)0 : (size_t)cur.pm * tstepA);
    const char* cB = (const char*)g.Bt + ((size_t)cur.be * g.bstride) * 2 + (size_t)cur.pn * tstepB;
    if constexpr (GATHER) PG8_GATHER_OFFS(voA, cur.pm);
    PG8_STAGE(PG8_SB(0, 0), cB, voB); PG8_STAGE(PG8_SB(0, 1), cB + hstepB, voB); PG8_STAGE(PG8_SA(0, 0), cA, voA[0]); PG8_STAGE(PG8_SA(0, 1), cA, voA[1]);
    if (wr == 1) PG8_BAR;
    PG8_WAIT_V(2); PG8_BAR;
    PG8_STAGE(PG8_SB(1, 0), cB + kstep, voB); PG8_STAGE(PG8_SA(1, 0), cA + kstep, voA[0]); PG8_STAGE(PG8_SB(1, 1), cB + hstepB + kstep, voB);
    PG8_WAIT_V(6); PG8_BAR;
    for (;;) {
        const bool has_next = S.next(ui + 1, nxt);
        const char* nA = has_next ? (const char*)g.A + (GATHER ? (size_t)0 : (size_t)nxt.pm * tstepA) : cA;
        const char* nB = has_next ? (const char*)g.Bt + ((size_t)nxt.be * g.bstride) * 2 + (size_t)nxt.pn * tstepB : cB;
        if constexpr (GATHER) { if (has_next) PG8_GATHER_OFFS(voN, nxt.pm); else {
#pragma unroll
            for (int h = 0; h < 2; ++h)
#pragma unroll
                for (int i = 0; i < 2; ++i) voN[h][i] = voA[h][i]; } }
        for (int t = 0; t < nt; t += 2) {
            const bool last = (t == nt - 2);
            const char* a1 = cA + (size_t)(t + 1) * kstep;
            const char* a2 = last ? nA : cA + (size_t)(t + 2) * kstep; const char* b2 = last ? nB : cB + (size_t)(t + 2) * kstep;
            const char* a3 = a2 + kstep; const char* b3 = b2 + kstep;
            unsigned vo2[2][2];
#pragma unroll
            for (int h = 0; h < 2; ++h)
#pragma unroll
                for (int i = 0; i < 2; ++i) vo2[h][i] = (GATHER && last) ? voN[h][i] : voA[h][i];
            PG8_LDB(B0, 0, 0); PG8_LDB(B1, 0, 1); PG8_SCHED; PG8_LDA(At, 0, 0); PG8_STAGE(PG8_SA(1, 1), a1, voA[1]);
            PG8_WAIT_V(8); PG8_WAIT_L(0); PG8_BAR; PG8_MMA(0, 0, At, B0); PG8_MMA(0, 1, At, B1); PG8_BAR; PG8_SCHED;
            PG8_LDA(At, 0, 1); PG8_STAGE(PG8_SB(0, 0), b2, voB); PG8_STAGE(PG8_SB(0, 1), b2 + hstepB, voB); PG8_STAGE(PG8_SA(0, 0), a2, vo2[0]);
            PG8_WAIT_V(8); PG8_WAIT_L(0); PG8_BAR; PG8_MMA(1, 0, At, B0); PG8_MMA(1, 1, At, B1); PG8_BAR; PG8_SCHED;
            PG8_LDB(B0, 1, 0); PG8_LDB(B1, 1, 1); PG8_SCHED; PG8_LDA(At, 1, 0); PG8_STAGE(PG8_SA(0, 1), a2, vo2[1]);
            PG8_WAIT_V(8); PG8_WAIT_L(0); PG8_BAR; PG8_MMA(0, 0, At, B0); PG8_MMA(0, 1, At, B1); PG8_BAR; PG8_SCHED;
            PG8_LDA(At, 1, 1); PG8_STAGE(PG8_SB(1, 0), b3, voB); PG8_STAGE(PG8_SB(1, 1), b3 + hstepB, voB); PG8_STAGE(PG8_SA(1, 0), a3, vo2[0]);
            PG8_WAIT_V(8); PG8_WAIT_L(0); PG8_BAR; PG8_MMA(1, 0, At, B0); PG8_MMA(1, 1, At, B1); PG8_BAR; PG8_SCHED;
        }
        if (wr == 0) PG8_BAR;
        E(acc, cur, wr, wc, fr, fq);
        if (!has_next) break;
#pragma unroll
        for (int a = 0; a < 2; ++a)
#pragma unroll
            for (int b = 0; b < 2; ++b)
#pragma unroll
                for (int m = 0; m < 4; ++m)
#pragma unroll
                    for (int n = 0; n < 2; ++n) acc[a][b][m][n] = (f32x4){0.f, 0.f, 0.f, 0.f};
        cur = nxt; cA = nA; cB = nB; ++ui;
        if constexpr (GATHER) {
#pragma unroll
            for (int h = 0; h < 2; ++h)
#pragma unroll
                for (int i = 0; i < 2; ++i) voA[h][i] = voN[h][i]; }
        if (wr == 1) PG8_BAR;
    }
    PG8_WAIT_V(0);
    PG8_BAR;
#undef PG8_SA
#undef PG8_SB
#undef PG8_STAGE
#undef PG8_LDA
#undef PG8_LDB
#undef PG8_MMA
#undef PG8_WAIT_V
#undef PG8_WAIT_L
#undef PG8_BAR
#undef PG8_SCHED
#undef PG8_GATHER_OFFS
}
}

#define GAS __attribute__((address_space(1)))
#define LAS __attribute__((address_space(3)))
typedef unsigned v4u __attribute__((ext_vector_type(4)));
typedef unsigned v2u __attribute__((ext_vector_type(2)));
typedef float f32x4 __attribute__((ext_vector_type(4)));
typedef float f32x16 __attribute__((ext_vector_type(16)));
typedef short bf16x8 __attribute__((ext_vector_type(8)));
typedef short s16x4 __attribute__((ext_vector_type(4)));
typedef GAS unsigned gu32;
#define RLX_AGENT __ATOMIC_RELAXED, __HIP_MEMORY_SCOPE_AGENT
#define LDS_WAIT() asm volatile("s_waitcnt lgkmcnt(0)" ::: "memory")
#define VM_WAIT() asm volatile("s_waitcnt vmcnt(0)" ::: "memory")
constexpr int NWAVES = 8;
constexpr int RING_OFF = 0, RING_BYTES = 131072;
constexpr int LDSCTL_OFF = RING_BYTES;
constexpr int MISC_OFF = LDSCTL_OFF + 64;
constexpr int LMETA_OFF = LDSCTL_OFF + 256;
constexpr int LDS_BYTES = 147456;
constexpr int CW_TMO = 0, CW_BAR = 4096;

#define XB_TMO      128
#define XB_XCNT(j)  (256  + 64 * (j))
#define XB_XSUB(j)  (1280 + 64 * (j))
#define XB_XGEN(j)  (2304 + 64 * (j))
#define XB_TOP      3328
#define XB_TOPGEN   3392
#define XCD_BAR_WORDS 3456
#define XB_SPIN_CAP (1u << 18)
__device__ __forceinline__ unsigned xb_ld(unsigned* p)              { return __hip_atomic_load(p, __ATOMIC_RELAXED, __HIP_MEMORY_SCOPE_AGENT); }
__device__ __forceinline__ unsigned xb_add(unsigned* p, unsigned v) { return __hip_atomic_fetch_add(p, v, __ATOMIC_RELAXED, __HIP_MEMORY_SCOPE_AGENT); }
__device__ __forceinline__ unsigned xb_xcc_id() { return (unsigned)__builtin_amdgcn_s_getreg((3 << 11) | 20) & 0xFu; }
#define XB_SPIN(cond, bar) do { unsigned _sp = 0; while (cond) { __builtin_amdgcn_s_sleep(1); \
    if ((++_sp & 255u) == 0u) { if (xb_ld(&(bar)[XB_TMO])) break; if (_sp > XB_SPIN_CAP) { atomicAdd(&(bar)[XB_TMO], 1u); break; } } } } while (0)
struct XcdBarrier { unsigned* bar; unsigned x; volatile LAS unsigned* st; };
__device__ __forceinline__ XcdBarrier xcd_barrier_post(unsigned* bar, volatile LAS unsigned* st) {
    XcdBarrier b; b.bar = bar; b.x = xb_xcc_id(); b.st = st;
    if (threadIdx.x == 0) (void)xb_add(&bar[XB_XCNT(b.x)], 1u);
    return b;
}
__device__ __forceinline__ void xcd_barrier_complete(unsigned* bar, unsigned x, unsigned& nloc, unsigned& nx) {
    const unsigned G = gridDim.x * gridDim.y * gridDim.z;
    unsigned sum, cnt, mine, sp = 0u;
    for (;;) {
        sum = 0u; cnt = 0u; mine = 0u;
#pragma unroll
        for (unsigned j = 0; j < 16; ++j) { const unsigned c = xb_ld(&bar[XB_XCNT(j)]); sum += c; cnt += (c > 0u) ? 1u : 0u; mine = (j == x) ? c : mine; }
        if (sum == G) break;
        __builtin_amdgcn_s_sleep(1);
        if ((++sp & 255u) == 0u) { if (xb_ld(&bar[XB_TMO])) break; if (sp > XB_SPIN_CAP) { atomicAdd(&bar[XB_TMO], 1u); break; } }
    }
    nloc = mine > 0u ? mine : 1u; nx = cnt > 0u ? cnt : 1u;
}
__device__ __forceinline__ void xcd_barrier(const XcdBarrier& b) {
    asm volatile("s_waitcnt vmcnt(0)" ::: "memory");
    __syncthreads();
    if (threadIdx.x == 0) {
        unsigned* bar = b.bar;
        __builtin_amdgcn_s_waitcnt(0);
        unsigned nloc = b.st[0], nx = b.st[1];
        if (nloc == 0u) { xcd_barrier_complete(bar, b.x, nloc, nx); b.st[0] = nloc; b.st[1] = nx; }
        const unsigned old = xb_add(&bar[XB_XSUB(b.x)], 1u);
        const unsigned gen = old / nloc;
        if (old + 1u == (gen + 1u) * nloc) {
            __builtin_amdgcn_fence(__ATOMIC_RELEASE, "agent");
            asm volatile("s_waitcnt vmcnt(0)" ::: "memory");
            const unsigned og = xb_add(&bar[XB_TOP], 1u);
            const unsigned tg = og / nx;
            if (og + 1u == (tg + 1u) * nx) xb_add(&bar[XB_TOPGEN], 1u);
            else XB_SPIN(xb_ld(&bar[XB_TOPGEN]) == tg, bar);
            __builtin_amdgcn_fence(__ATOMIC_ACQUIRE, "agent");
            xb_add(&bar[XB_XGEN(b.x)], 1u);
            asm volatile("s_waitcnt vmcnt(0)" ::: "memory");
        } else {
            XB_SPIN(xb_ld(&bar[XB_XGEN(b.x)]) == gen, bar);
            __builtin_amdgcn_fence(__ATOMIC_ACQUIRE, "agent");
            asm volatile("s_waitcnt vmcnt(0)" ::: "memory");
        }
    }
    __syncthreads();
}

struct Args { const float* in[21]; float* out; unsigned char* ws; int ph_lo, ph_hi; };
struct Frame {
    LAS unsigned char* lds; volatile LAS unsigned* MISC; LAS int* LM; gu32* ctl;
    int tid, lane, wave, vcu, G;
    const float *x, *c, *w_ada, *b_ada, *g1, *w_in, *sinks, *w_pool, *pool_scale, *w_ab, *w_pb, *w_out, *g2, *w_rg, *b_rg, *w_re, *b_re, *w_eg, *w_eu, *w_ed, *fg;
    float* out; unsigned char* ws;
};

__device__ __forceinline__ unsigned pk2(float lo, float hi) { return f2bf(lo) | (f2bf(hi) << 16); }
__device__ __forceinline__ void p0_transpose_item(const float* W, int N, bf16* WT, int dpitch, int drow0, int k0, int n0, LAS float* scr, int lane) {
#pragma unroll 8
    for (int i = 0; i < 32; ++i) { const int kk = 2 * i + (lane >> 5); scr[kk * 33 + (lane & 31)] = W[(size_t)(k0 + kk) * N + n0 + (lane & 31)]; }
    LDS_WAIT(); asm volatile("" ::: "memory");
    const int c = lane & 7;
#pragma unroll
    for (int j = 0; j < 4; ++j) { const int n = (lane >> 3) + 8 * j; const LAS float* s = scr + (8 * c) * 33 + n;
        v4u o; o.x = pk2(s[0 * 33], s[1 * 33]); o.y = pk2(s[2 * 33], s[3 * 33]); o.z = pk2(s[4 * 33], s[5 * 33]); o.w = pk2(s[6 * 33], s[7 * 33]);
        *(GAS v4u*)(WT + (size_t)(drow0 + n) * dpitch + k0 + 8 * c) = o; }
    LDS_WAIT(); asm volatile("" ::: "memory");
}
__device__ __forceinline__ void p0_prologue(Frame& F) {
    LAS float* scr = (LAS float*)(F.lds + RING_OFF + F.wave * 16384);
    const int gw = F.vcu * NWAVES + F.wave, NGW = F.G * NWAVES, lane = F.lane;
    float* ADAP = (float*)(F.ws + WS_ADAP);
    for (int task = gw; task < ADA_SL * 48; task += NGW) { const int ks = task / 48, j = (task % 48) * 256 + 4 * lane; constexpr int KS = D / ADA_SL;
        f32x4 a0 = {0.f, 0.f, 0.f, 0.f}, a1 = {0.f, 0.f, 0.f, 0.f};
#pragma unroll 8
        for (int k = ks * KS; k < ks * KS + KS; ++k) { const f32x4 w = *(const f32x4*)(F.w_ada + (size_t)k * NADA + j); a0 += w * F.c[k]; a1 += w * F.c[D + k]; }
        *(f32x4*)(ADAP + ((size_t)ks * 2 + 0) * NADA + j) = a0; *(f32x4*)(ADAP + ((size_t)ks * 2 + 1) * NADA + j) = a1; }
    constexpr int I_IN = (D / 64) * (NPROJ / 32), I_BR = (1024 / 64) * (D / 32), I_OUT = (D / 64) * (D / 32), I_POOL = 4 * (256 / 64) * (256 / 32);
    constexpr int I_GE = (D / 64) * (FF / 32), I_DN = (FF / 64) * (D / 32);
    constexpr int NITEMS = I_IN + 2 * I_BR + I_OUT + I_POOL + NEXP * (2 * I_GE + I_DN);
    bf16* WIN = (bf16*)(F.ws + WS_WIN); bf16* WPB = (bf16*)(F.ws + WS_WPB); bf16* WAB = (bf16*)(F.ws + WS_WAB); bf16* WOUT = (bf16*)(F.ws + WS_WOUT);
    bf16* WPOOL = (bf16*)(F.ws + WS_WPOOL); bf16* WGU = (bf16*)(F.ws + WS_WGU); bf16* WDN = (bf16*)(F.ws + WS_WDN);
    for (int it = gw; it < NITEMS; it += NGW) {
        int r = it;
        if (r < I_IN) { const int nb = NPROJ / 32, k0 = 64 * (r / nb), n0 = 32 * (r % nb); p0_transpose_item(F.w_in, NPROJ, WIN, D, n0, k0, n0, scr, lane); continue; } r -= I_IN;
        if (r < I_BR) { const int nb = D / 32, k0 = 64 * (r / nb), n0 = 32 * (r % nb); p0_transpose_item(F.w_pb, D, WPB, 1024, n0, k0, n0, scr, lane); continue; } r -= I_BR;
        if (r < I_BR) { const int nb = D / 32, k0 = 64 * (r / nb), n0 = 32 * (r % nb); p0_transpose_item(F.w_ab, D, WAB, 1024, n0, k0, n0, scr, lane); continue; } r -= I_BR;
        if (r < I_OUT) { const int nb = D / 32, k0 = 64 * (r / nb), n0 = 32 * (r % nb); p0_transpose_item(F.w_out, D, WOUT, D, n0, k0, n0, scr, lane); continue; } r -= I_OUT;
        if (r < I_POOL) { const int g = r / 32, q = r % 32, k0 = 64 * (q / 8), n0 = 32 * (q % 8); p0_transpose_item(F.w_pool + (size_t)g * 65536, 256, WPOOL + (size_t)g * 65536, 256, n0, k0, n0, scr, lane); continue; } r -= I_POOL;
        if (r < NEXP * I_GE) { const int e = r / I_GE, q = r % I_GE, nb = FF / 32, k0 = 64 * (q / nb), n0 = 32 * (q % nb);
            p0_transpose_item(F.w_eg + (size_t)e * D * FF, FF, WGU + (size_t)e * 1024 * D, D, (n0 >> 7) * 256 + (n0 & 127), k0, n0, scr, lane); continue; } r -= NEXP * I_GE;
        if (r < NEXP * I_GE) { const int e = r / I_GE, q = r % I_GE, nb = FF / 32, k0 = 64 * (q / nb), n0 = 32 * (q % nb);
            p0_transpose_item(F.w_eu + (size_t)e * D * FF, FF, WGU + (size_t)e * 1024 * D, D, (n0 >> 7) * 256 + 128 + (n0 & 127), k0, n0, scr, lane); continue; } r -= NEXP * I_GE;
        { const int e = r / I_DN, q = r % I_DN, nb = D / 32, k0 = 64 * (q / nb), n0 = 32 * (q % nb);
            p0_transpose_item(F.w_ed + (size_t)e * FF * D, D, WDN + (size_t)e * D * FF, FF, n0, k0, n0, scr, lane); }
    }
}
__device__ __forceinline__ void p0b_h1(Frame& F) {
    const float* ADAP = (const float*)(F.ws + WS_ADAP); float* ADA = (float*)(F.ws + WS_ADA); bf16* H1 = (bf16*)(F.ws + WS_B);
    LAS float* gsL = (LAS float*)(F.lds + RING_OFF);
    LAS float* shL = gsL + 2 * D;
    for (int i = F.tid; i < 2 * D; i += NWAVES * 64) { const int b = i / D, d = i % D; float sh = F.b_ada[d], sc = F.b_ada[D + d];
#pragma unroll 4
        for (int ks = 0; ks < ADA_SL; ++ks) { sh += ADAP[((size_t)ks * 2 + b) * NADA + d]; sc += ADAP[((size_t)ks * 2 + b) * NADA + D + d]; }
        gsL[i] = F.g1[d] * (1.f + sc); shL[i] = sh; }
    { const int i = F.vcu * (NWAVES * 64) + F.tid; if (i < 2 * NADA) { const int b = i / NADA, j = i % NADA; float s = F.b_ada[j];
        for (int ks = 0; ks < ADA_SL; ++ks) s += ADAP[((size_t)ks * 2 + b) * NADA + j]; ADA[i] = s; } }
    LDS_WAIT(); __syncthreads();
    const int gw = F.vcu * NWAVES + F.wave, NGW = F.G * NWAVES, lane = F.lane;
    for (int row = gw; row < T; row += NGW) { const int b = row / SEQ;
        const GAS f32x4* xr = (const GAS f32x4*)(F.x + (size_t)row * D) + lane;
        f32x4 v[8]; float ss = 0.f;
#pragma unroll
        for (int j = 0; j < 8; ++j) { v[j] = xr[64 * j]; ss += (v[j].x * v[j].x + v[j].y * v[j].y) + (v[j].z * v[j].z + v[j].w * v[j].w); }
        const float rstd = rsqrtf(wave_sum(ss) * (1.0f / D) + EPS);
#pragma unroll
        for (int j = 0; j < 8; ++j) { const int d = 4 * lane + 256 * j; const f32x4 gs = *(const LAS f32x4*)(gsL + b * D + d), sh = *(const LAS f32x4*)(shL + b * D + d);
            const f32x4 o = v[j] * rstd * gs + sh; v2u w; w.x = pk2(o.x, o.y); w.y = pk2(o.z, o.w);
            *(GAS v2u*)(H1 + (size_t)row * D + d) = w; } }
    __syncthreads();
}

constexpr int AT_K = 0, AT_V = 24576, AT_WS = 49152, AT_OST = AT_WS + 2048, AT_BYTES = AT_OST + 32768;
__device__ __forceinline__ int crow(int r, int hi) { return (r & 3) + 8 * (r >> 2) + 4 * hi; }
__device__ __forceinline__ unsigned cvtpk_s(float lo, float hi) { typedef float f32x2_t __attribute__((ext_vector_type(2))); typedef __bf16 bf16x2_t __attribute__((ext_vector_type(2)));
    f32x2_t v = {lo, hi}; bf16x2_t b = __builtin_convertvector(v, bf16x2_t); return __builtin_bit_cast(unsigned, b); }
typedef short v4i16_t __attribute__((ext_vector_type(4)));
__device__ __forceinline__ s16x4 vtr(LAS const unsigned char* p) { return __builtin_bit_cast(s16x4, __builtin_amdgcn_ds_read_tr16_b64_v4i16((LAS v4i16_t*)p)); }
__device__ __forceinline__ void attn_unit(Frame& F, int unit) {
    const bf16* P = (const bf16*)(F.ws + WS_PROJ); bf16* AP = (bf16*)(F.ws + WS_B);
    const int tid = F.tid, lane = F.lane, wid = F.wave, r32 = lane & 31, hi = lane >> 5;
    const int qb = unit & 127, kvh = (unit >> 7) & 3, b = unit >> 9, q0 = qb * 64;
    LAS unsigned char* L = F.lds + RING_OFF;
    { const int key = tid >> 3, ch = tid & 7;
        v4u kv[3], vv[3];
#pragma unroll
        for (int t = 0; t < 3; ++t) { int kpos = q0 - 128 + 64 * t + key; if (kpos < 0) kpos = 0;
            const bf16* rp = P + ((size_t)b * SEQ + kpos) * NPROJ + kvh * 64 + ch * 8;
            kv[t] = *(const GAS v4u*)(rp + C_K); vv[t] = *(const GAS v4u*)(rp + C_V); }
#pragma unroll
        for (int t = 0; t < 3; ++t) {
            *(LAS v4u*)(L + AT_K + t * 8192 + ch * 1024 + key * 16) = kv[t];
            *(LAS v4u*)(L + AT_V + t * 8192 + ((ch >> 2) * 4 + (key >> 4)) * 1024 + (key & 15) * 64 + (ch & 3) * 16) = vv[t]; } }
    const int hq = kvh * 4 + (wid & 3), rh = wid >> 2;
    const size_t qrow = (size_t)b * SEQ + q0 + 32 * rh + r32;
    bf16x8 qr[4];
#pragma unroll
    for (int d0 = 0; d0 < 4; ++d0) qr[d0] = *(const GAS bf16x8*)(P + qrow * NPROJ + C_Q + hq * 64 + d0 * 16 + hi * 8);
    const float sink2 = F.sinks[hq] * LOG2E;
    LDS_WAIT(); __syncthreads();
    f32x16 p[3][2];
#pragma unroll
    for (int t = 0; t < 3; ++t)
#pragma unroll
        for (int hf = 0; hf < 2; ++hf) { f32x16 a = {};
#pragma unroll
            for (int d0 = 0; d0 < 4; ++d0) { const bf16x8 kf = *(const LAS bf16x8*)(L + AT_K + t * 8192 + (2 * d0 + hi) * 1024 + (hf * 32 + r32) * 16);
                a = __builtin_amdgcn_mfma_f32_32x32x16_bf16(kf, qr[d0], a, 0, 0, 0); }
            p[t][hf] = a; }
    float mx = sink2;
#pragma unroll
    for (int t = 0; t < 3; ++t) { const bool tile_ok = (q0 - 128 + 64 * t) >= 0;
#pragma unroll
        for (int hf = 0; hf < 2; ++hf) { const float basef = tile_ok ? (float)(128 + 32 * rh + r32 - 64 * t - 32 * hf - 4 * hi) : 300.0f;
#pragma unroll
            for (int r = 0; r < 16; ++r) { const float x = basef - (float)((r & 3) + 8 * (r >> 2)); const float v = fmaxf(fmaxf(-x, x - 127.0f), 0.0f);
                const float s = __builtin_fmaf(v, -1e30f, p[t][hf][r]); p[t][hf][r] = s; mx = fmaxf(mx, s); } } }
    mx = fmaxf(mx, __shfl_xor(mx, 32));
    float lsum = 0.f;
#pragma unroll
    for (int t = 0; t < 3; ++t)
#pragma unroll
        for (int hf = 0; hf < 2; ++hf)
#pragma unroll
            for (int r = 0; r < 16; ++r) { const float e = __builtin_amdgcn_exp2f(p[t][hf][r] - mx); p[t][hf][r] = e; lsum += e; }
    lsum += __shfl_xor(lsum, 32);
    lsum += __builtin_amdgcn_exp2f(sink2 - mx);
    f32x16 o[2]; o[0] = f32x16{}; o[1] = f32x16{};
    const int vb = AT_V + ((lane >> 4) & 1) * 32 + (lane & 3) * 8 + (4 * hi + ((lane & 15) >> 2)) * 64;
#pragma unroll
    for (int t = 0; t < 3; ++t) {
        v4u pw[4];
#pragma unroll
        for (int ks = 0; ks < 4; ++ks) { const int hf = ks >> 1, rb = (ks & 1) * 8;
            pw[ks].x = cvtpk_s(p[t][hf][rb + 0], p[t][hf][rb + 1]); pw[ks].y = cvtpk_s(p[t][hf][rb + 2], p[t][hf][rb + 3]);
            pw[ks].z = cvtpk_s(p[t][hf][rb + 4], p[t][hf][rb + 5]); pw[ks].w = cvtpk_s(p[t][hf][rb + 6], p[t][hf][rb + 7]); }
#pragma unroll
        for (int d0 = 0; d0 < 2; ++d0)
#pragma unroll
            for (int ks = 0; ks < 4; ++ks) { const s16x4 lo = vtr(L + vb + t * 8192 + d0 * 4096 + ks * 1024), hh = vtr(L + vb + t * 8192 + d0 * 4096 + ks * 1024 + 512);
                const bf16x8 vf = {lo[0], lo[1], lo[2], lo[3], hh[0], hh[1], hh[2], hh[3]};
                o[d0] = __builtin_amdgcn_mfma_f32_32x32x16_bf16(__builtin_bit_cast(bf16x8, pw[ks]), vf, o[d0], 0, 0, 0); }
        __builtin_amdgcn_sched_barrier(0); }
    LAS float* wsf = (LAS float*)(L + AT_WS) + wid * 64;
    if (hi == 0) wsf[r32] = lsum;
    LDS_WAIT();
    LAS bf16* stg = (LAS bf16*)(L + AT_OST) + wid * 2048;
#pragma unroll
    for (int r = 0; r < 16; ++r) { const int orow = crow(r, hi); const float rl = __builtin_amdgcn_rcpf(wsf[orow]);
#pragma unroll
        for (int d0 = 0; d0 < 2; ++d0) stg[orow * 64 + d0 * 32 + r32] = (bf16)f2bf(o[d0][r] * rl); }
    LDS_WAIT();
    bf16* Ow = AP + ((size_t)b * SEQ + q0 + 32 * rh) * D + 1024 + hq * 64;
#pragma unroll
    for (int i = 0; i < 4; ++i) { const int row = i * 8 + (lane >> 3), ch = lane & 7; const v4u v = *(const LAS v4u*)(stg + row * 64 + ch * 8); *(GAS v4u*)(Ow + (size_t)row * D + ch * 8) = v; }
    LDS_WAIT(); __syncthreads();
}
__device__ __forceinline__ void pooled_unit(Frame& F, int pm, int g) {
    const bf16* P = (const bf16*)(F.ws + WS_PROJ); bf16* PO = (bf16*)(F.ws + WS_C);
    const int chq = F.tid & 127, seg = F.tid >> 7, w = 2 << g;
    const int r0 = pm * 256 + seg * 64, t0 = r0 % SEQ;
    const bf16* up = P + C_U + 256 * g + 2 * chq;
    float s0 = 0.f, s1 = 0.f;
    for (int i = 1; i < w; ++i) if (t0 - i >= 0) { const unsigned v = *(const GAS unsigned*)(up + (size_t)(r0 - i) * NPROJ); s0 += bflo(v); s1 += bfhi(v); }
#pragma unroll 4
    for (int i = 0; i < 64; ++i) { const int row = r0 + i, t = t0 + i; const unsigned v = *(const GAS unsigned*)(up + (size_t)row * NPROJ); const float u0 = bflo(v), u1 = bfhi(v);
        s0 += u0; s1 += u1; const float cnt = (float)((t + 1) < w ? (t + 1) : w);
        *(GAS unsigned*)(PO + (size_t)row * 1024 + 256 * g + 2 * chq) = pk2(s0 / cnt - u0, s1 / cnt - u1);
        if (t - w + 1 >= 0) { const unsigned o = *(const GAS unsigned*)(up + (size_t)(row - w + 1) * NPROJ); s0 -= bflo(o); s1 -= bfhi(o); } }
}

__device__ __forceinline__ void p5b_fill(Frame& F) {
    unsigned char* rt = F.ws + WS_RT;
    const int* TOKE = (const int*)(rt + RT_TOKE); const float* TOKW = (const float*)(rt + RT_TOKW); const int* LRANK = (const int*)(rt + RT_LRANK); int* TOKSLOT = (int*)(rt + RT_TOKSLOT);
    const int* BLKCNT = (const int*)(rt + RT_BLKCNT); int* SLOTTOK = (int*)(rt + RT_SLOTTOK); float* SLOTW = (float*)(rt + RT_SLOTW); int* META = (int*)(rt + RT_META);
    LAS int* cntL = (LAS int*)(F.lds + RING_OFF);
    LAS int* totL = cntL + 4096;
    for (int i = F.tid; i < 4096; i += NWAVES * 64) cntL[i] = BLKCNT[i];
    LDS_WAIT(); __syncthreads();
    for (int blk = F.vcu; blk < 256; blk += F.G) {
        { const int e = F.tid >> 5, s = F.tid & 31; int pt = 0, pb = 0;
            for (int bb = 8 * s; bb < 8 * s + 8; ++bb) { const int c = cntL[bb * 16 + e]; pt += c; pb += (bb < blk) ? c : 0; }
#pragma unroll
            for (int o = 1; o < 32; o <<= 1) { pt += __shfl_xor(pt, o); pb += __shfl_xor(pb, o); }
            if (s == 0) { totL[e] = pt; totL[16 + e] = pb; } }
        LDS_WAIT(); __syncthreads();
        if (F.tid == 0) { int o = 0, nt = 0; for (int e = 0; e < 16; ++e) { totL[32 + e] = o; const int tl = (totL[e] + 255) >> 8;
                if (F.vcu == 0 && blk == 0) { META[e] = o; for (int i = 0; i < tl; ++i) META[32 + nt + i] = e; } nt += tl; o += tl * 256; }
            totL[48] = o; if (F.vcu == 0 && blk == 0) { META[16] = o; META[17] = o; META[18] = nt; } }
        LDS_WAIT(); __syncthreads();
        if (F.tid < 128) { const int i = blk * 128 + F.tid, e = TOKE[i]; const int slot = totL[32 + e] + totL[16 + e] + LRANK[i];
            SLOTTOK[slot] = i >> 1; SLOTW[slot] = TOKW[i]; TOKSLOT[i] = slot; }
        if (blk < 16) { const int e = blk; for (int s = totL[32 + e] + totL[e] + F.tid; s < totL[32 + e + 1]; s += NWAVES * 64) { SLOTTOK[s] = 0; SLOTW[s] = 0.f; } }
        __syncthreads();
    }
}

__global__ void __launch_bounds__(NWAVES * 64, 2) mk_fwd(Args args) {
    extern __shared__ __attribute__((aligned(16))) unsigned char lds[];
    Frame F;
    F.lds = (LAS unsigned char*)lds; F.MISC = (volatile LAS unsigned*)(F.lds + MISC_OFF); F.LM = (LAS int*)(F.lds + LMETA_OFF);
    F.tid = threadIdx.x; F.lane = F.tid & 63; F.wave = __builtin_amdgcn_readfirstlane(F.tid >> 6);
    F.G = gridDim.x; { const int bx = blockIdx.x; F.vcu = (F.G % 8 == 0) ? (bx % 8) * (F.G / 8) + bx / 8 : bx; }
    F.ws = args.ws; F.out = args.out; F.ctl = (gu32*)(args.ws + WS_CTL);
    F.x = args.in[0]; F.c = args.in[1]; F.w_ada = args.in[2]; F.b_ada = args.in[3]; F.g1 = args.in[4]; F.w_in = args.in[5]; F.sinks = args.in[6]; F.w_pool = args.in[7];
    F.pool_scale = args.in[8]; F.w_ab = args.in[9]; F.w_pb = args.in[10]; F.w_out = args.in[11]; F.g2 = args.in[12]; F.w_rg = args.in[13]; F.b_rg = args.in[14]; F.w_re = args.in[15];
    F.b_re = args.in[16]; F.w_eg = args.in[17]; F.w_eu = args.in[18]; F.w_ed = args.in[19]; F.fg = args.in[20];
    for (int u = F.tid; u < (LDS_BYTES - LDSCTL_OFF) / 4; u += NWAVES * 64) ((LAS unsigned*)(F.lds + LDSCTL_OFF))[u] = 0u;
    __syncthreads();
    const int lo = args.ph_lo, hi = args.ph_hi;
    XcdBarrier bar; bar.bar = (unsigned*)(F.ctl + CW_BAR); bar.x = 0; bar.st = nullptr;
    if (hi - lo > 1) bar = xcd_barrier_post((unsigned*)(F.ctl + CW_BAR), F.MISC);
#ifndef ENMASK
#define ENMASK 0x7FF
#endif
#define IN(k) (((ENMASK >> (k)) & 1) && lo <= (k) && (k) < hi)
#define SEAM(k) do { if (IN(k) && IN((k) + 1)) xcd_barrier(bar); } while (0)
    unsigned char* ws = args.ws; float* ADA = (float*)(ws + WS_ADA);
    bf16* PROJ = (bf16*)(ws + WS_PROJ); bf16* BUFB = (bf16*)(ws + WS_B); bf16* BUFC = (bf16*)(ws + WS_C);
    unsigned char* rt = ws + WS_RT;

    if (IN(0)) { p0_prologue(F); } SEAM(0);
    if (IN(1)) { p0b_h1(F); } SEAM(1);
    if (IN(2)) {
        pg8::Gemm g{BUFB, (const bf16*)(ws + WS_WIN), D, D, D, 0, nullptr}; pg8::StaticOrder S; S.init(T, NPROJ, F.G, (int)blockIdx.x);
        pg8::gemm_phase<pg8::EpProj, pg8::StaticOrder, false>(F.lds + RING_OFF, g, S, pg8::EpProj{PROJ});
    } SEAM(2);
    if (IN(3)) {
#ifndef NO_ATTN
        for (int u = F.vcu; u < BATCH * 4 * (SEQ / 64); u += F.G) attn_unit(F, u);
#endif
#ifndef NO_POOL
        for (int u = F.vcu; u < 256; u += F.G) { const int pm = u >> 2, g = u & 3;
            pooled_unit(F, pm, g);
            VM_WAIT(); __syncthreads();
            if (F.tid == 0) { __builtin_amdgcn_fence(__ATOMIC_ACQUIRE, "agent"); VM_WAIT(); }
            __syncthreads();
            pg8::Gemm gg{BUFC + 256 * g, (const bf16*)(ws + WS_WPOOL), 1024, 256, 256, 65536, nullptr};
            pg8::OneUnit S{{pm, 0, g}};
            pg8::gemm_phase<pg8::EpPoolMix, pg8::OneUnit, false>(F.lds + RING_OFF, gg, S, pg8::EpPoolMix{BUFB, F.pool_scale}); }
#endif
    } SEAM(3);
    if (IN(4)) {
        { pg8::Gemm g{BUFB, (const bf16*)(ws + WS_WPB), D, 1024, 1024, 0, nullptr}; pg8::StaticOrder S; S.init(T, D, F.G, (int)blockIdx.x);
          pg8::gemm_phase<pg8::EpT1, pg8::StaticOrder, false>(F.lds + RING_OFF, g, S, pg8::EpT1{BUFC, PROJ}); }
        VM_WAIT(); __syncthreads();
        { pg8::Gemm g{BUFB + 1024, (const bf16*)(ws + WS_WAB), D, 1024, 1024, 0, nullptr}; pg8::StaticOrder S; S.init(T, D, F.G, (int)blockIdx.x);
          pg8::gemm_phase<pg8::EpMerged, pg8::StaticOrder, false>(F.lds + RING_OFF, g, S, pg8::EpMerged{BUFC, PROJ}); }
    } SEAM(4);
    if (IN(5)) {
        pg8::Gemm g{BUFC, (const bf16*)(ws + WS_WOUT), D, D, D, 0, nullptr}; pg8::StaticOrder S; S.init(T, D, F.G, (int)blockIdx.x);
        pg8::gemm_phase<pg8::EpX1, pg8::StaticOrder, false>(F.lds + RING_OFF, g, S, pg8::EpX1{F.x, F.out, ADA, (float*)(ws + WS_SSQ)});
    } SEAM(5);
    if (IN(6)) {
        LAS int* eL = (LAS int*)(F.lds + RING_OFF);
        for (int blk = F.vcu; blk < 256; blk += F.G) {
            for (int i = 0; i < 8; ++i) { const int rl = F.wave * 8 + i, row = blk * 64 + rl; float w1, w2;
                const int ee = route_row(F.out, (const float*)(ws + WS_SSQ), F.g2, ADA, F.w_rg, F.b_rg, F.w_re, F.b_re, BUFB, row, F.lane, w1, w2);
                if (F.lane == 0) { eL[rl] = ee; ((int*)(rt + RT_TOKE))[row * 2] = ee & 255; ((int*)(rt + RT_TOKE))[row * 2 + 1] = ee >> 8;
                    ((float*)(rt + RT_TOKW))[row * 2] = w1; ((float*)(rt + RT_TOKW))[row * 2 + 1] = w2; } }
            LDS_WAIT(); __syncthreads();
            if (F.wave == 0) { const int ee = eL[F.lane]; int r1, r2; hist_wave(ee & 255, ee >> 8, F.lane, blk, (int*)(rt + RT_BLKCNT), r1, r2);
                ((int*)(rt + RT_LRANK))[(blk * 64 + F.lane) * 2] = r1; ((int*)(rt + RT_LRANK))[(blk * 64 + F.lane) * 2 + 1] = r2; }
            __syncthreads(); }
    } SEAM(6);
    if (IN(7)) { p5b_fill(F); } SEAM(7);
    if (IN(8) || IN(9)) {
        for (int i = F.tid; i < 256; i += NWAVES * 64) F.LM[i] = ((const int*)(rt + RT_META))[i];
        LDS_WAIT(); __syncthreads();
    }
    if (IN(8)) {
        pg8::Gemm g{BUFB, (const bf16*)(ws + WS_WGU), D, D, D, (size_t)1024 * D, (const int*)(rt + RT_SLOTTOK)};
        pg8::DynOrder S{F.LM[18] * 4, 4, F.G, F.vcu, F.LM + 32};
        pg8::gemm_phase<pg8::EpAct, pg8::DynOrder, true>(F.lds + RING_OFF, g, S, pg8::EpAct{(bf16*)(ws + WS_ACT), (const float*)(rt + RT_SLOTW)});
    } SEAM(8);
    if (IN(9)) {
        pg8::Gemm g{(const bf16*)(ws + WS_ACT), (const bf16*)(ws + WS_WDN), FF, FF, FF, (size_t)D * FF, nullptr};
        pg8::DynOrder S{F.LM[18] * 8, 8, F.G, F.vcu, F.LM + 32};
        pg8::gemm_phase<pg8::EpY, pg8::DynOrder, false>(F.lds + RING_OFF, g, S, pg8::EpY{(bf16*)(ws + WS_Y)});
    } SEAM(9);
    if (IN(10)) {
        const int gw = F.vcu * NWAVES + F.wave, NGW = F.G * NWAVES;
        for (int row = gw; row < T; row += NGW) final_row(F.out, (const bf16*)(ws + WS_Y), (const int*)(rt + RT_TOKSLOT), ADA, F.fg, row, F.lane);
    }
#undef IN
#undef SEAM
}

#ifndef FASTMASK
#define FASTMASK 0x7FF
#endif
#ifndef ONE_LAUNCH
#define ONE_LAUNCH 0
#endif
constexpr int NPHASE = 11;
extern "C" void kernel_launch(void* const* d_in, const int* in_sizes, int n_in, void* d_out, int out_size, void* d_ws, size_t ws_size, hipStream_t stream) {
    if (n_in != 21 || out_size != T * D || ws_size < WS_END) { fprintf(stderr, "kernel_launch: unexpected shapes (n_in %d out %d ws %zu)\n", n_in, out_size, ws_size); return; }
    static int grid = 0;
    if (grid == 0) {
        int dev = 0, cus = 0, per_cu = 0;
        if (hipGetDevice(&dev) != hipSuccess || hipDeviceGetAttribute(&cus, hipDeviceAttributeMultiprocessorCount, dev) != hipSuccess) { fprintf(stderr, "kernel_launch: device query failed\n"); grid = -1; return; }
        if (hipFuncSetAttribute((const void*)mk_fwd, hipFuncAttributeMaxDynamicSharedMemorySize, LDS_BYTES) != hipSuccess) { fprintf(stderr, "kernel_launch: hipFuncSetAttribute failed\n"); grid = -1; return; }
        if (hipOccupancyMaxActiveBlocksPerMultiprocessor(&per_cu, (const void*)mk_fwd, NWAVES * 64, LDS_BYTES) != hipSuccess || per_cu < 1) { fprintf(stderr, "kernel_launch: occupancy query says %d\n", per_cu); }
        (void)hipGetLastError();
        grid = cus;
    }
    if (grid < 0) return;
    const float* x = (const float*)d_in[0]; const float* c = (const float*)d_in[1]; const float* w_ada = (const float*)d_in[2]; const float* b_ada = (const float*)d_in[3];
    const float* norm1_g = (const float*)d_in[4]; const float* w_in = (const float*)d_in[5]; const float* sinks = (const float*)d_in[6]; const float* w_pool = (const float*)d_in[7];
    const float* pool_scale = (const float*)d_in[8]; const float* w_ab = (const float*)d_in[9]; const float* w_pb = (const float*)d_in[10]; const float* w_out = (const float*)d_in[11];
    const float* norm2_g = (const float*)d_in[12]; const float* w_rg = (const float*)d_in[13]; const float* b_rg = (const float*)d_in[14]; const float* w_re = (const float*)d_in[15];
    const float* b_re = (const float*)d_in[16]; const float* w_eg = (const float*)d_in[17]; const float* w_eu = (const float*)d_in[18]; const float* w_ed = (const float*)d_in[19];
    const float* final_g = (const float*)d_in[20];
    unsigned char* ws = (unsigned char*)d_ws; float* out = (float*)d_out;
    float* ADA = (float*)(ws + WS_ADA); float* ADAP = (float*)(ws + WS_ADAP); float* SSQ = (float*)(ws + WS_SSQ);
    bf16* PROJ = (bf16*)(ws + WS_PROJ); bf16* ACT = (bf16*)(ws + WS_ACT); bf16* Y = (bf16*)(ws + WS_Y);
    bf16* BUFB = (bf16*)(ws + WS_B); bf16* BUFC = (bf16*)(ws + WS_C);
    unsigned char* rt = ws + WS_RT;
    int* TOKE = (int*)(rt + RT_TOKE); float* TOKW = (float*)(rt + RT_TOKW); int* LRANK = (int*)(rt + RT_LRANK); int* TOKSLOT = (int*)(rt + RT_TOKSLOT);
    int* BLKCNT = (int*)(rt + RT_BLKCNT); int* BLKBASE = (int*)(rt + RT_BLKBASE); int* SLOTTOK = (int*)(rt + RT_SLOTTOK); float* SLOTW = (float*)(rt + RT_SLOTW); int* META = (int*)(rt + RT_META);

    (void)hipMemsetAsync(ws + WS_CTL, 0, 1 * MiB, stream);
    Args a{}; for (int i = 0; i < 21; ++i) a.in[i] = (const float*)d_in[i]; a.out = out; a.ws = ws;
    if (ONE_LAUNCH && FASTMASK == 0x7FF) { a.ph_lo = 0; a.ph_hi = NPHASE; hipLaunchKernelGGL(mk_fwd, dim3(grid), dim3(NWAVES * 64), LDS_BYTES, stream, a); return; }
    for (int ph = 0; ph < NPHASE; ++ph) {
        const bool fast = (FASTMASK >> ph) & 1;
        if (fast || (ph == 0 && (FASTMASK & 0x33C))) { a.ph_lo = ph; a.ph_hi = ph + 1; hipLaunchKernelGGL(mk_fwd, dim3(grid), dim3(NWAVES * 64), LDS_BYTES, stream, a); if (fast) continue; }
        switch (ph) {
        case 0: nv::ada_part<<<dim3(NADA / 256, ADA_SL), 256, 0, stream>>>(c, w_ada, ADAP); break;
        case 1: nv::ada_sum<<<2 * NADA / 256, 256, 0, stream>>>(ADAP, b_ada, ADA); nv::h1<<<T / 4, 256, 0, stream>>>(x, norm1_g, ADA, BUFB); break;
        case 2: nv::gemm<false><<<dim3(NPROJ / 64, T / 64), 256, 0, stream>>>(nv::ABf16{BUFB, D, 0}, nv::WPlain{w_in, NPROJ}, nv::WPlain{w_in, NPROJ}, nv::EpProj{PROJ}, D); break;
        case 3: nv::attn<<<dim3(SEQ / 16, 16, BATCH), 256, 0, stream>>>(PROJ, sinks, BUFB);
                nv::pooled<<<(unsigned)((size_t)T * 1024 / 256), 256, 0, stream>>>(PROJ, BUFC);
                for (int g = 0; g < 4; ++g) nv::gemm<false><<<dim3(256 / 64, T / 64), 256, 0, stream>>>(nv::ABf16{BUFC, 1024, g * 256}, nv::WPlain{w_pool + (size_t)g * 256 * 256, 256}, nv::WPlain{w_pool, 256}, nv::EpPool{BUFB, pool_scale, g}, 256);
                break;
        case 4: nv::gemm<false><<<dim3(D / 64, T / 64), 256, 0, stream>>>(nv::ABf16{BUFB, D, 0}, nv::WPlain{w_pb, D}, nv::WPlain{w_pb, D}, nv::EpT1{BUFC, PROJ}, 1024);
                nv::gemm<false><<<dim3(D / 64, T / 64), 256, 0, stream>>>(nv::ABf16{BUFB, D, 1024}, nv::WPlain{w_ab, D}, nv::WPlain{w_ab, D}, nv::EpMerged{BUFC, PROJ}, 1024); break;
        case 5: nv::gemm<false><<<dim3(D / 64, T / 64), 256, 0, stream>>>(nv::ABf16{BUFC, D, 0}, nv::WPlain{w_out, D}, nv::WPlain{w_out, D}, nv::EpX1{out, x, ADA}, D);
                nv::ssq<<<T / 4, 256, 0, stream>>>(out, SSQ); break;
        case 6: nv::route<<<T / 4, 256, 0, stream>>>(out, SSQ, norm2_g, ADA, w_rg, b_rg, w_re, b_re, BUFB, TOKE, TOKW); nv::hist<<<256, 64, 0, stream>>>(TOKE, BLKCNT, LRANK); break;
        case 7: nv::scan<<<1, 256, 0, stream>>>(BLKCNT, BLKBASE, META, SLOTTOK, SLOTW); nv::fill<<<2 * T / 256, 256, 0, stream>>>(TOKE, TOKW, LRANK, BLKBASE, META, SLOTTOK, SLOTW, TOKSLOT); break;
        case 8: nv::gemm<true><<<dim3(FF / 64, MAXSLOT / 64), 256, 0, stream>>>(nv::AGather{BUFB, D, SLOTTOK, META}, nv::WExpert{w_eg, FF, (size_t)D * FF, META}, nv::WExpert{w_eu, FF, (size_t)D * FF, META}, nv::EpAct{ACT, SLOTW}, D); break;
        case 9: nv::gemm<false><<<dim3(D / 64, MAXSLOT / 64), 256, 0, stream>>>(nv::ASlot{ACT, FF, META}, nv::WExpert{w_ed, D, (size_t)FF * D, META}, nv::WExpert{w_ed, D, (size_t)FF * D, META}, nv::EpY{Y}, FF); break;
        case 10: nv::final_<<<T / 4, 256, 0, stream>>>(out, Y, TOKSLOT, ADA, final_g); break;
        }
    }
}
```

```cpp
#include <hip/hip_runtime.h>
#include <stdint.h>
#include <cstdio>

constexpr int D = 2048, BATCH = 2, SEQ = 8192, T = BATCH * SEQ;
constexpr int NPROJ = 6656;
constexpr int C_Q = 0, C_K = 1024, C_V = 1280, C_U = 1536, C_GA = 2560, C_GP = 4608;
constexpr int NADA = 6 * D;
constexpr int NEXP = 16, FF = 512;
constexpr int MAXSLOT = 2 * T + NEXP * 256;
constexpr int ADA_SL = 16;
constexpr float EPS = 1e-6f;
constexpr float LOG2E = 1.4426950408889634f;
constexpr float C2 = 0.125f * LOG2E;

typedef unsigned short bf16;

constexpr size_t MiB = 1u << 20;
constexpr size_t WS_CTL = 0;
constexpr size_t WS_ADA = 1 * MiB;
constexpr size_t WS_ADAP = 2 * MiB;
constexpr size_t WS_WIN = 4 * MiB;
constexpr size_t WS_WPB = 30 * MiB;
constexpr size_t WS_WAB = 34 * MiB;
constexpr size_t WS_WOUT = 38 * MiB;
constexpr size_t WS_WPOOL = 46 * MiB;
constexpr size_t WS_WGU = 47 * MiB;
constexpr size_t WS_WDN = 111 * MiB;
constexpr size_t WS_PROJ = 144 * MiB;
constexpr size_t WS_ACT = 144 * MiB;
constexpr size_t WS_Y = 180 * MiB;
constexpr size_t WS_B = 352 * MiB;
constexpr size_t WS_C = 416 * MiB;
constexpr size_t WS_RT = 480 * MiB;
constexpr size_t WS_SSQ = 482 * MiB;
constexpr size_t WS_END = 484 * MiB;
constexpr size_t RT_TOKE = 0;
constexpr size_t RT_TOKW = RT_TOKE + (size_t)T * 2 * 4;
constexpr size_t RT_LRANK = RT_TOKW + (size_t)T * 2 * 4;
constexpr size_t RT_TOKSLOT = RT_LRANK + (size_t)T * 2 * 4;
constexpr size_t RT_BLKCNT = RT_TOKSLOT + (size_t)T * 2 * 4;
constexpr size_t RT_BLKBASE = RT_BLKCNT + 256 * 16 * 4;
constexpr size_t RT_SLOTTOK = RT_BLKBASE + 256 * 16 * 4;
constexpr size_t RT_SLOTW = RT_SLOTTOK + (size_t)MAXSLOT * 4;
constexpr size_t RT_META = RT_SLOTW + (size_t)MAXSLOT * 4;
static_assert(RT_META + 1024 * 4 <= 2 * MiB, "routing arrays");

__device__ __forceinline__ unsigned f2bf(float f) { unsigned u = __builtin_bit_cast(unsigned, f); return (u + 0x7fffu + ((u >> 16) & 1u)) >> 16; }
__device__ __forceinline__ float bf2f(unsigned h) { return __builtin_bit_cast(float, h << 16); }
__device__ __forceinline__ float bflo(unsigned w) { return __builtin_bit_cast(float, w << 16); }
__device__ __forceinline__ float bfhi(unsigned w) { return __builtin_bit_cast(float, w & 0xffff0000u); }
__device__ __forceinline__ float wave_sum(float v) {
#pragma unroll
    for (int o = 1; o < 64; o <<= 1) v += __shfl_xor(v, o);
    return v;
}
__device__ __forceinline__ float sigmoidf_(float v) { return 1.0f / (1.0f + __expf(-v)); }
__device__ __forceinline__ float sigmoid_fast(float v) { return __builtin_amdgcn_rcpf(1.0f + __builtin_amdgcn_exp2f(-LOG2E * v)); }

namespace nv {
__global__ __launch_bounds__(256) void ada_part(const float* __restrict__ c, const float* __restrict__ W, float* __restrict__ adap) {
    const int j = blockIdx.x * 256 + threadIdx.x, ks = blockIdx.y; constexpr int KS = D / ADA_SL;
    float a0 = 0.f, a1 = 0.f;
    for (int k = ks * KS; k < ks * KS + KS; ++k) { const float w = W[(size_t)k * NADA + j]; a0 += c[k] * w; a1 += c[D + k] * w; }
    adap[((size_t)ks * 2 + 0) * NADA + j] = a0; adap[((size_t)ks * 2 + 1) * NADA + j] = a1;
}
__global__ __launch_bounds__(256) void ada_sum(const float* __restrict__ adap, const float* __restrict__ bias, float* __restrict__ ada) {
    const int i = blockIdx.x * 256 + threadIdx.x;
    const int b = i / NADA, j = i % NADA; float s = bias[j];
    for (int ks = 0; ks < ADA_SL; ++ks) s += adap[((size_t)ks * 2 + b) * NADA + j];
    ada[i] = s;
}
__global__ __launch_bounds__(256) void h1(const float* __restrict__ x, const float* __restrict__ g1, const float* __restrict__ ada, bf16* __restrict__ H1) {
    const int lane = threadIdx.x & 63, row = blockIdx.x * 4 + (threadIdx.x >> 6), b = row / SEQ;
    const float4* xr = (const float4*)(x + (size_t)row * D) + lane;
    float4 v[8]; float ss = 0.f;
#pragma unroll
    for (int j = 0; j < 8; ++j) { v[j] = xr[64 * j]; ss += v[j].x * v[j].x + v[j].y * v[j].y + v[j].z * v[j].z + v[j].w * v[j].w; }
    const float rstd = rsqrtf(wave_sum(ss) * (1.0f / D) + EPS);
    const float* sh = ada + (size_t)b * NADA + 0 * D; const float* sc = ada + (size_t)b * NADA + 1 * D;
#pragma unroll
    for (int j = 0; j < 8; ++j) { const int d = 4 * lane + 256 * j;
        const float4 g = *(const float4*)(g1 + d), s = *(const float4*)(sc + d), h = *(const float4*)(sh + d);
        const float o0 = v[j].x * rstd * g.x * (1.f + s.x) + h.x, o1 = v[j].y * rstd * g.y * (1.f + s.y) + h.y;
        const float o2 = v[j].z * rstd * g.z * (1.f + s.z) + h.z, o3 = v[j].w * rstd * g.w * (1.f + s.w) + h.w;
        uint2 w; w.x = f2bf(o0) | (f2bf(o1) << 16); w.y = f2bf(o2) | (f2bf(o3) << 16);
        *(uint2*)(H1 + (size_t)row * D + d) = w; }
}
struct ABf16 { const bf16* A; long long lda; long long koff;
    __device__ bool init(int bm) { return true; }
    __device__ const bf16* rowptr(int m) const { return A + (size_t)m * lda + koff; } };
struct AGather { const bf16* A; long long lda; const int* slot_tok; const int* meta;
    __device__ bool init(int bm) { return bm < meta[17]; }
    __device__ const bf16* rowptr(int m) const { return A + (size_t)slot_tok[m] * lda; } };
struct ASlot { const bf16* A; long long lda; const int* meta;
    __device__ bool init(int bm) { return bm < meta[17]; }
    __device__ const bf16* rowptr(int m) const { return A + (size_t)m * lda; } };
struct WPlain { const float* W; long long ldw;
    __device__ const float* base(int bm) const { return W; } };
struct WExpert { const float* W; long long ldw; size_t estride; const int* meta;
    __device__ const float* base(int bm) const { return W + (size_t)meta[32 + (bm >> 8)] * estride; } };

template <bool DUAL, class AL, class WL, class EP>
__global__ __launch_bounds__(256) void gemm(AL al, WL wl, WL wl2, EP ep, long long K_) {
    const int K = (int)K_;
    __shared__ float As[16][68]; __shared__ float Ws[16][64]; __shared__ float Ws2[DUAL ? 16 : 1][64];
    const int tid = threadIdx.x, tx = tid & 15, ty = tid >> 4, bm = blockIdx.y * 64, bn = blockIdx.x * 64;
    if (!al.init(bm)) return;
    const float* Wb = wl.base(bm); const float* Wb2 = DUAL ? wl2.base(bm) : nullptr;
    const bf16* arow = al.rowptr(bm + (tid >> 2)); const int ak = (tid & 3) * 4;
    float acc[4][4], acc2[4][4];
#pragma unroll
    for (int i = 0; i < 4; ++i)
#pragma unroll
        for (int j = 0; j < 4; ++j) { acc[i][j] = 0.f; acc2[i][j] = 0.f; }
    for (int k0 = 0; k0 < K; k0 += 16) {
        const uint2 a = *(const uint2*)(arow + k0 + ak);
        As[ak + 0][tid >> 2] = bf2f(a.x & 0xffffu); As[ak + 1][tid >> 2] = bf2f(a.x >> 16); As[ak + 2][tid >> 2] = bf2f(a.y & 0xffffu); As[ak + 3][tid >> 2] = bf2f(a.y >> 16);
        *(float4*)&Ws[ty][tx * 4] = *(const float4*)(Wb + (size_t)(k0 + ty) * wl.ldw + bn + tx * 4);
        if (DUAL) *(float4*)&Ws2[ty][tx * 4] = *(const float4*)(Wb2 + (size_t)(k0 + ty) * wl.ldw + bn + tx * 4);
        __syncthreads();
#pragma unroll
        for (int kk = 0; kk < 16; ++kk) {
            const float4 av = *(const float4*)&As[kk][ty * 4]; const float4 wv = *(const float4*)&Ws[kk][tx * 4];
            const float a4[4] = {av.x, av.y, av.z, av.w}, w4[4] = {wv.x, wv.y, wv.z, wv.w};
#pragma unroll
            for (int i = 0; i < 4; ++i)
#pragma unroll
                for (int j = 0; j < 4; ++j) acc[i][j] += a4[i] * w4[j];
            if (DUAL) { const float4 wv2 = *(const float4*)&Ws2[kk][tx * 4]; const float u4[4] = {wv2.x, wv2.y, wv2.z, wv2.w};
#pragma unroll
                for (int i = 0; i < 4; ++i)
#pragma unroll
                    for (int j = 0; j < 4; ++j) acc2[i][j] += a4[i] * u4[j]; }
        }
        __syncthreads();
    }
#pragma unroll
    for (int i = 0; i < 4; ++i)
#pragma unroll
        for (int j = 0; j < 4; ++j) ep(bm + ty * 4 + i, bn + tx * 4 + j, acc[i][j], acc2[i][j]);
}
struct EpProj { bf16* P;
    __device__ void operator()(int m, int n, float v, float) const {
        if (n < C_K) v *= C2; else if (n >= C_GA) v = sigmoidf_(v);
        P[(size_t)m * NPROJ + n] = (bf16)f2bf(v); } };
struct EpPool { bf16* AP; const float* pool_scale; long long g;
    __device__ void operator()(int m, int n, float v, float) const { AP[(size_t)m * D + g * 256 + n] = (bf16)f2bf(v * pool_scale[g * 256 + n]); } };
struct EpT1 { bf16* T1; const bf16* P;
    __device__ void operator()(int m, int n, float v, float) const { T1[(size_t)m * D + n] = (bf16)f2bf(v * bf2f(P[(size_t)m * NPROJ + C_GP + n])); } };
struct EpMerged { bf16* T1; const bf16* P;
    __device__ void operator()(int m, int n, float v, float) const { const size_t o = (size_t)m * D + n; T1[o] = (bf16)f2bf(v * bf2f(P[(size_t)m * NPROJ + C_GA + n]) + bf2f(T1[o])); } };
struct EpX1 { float* X1; const float* x; const float* ada;
    __device__ void operator()(int m, int n, float v, float) const { const size_t o = (size_t)m * D + n; X1[o] = x[o] + ada[(size_t)(m / SEQ) * NADA + 2 * D + n] * v; } };
struct EpAct { bf16* ACT; const float* slot_w;
    __device__ void operator()(int m, int n, float g, float u) const { ACT[(size_t)m * FF + n] = (bf16)f2bf(g * sigmoidf_(g) * u * slot_w[m]); } };
struct EpY { bf16* Y;
    __device__ void operator()(int m, int n, float v, float) const { Y[(size_t)m * D + n] = (bf16)f2bf(v); } };

__global__ __launch_bounds__(256) void attn(const bf16* __restrict__ P, const float* __restrict__ sinks, bf16* __restrict__ AP) {
    __shared__ float Ps[16][129];
    const int tid = threadIdx.x, r = tid >> 4, part = tid & 15, h = blockIdx.y, b = blockIdx.z, kvh = h >> 2;
    const int t = blockIdx.x * 16 + r; const size_t rowq = (size_t)b * SEQ + t;
    uint4 q4[8];
#pragma unroll
    for (int c = 0; c < 8; ++c) q4[c] = *(const uint4*)(P + rowq * NPROJ + C_Q + h * 64 + c * 8);
    float s[8]; float mx = sinks[h] * LOG2E;
#pragma unroll
    for (int jj = 0; jj < 8; ++jj) { const int w = part + 16 * jj, kp = t - w; float dot = -1e30f;
        if (kp >= 0) { const bf16* kr = P + ((size_t)b * SEQ + kp) * NPROJ + C_K + kvh * 64; dot = 0.f;
#pragma unroll
            for (int c = 0; c < 8; ++c) { const uint4 k4 = *(const uint4*)(kr + c * 8);
                dot += bflo(q4[c].x) * bflo(k4.x) + bfhi(q4[c].x) * bfhi(k4.x) + bflo(q4[c].y) * bflo(k4.y) + bfhi(q4[c].y) * bfhi(k4.y)
                     + bflo(q4[c].z) * bflo(k4.z) + bfhi(q4[c].z) * bfhi(k4.z) + bflo(q4[c].w) * bflo(k4.w) + bfhi(q4[c].w) * bfhi(k4.w); } }
        s[jj] = dot; mx = fmaxf(mx, dot); }
    mx = fmaxf(mx, __shfl_xor(mx, 1)); mx = fmaxf(mx, __shfl_xor(mx, 2)); mx = fmaxf(mx, __shfl_xor(mx, 4)); mx = fmaxf(mx, __shfl_xor(mx, 8));
    float sum = 0.f;
#pragma unroll
    for (int jj = 0; jj < 8; ++jj) { const float p = exp2f(s[jj] - mx); sum += p; Ps[r][part + 16 * jj] = p; }
    sum += __shfl_xor(sum, 1); sum += __shfl_xor(sum, 2); sum += __shfl_xor(sum, 4); sum += __shfl_xor(sum, 8);
    sum += exp2f(sinks[h] * LOG2E - mx);
    __syncthreads();
    float o[4] = {0.f, 0.f, 0.f, 0.f};
    const int wmax = t < 127 ? t : 127;
    for (int w = 0; w <= wmax; ++w) { const float p = Ps[r][w]; const uint2 v2 = *(const uint2*)(P + ((size_t)b * SEQ + (t - w)) * NPROJ + C_V + kvh * 64 + part * 4);
        o[0] += p * bflo(v2.x); o[1] += p * bfhi(v2.x); o[2] += p * bflo(v2.y); o[3] += p * bfhi(v2.y); }
    const float inv = 1.0f / sum; uint2 w2; w2.x = f2bf(o[0] * inv) | (f2bf(o[1] * inv) << 16); w2.y = f2bf(o[2] * inv) | (f2bf(o[3] * inv) << 16);
    *(uint2*)(AP + rowq * D + 1024 + h * 64 + part * 4) = w2;
}
__global__ __launch_bounds__(256) void pooled(const bf16* __restrict__ P, bf16* __restrict__ PO) {
    const size_t idx = (size_t)blockIdx.x * 256 + threadIdx.x; const int row = (int)(idx >> 10), ch = (int)(idx & 1023), t = row % SEQ, g = ch >> 8, w = 2 << g;
    const int cnt = (t + 1) < w ? (t + 1) : w; float s = 0.f;
    for (int i = 0; i < cnt; ++i) s += bf2f(P[(size_t)(row - i) * NPROJ + C_U + ch]);
    PO[(size_t)row * 1024 + ch] = (bf16)f2bf(s / (float)cnt - bf2f(P[(size_t)row * NPROJ + C_U + ch]));
}
__global__ __launch_bounds__(256) void ssq(const float* __restrict__ X1, float* __restrict__ SSQ) {
    const int lane = threadIdx.x & 63, row = blockIdx.x * 4 + (threadIdx.x >> 6);
    const float* xr = X1 + (size_t)row * D;
    for (int p = 0; p < 32; ++p) { const float v = xr[64 * p + lane]; const float s = wave_sum(v * v); if (lane == 0) SSQ[(size_t)row * 32 + p] = s; }
}
}

__device__ __forceinline__ int route_row(const float* __restrict__ X1, const float* __restrict__ SSQ, const float* __restrict__ g2, const float* __restrict__ ada,
                                         const float* __restrict__ wrg, const float* __restrict__ brg, const float* __restrict__ wre, const float* __restrict__ bre,
                                         bf16* __restrict__ H2, int row, int lane, float& w1, float& w2) {
    const int b = row / SEQ;
    const float part = lane < 32 ? SSQ[(size_t)row * 32 + lane] : 0.f;
    const float rstd = rsqrtf(wave_sum(part) * (1.0f / D) + EPS);
    const float* sh = ada + (size_t)b * NADA + 3 * D; const float* sc = ada + (size_t)b * NADA + 4 * D;
    float acc[20];
#pragma unroll
    for (int o = 0; o < 20; ++o) acc[o] = 0.f;
#pragma unroll
    for (int j = 0; j < 8; ++j) { const int d = 4 * lane + 256 * j;
        const float4 xv = *(const float4*)(X1 + (size_t)row * D + d), g = *(const float4*)(g2 + d), s = *(const float4*)(sc + d), h = *(const float4*)(sh + d);
        const float hv[4] = {xv.x * rstd * g.x * (1.f + s.x) + h.x, xv.y * rstd * g.y * (1.f + s.y) + h.y, xv.z * rstd * g.z * (1.f + s.z) + h.z, xv.w * rstd * g.w * (1.f + s.w) + h.w};
        uint2 w; w.x = f2bf(hv[0]) | (f2bf(hv[1]) << 16); w.y = f2bf(hv[2]) | (f2bf(hv[3]) << 16);
        *(uint2*)(H2 + (size_t)row * D + d) = w;
#pragma unroll
        for (int e = 0; e < 4; ++e) { const float4 wg = *(const float4*)(wrg + (size_t)(d + e) * 4);
            acc[0] += hv[e] * wg.x; acc[1] += hv[e] * wg.y; acc[2] += hv[e] * wg.z; acc[3] += hv[e] * wg.w;
#pragma unroll
            for (int q = 0; q < 4; ++q) { const float4 we = *(const float4*)(wre + (size_t)(d + e) * 16 + q * 4);
                acc[4 + 4 * q] += hv[e] * we.x; acc[5 + 4 * q] += hv[e] * we.y; acc[6 + 4 * q] += hv[e] * we.z; acc[7 + 4 * q] += hv[e] * we.w; } } }
#pragma unroll
    for (int o = 0; o < 20; ++o) acc[o] = wave_sum(acc[o]);
    float gl[4]; int gi = 0;
#pragma unroll
    for (int o = 0; o < 4; ++o) gl[o] = acc[o] + brg[o];
#pragma unroll
    for (int o = 1; o < 4; ++o) if (gl[o] > gl[gi]) gi = o;
    float gsum = 0.f;
#pragma unroll
    for (int o = 0; o < 4; ++o) gsum += __expf(gl[o] - gl[gi]);
    const float gp = 1.0f / gsum;
    float el[4];
#pragma unroll
    for (int o = 0; o < 4; ++o) { float v = 0.f;
#pragma unroll
        for (int g = 0; g < 4; ++g) v = (g == gi) ? acc[4 + 4 * g + o] + bre[4 * g + o] : v;
        el[o] = v; }
    int i1 = 0;
#pragma unroll
    for (int o = 1; o < 4; ++o) if (el[o] > el[i1]) i1 = o;
    int i2 = (i1 == 0) ? 1 : 0;
#pragma unroll
    for (int o = 0; o < 4; ++o) if (o != i1 && el[o] > el[i2]) i2 = o;
    const float r = __expf(el[i2] - el[i1]);
    w1 = gp / (1.0f + r); w2 = gp * r / (1.0f + r);
    return (gi * 4 + i1) | ((gi * 4 + i2) << 8);
}
__device__ __forceinline__ void hist_wave(int e1, int e2, int lane, int blk, int* __restrict__ blkcnt, int& r1, int& r2) {
    const unsigned long long lt = (1ull << lane) - 1ull; r1 = 0; r2 = 0;
    for (int e = 0; e < NEXP; ++e) { const unsigned long long m1 = __ballot(e1 == e), m2 = __ballot(e2 == e);
        if (e1 == e) r1 = __popcll(m1 & lt); if (e2 == e) r2 = __popcll(m1) + __popcll(m2 & lt);
        if (lane == 0) blkcnt[blk * 16 + e] = __popcll(m1) + __popcll(m2); }
}
__device__ __forceinline__ void final_row(float* __restrict__ X1, const bf16* __restrict__ Y, const int* __restrict__ tokslot, const float* __restrict__ ada, const float* __restrict__ fg, int row, int lane) {
    const int b = row / SEQ;
    const int s1 = tokslot[row * 2], s2 = tokslot[row * 2 + 1]; const float* g2 = ada + (size_t)b * NADA + 5 * D;
    float4 v[8]; float ss = 0.f;
#pragma unroll
    for (int j = 0; j < 8; ++j) { const int d = 4 * lane + 256 * j; const float4 xv = *(const float4*)(X1 + (size_t)row * D + d), g = *(const float4*)(g2 + d);
        const uint2 a = *(const uint2*)(Y + (size_t)s1 * D + d), c = *(const uint2*)(Y + (size_t)s2 * D + d);
        v[j].x = xv.x + g.x * (bflo(a.x) + bflo(c.x)); v[j].y = xv.y + g.y * (bfhi(a.x) + bfhi(c.x));
        v[j].z = xv.z + g.z * (bflo(a.y) + bflo(c.y)); v[j].w = xv.w + g.w * (bfhi(a.y) + bfhi(c.y));
        ss += v[j].x * v[j].x + v[j].y * v[j].y + v[j].z * v[j].z + v[j].w * v[j].w; }
    const float rstd = rsqrtf(wave_sum(ss) * (1.0f / D) + EPS);
#pragma unroll
    for (int j = 0; j < 8; ++j) { const int d = 4 * lane + 256 * j; const float4 g = *(const float4*)(fg + d);
        *(float4*)(X1 + (size_t)row * D + d) = make_float4(v[j].x * rstd * g.x, v[j].y * rstd * g.y, v[j].z * rstd * g.z, v[j].w * rstd * g.w); }
}
namespace nv {
__global__ __launch_bounds__(256) void route(const float* X1, const float* SSQ, const float* g2, const float* ada, const float* wrg, const float* brg, const float* wre, const float* bre,
                                             bf16* H2, int* __restrict__ toke, float* __restrict__ tokw) {
    const int lane = threadIdx.x & 63, row = blockIdx.x * 4 + (threadIdx.x >> 6); float w1, w2;
    const int ee = route_row(X1, SSQ, g2, ada, wrg, brg, wre, bre, H2, row, lane, w1, w2);
    if (lane == 0) { toke[row * 2] = ee & 255; toke[row * 2 + 1] = ee >> 8; tokw[row * 2] = w1; tokw[row * 2 + 1] = w2; }
}
__global__ __launch_bounds__(64) void hist(const int* __restrict__ toke, int* __restrict__ blkcnt, int* __restrict__ lrank) {
    const int lane = threadIdx.x, tkn = blockIdx.x * 64 + lane; int r1, r2;
    hist_wave(toke[tkn * 2], toke[tkn * 2 + 1], lane, blockIdx.x, blkcnt, r1, r2);
    lrank[tkn * 2] = r1; lrank[tkn * 2 + 1] = r2;
}
__global__ __launch_bounds__(256) void scan(const int* __restrict__ blkcnt, int* __restrict__ blkbase, int* __restrict__ meta, int* __restrict__ slot_tok, float* __restrict__ slot_w) {
    __shared__ int cnt[16], off[17];
    const int tid = threadIdx.x;
    if (tid < 16) { int base = 0; for (int b = 0; b < 256; ++b) { blkbase[b * 16 + tid] = base; base += blkcnt[b * 16 + tid]; } cnt[tid] = base; }
    __syncthreads();
    if (tid == 0) { int o = 0, nt = 0; for (int e = 0; e < 16; ++e) { off[e] = o; meta[e] = o; const int tl = (cnt[e] + 255) >> 8; for (int i = 0; i < tl; ++i) meta[32 + nt++] = e; o += tl * 256; } off[16] = o; meta[16] = o; meta[17] = o; meta[18] = nt; }
    __syncthreads();
    for (int e = 0; e < 16; ++e) for (int s = off[e] + cnt[e] + tid; s < off[e + 1]; s += 256) { slot_tok[s] = 0; slot_w[s] = 0.f; }
}
__global__ __launch_bounds__(256) void fill(const int* __restrict__ toke, const float* __restrict__ tokw, const int* __restrict__ lrank, const int* __restrict__ blkbase, const int* __restrict__ meta,
                                            int* __restrict__ slot_tok, float* __restrict__ slot_w, int* __restrict__ tokslot) {
    const int i = blockIdx.x * 256 + threadIdx.x;
    const int tkn = i >> 1, e = toke[i], slot = meta[e] + blkbase[(tkn >> 6) * 16 + e] + lrank[i];
    slot_tok[slot] = tkn; slot_w[slot] = tokw[i]; tokslot[i] = slot;
}
__global__ __launch_bounds__(256) void final_(float* X1, const bf16* Y, const int* tokslot, const float* ada, const float* fg) {
    final_row(X1, Y, tokslot, ada, fg, blockIdx.x * 4 + (threadIdx.x >> 6), threadIdx.x & 63);
}
}

namespace pg8 {
#define PG8_LAS __attribute__((address_space(3)))
typedef unsigned short bf16_t;
typedef short bf16x8 __attribute__((ext_vector_type(8)));
typedef float f32x4 __attribute__((ext_vector_type(4)));
typedef unsigned u32x4 __attribute__((ext_vector_type(4)));
constexpr int BM = 256, BK = 64, HALF = 128, HTB = HALF * BK * 2, STAGE_BYTES = 8 * HTB, NXCD = 8, WGM = 8;
__host__ __device__ __forceinline__ int lds_byte(int r, int c) { const int st = (r >> 4) * 2 + (c >> 5), rr = r & 15, cc = c & 31, ob = rr * 64 + cc * 2; return st * 1024 + (ob ^ (((ob >> 9) & 1) << 5)); }
__host__ __device__ __forceinline__ void stage_rc(int b, int& R, int& C) { const int st = b / 1024, sb = b % 1024, swz = sb ^ (((sb >> 9) & 1) << 5); R = (st >> 1) * 16 + swz / 64; C = (st & 1) * 32 + (swz % 64) / 2; }
__host__ __device__ __forceinline__ int perm32(int rho) { const int n = rho >> 4, i = rho & 15; return 8 * (i >> 2) + 4 * n + (i & 3); }

struct Unit { int pm, pn, be; };
struct Gemm { const bf16_t* A; const bf16_t* Bt; int lda, ldb, K; size_t bstride; const int* rowidx; };

struct StaticOrder {
    int nM, nN, nwg, G, c;
    __device__ void init(int M, int N, int G_, int c_) { nM = M / BM; nN = N / BM; nwg = nM * nN; G = G_; c = c_; }
    __device__ bool next(int i, Unit& u) const {
        const long L = (long)i * G + c; if (L >= nwg) return false;
        int wgid = (int)L; { const int q = nwg / NXCD, r = nwg % NXCD, xcd = wgid % NXCD, off = wgid / NXCD; wgid = (xcd < r ? xcd * (q + 1) : r * (q + 1) + (xcd - r) * q) + off; }
        const int nig = WGM * nN, gid = wgid / nig, fm = gid * WGM, gsz = (nM - fm) < WGM ? (nM - fm) : WGM;
        u.pm = fm + ((wgid % nig) % gsz); u.pn = (wgid % nig) / gsz; u.be = 0; return true;
    }
};
struct OneUnit { Unit u0; __device__ bool next(int i, Unit& u) const { if (i) return false; u = u0; return true; } };
struct DynOrder { int nunits, nN, G, c; const PG8_LAS int* tile_e;
    __device__ bool next(int i, Unit& u) const { const int L = i * G + c; if (L >= nunits) return false; u.pm = L / nN; u.pn = L % nN; u.be = tile_e[u.pm]; return true; } };

__device__ __forceinline__ unsigned cvt_pk_bf16(float lo, float hi) { unsigned r; asm volatile("v_cvt_pk_bf16_f32 %0, %1, %2" : "=v"(r) : "v"(lo), "v"(hi)); return r; }
__device__ __forceinline__ u32x4 pack8(f32x4 v0, f32x4 v1) { u32x4 w; w.x = cvt_pk_bf16(v0[0], v0[1]); w.y = cvt_pk_bf16(v0[2], v0[3]); w.z = cvt_pk_bf16(v1[0], v1[1]); w.w = cvt_pk_bf16(v1[2], v1[3]); return w; }

struct EpProj { static constexpr bool PERM = true; bf16_t* O;
    __device__ __forceinline__ void operator()(const f32x4 (&acc)[2][2][4][2], const Unit& u, int wr, int wc, int fr, int fq) const {
        const int row0 = u.pm * BM + wr * 64 + fr, col0 = u.pn * BM + wc * 32 + 8 * fq; const int mode = u.pn < 4 ? 0 : (u.pn < 10 ? 1 : 2);
#pragma unroll
        for (int ai = 0; ai < 2; ++ai)
#pragma unroll
            for (int m = 0; m < 4; ++m) { bf16_t* rowp = O + (size_t)(row0 + ai * HALF + m * 16) * NPROJ + col0;
#pragma unroll
                for (int bj = 0; bj < 2; ++bj) { f32x4 v0 = acc[ai][bj][m][0], v1 = acc[ai][bj][m][1];
                    if (mode == 0) { v0 = v0 * C2; v1 = v1 * C2; }
                    else if (mode == 2) {
#pragma unroll
                        for (int i = 0; i < 4; ++i) { v0[i] = sigmoid_fast(v0[i]); v1[i] = sigmoid_fast(v1[i]); } }
                    *(u32x4*)(rowp + bj * HALF) = pack8(v0, v1); } }
    } };
struct EpPoolMix { static constexpr bool PERM = true; bf16_t* O; const float* pool_scale;
    __device__ __forceinline__ void operator()(const f32x4 (&acc)[2][2][4][2], const Unit& u, int wr, int wc, int fr, int fq) const {
        const int row0 = u.pm * BM + wr * 64 + fr, col0 = u.be * 256 + wc * 32 + 8 * fq;
        f32x4 sc[2][2];
#pragma unroll
        for (int bj = 0; bj < 2; ++bj)
#pragma unroll
            for (int n = 0; n < 2; ++n) sc[bj][n] = *(const f32x4*)(pool_scale + col0 + bj * HALF + 4 * n);
#pragma unroll
        for (int ai = 0; ai < 2; ++ai)
#pragma unroll
            for (int m = 0; m < 4; ++m) { bf16_t* rowp = O + (size_t)(row0 + ai * HALF + m * 16) * D + col0;
#pragma unroll
                for (int bj = 0; bj < 2; ++bj) *(u32x4*)(rowp + bj * HALF) = pack8(acc[ai][bj][m][0] * sc[bj][0], acc[ai][bj][m][1] * sc[bj][1]); }
    } };
__device__ __forceinline__ void unpack8(u32x4 w, f32x4& a, f32x4& b) { a[0] = bflo(w.x); a[1] = bfhi(w.x); a[2] = bflo(w.y); a[3] = bfhi(w.y); b[0] = bflo(w.z); b[1] = bfhi(w.z); b[2] = bflo(w.w); b[3] = bfhi(w.w); }
struct EpT1 { static constexpr bool PERM = true; bf16_t* T1; const bf16_t* P;
    __device__ __forceinline__ void operator()(const f32x4 (&acc)[2][2][4][2], const Unit& u, int wr, int wc, int fr, int fq) const {
        const int row0 = u.pm * BM + wr * 64 + fr, col0 = u.pn * BM + wc * 32 + 8 * fq;
#pragma unroll
        for (int ai = 0; ai < 2; ++ai)
#pragma unroll
            for (int m = 0; m < 4; ++m) { const size_t r = (size_t)(row0 + ai * HALF + m * 16);
#pragma unroll
                for (int bj = 0; bj < 2; ++bj) { const u32x4 gw = *(const u32x4*)(P + r * NPROJ + C_GP + col0 + bj * HALF); f32x4 g0, g1; unpack8(gw, g0, g1);
                    *(u32x4*)(T1 + r * D + col0 + bj * HALF) = pack8(acc[ai][bj][m][0] * g0, acc[ai][bj][m][1] * g1); } }
    } };
struct EpMerged { static constexpr bool PERM = true; bf16_t* T1; const bf16_t* P;
    __device__ __forceinline__ void operator()(const f32x4 (&acc)[2][2][4][2], const Unit& u, int wr, int wc, int fr, int fq) const {
        const int row0 = u.pm * BM + wr * 64 + fr, col0 = u.pn * BM + wc * 32 + 8 * fq;
#pragma unroll
        for (int ai = 0; ai < 2; ++ai)
#pragma unroll
            for (int m = 0; m < 4; ++m) { const size_t r = (size_t)(row0 + ai * HALF + m * 16);
#pragma unroll
                for (int bj = 0; bj < 2; ++bj) { const u32x4 gw = *(const u32x4*)(P + r * NPROJ + C_GA + col0 + bj * HALF); f32x4 g0, g1; unpack8(gw, g0, g1);
                    bf16_t* tp = T1 + r * D + col0 + bj * HALF; const u32x4 tw = *(const u32x4*)tp; f32x4 t0, t1; unpack8(tw, t0, t1);
                    *(u32x4*)tp = pack8(acc[ai][bj][m][0] * g0 + t0, acc[ai][bj][m][1] * g1 + t1); } }
    } };
struct EpX1 { static constexpr bool PERM = false; const float* x; float* X1; const float* ada; float* SSQ;
    __device__ __forceinline__ void operator()(const f32x4 (&acc)[2][2][4][2], const Unit& u, int wr, int wc, int fr, int fq) const {
        const int row0 = u.pm * BM + wr * 64 + fr, col0 = u.pn * BM + wc * 32 + 4 * fq; const float* g1 = ada + (size_t)(u.pm >> 5) * NADA + 2 * D;
        f32x4 gv[2][2];
#pragma unroll
        for (int bj = 0; bj < 2; ++bj)
#pragma unroll
            for (int n = 0; n < 2; ++n) gv[bj][n] = *(const f32x4*)(g1 + col0 + bj * HALF + n * 16);
#pragma unroll
        for (int ai = 0; ai < 2; ++ai)
#pragma unroll
            for (int m = 0; m < 4; ++m) { const size_t r = (size_t)(row0 + ai * HALF + m * 16); float s = 0.f;
#pragma unroll
                for (int bj = 0; bj < 2; ++bj)
#pragma unroll
                    for (int n = 0; n < 2; ++n) { const size_t o = r * D + col0 + bj * HALF + n * 16; const f32x4 xv = *(const f32x4*)(x + o); const f32x4 v = xv + gv[bj][n] * acc[ai][bj][m][n];
                        *(f32x4*)(X1 + o) = v; s += (v[0] * v[0] + v[1] * v[1]) + (v[2] * v[2] + v[3] * v[3]); }
                s += __shfl_xor(s, 16); s += __shfl_xor(s, 32);
                if (fq == 0) SSQ[r * 32 + u.pn * 4 + wc] = s; }
    } };
struct EpAct { static constexpr bool PERM = true; bf16_t* ACT; const float* slot_w;
    __device__ __forceinline__ void operator()(const f32x4 (&acc)[2][2][4][2], const Unit& u, int wr, int wc, int fr, int fq) const {
        const int row0 = u.pm * BM + wr * 64 + fr, col0 = u.pn * HALF + wc * 32 + 8 * fq;
#pragma unroll
        for (int ai = 0; ai < 2; ++ai)
#pragma unroll
            for (int m = 0; m < 4; ++m) { const size_t r = (size_t)(row0 + ai * HALF + m * 16); const float w = slot_w[r]; f32x4 o[2];
#pragma unroll
                for (int n = 0; n < 2; ++n)
#pragma unroll
                    for (int i = 0; i < 4; ++i) { const float g = acc[ai][0][m][n][i], uu = acc[ai][1][m][n][i]; o[n][i] = g * sigmoid_fast(g) * uu * w; }
                *(u32x4*)(ACT + r * FF + col0) = pack8(o[0], o[1]); }
    } };
struct EpY { static constexpr bool PERM = true; bf16_t* Y;
    __device__ __forceinline__ void operator()(const f32x4 (&acc)[2][2][4][2], const Unit& u, int wr, int wc, int fr, int fq) const {
        const int row0 = u.pm * BM + wr * 64 + fr, col0 = u.pn * BM + wc * 32 + 8 * fq;
#pragma unroll
        for (int ai = 0; ai < 2; ++ai)
#pragma unroll
            for (int m = 0; m < 4; ++m) { bf16_t* rowp = Y + (size_t)(row0 + ai * HALF + m * 16) * D + col0;
#pragma unroll
                for (int bj = 0; bj < 2; ++bj) *(u32x4*)(rowp + bj * HALF) = pack8(acc[ai][bj][m][0], acc[ai][bj][m][1]); }
    } };

template <class Epi, class Sched, bool GATHER>
__device__ __forceinline__ void gemm_phase(PG8_LAS unsigned char* lds, const Gemm g, const Sched& S, const Epi& E) {
    const int tid = threadIdx.x, wid = __builtin_amdgcn_readfirstlane(tid >> 6), lane = tid & 63, wr = wid >> 2, wc = wid & 3, fr = lane & 15, fq = lane >> 4;
    int K = g.K; asm volatile("" : "+s"(K));
    const int nt = K / BK;
    int sR[2], sC[2]; unsigned voB[2], voA[2][2], voN[2][2];
#pragma unroll
    for (int i = 0; i < 2; ++i) { int R, C; stage_rc(tid * 16 + i * 8192, R, C); sR[i] = R; sC[i] = C; const int Rb = Epi::PERM ? ((R & ~31) + perm32(R & 31)) : R;
        voB[i] = (unsigned)(Rb * g.ldb + C) * 2u;
#pragma unroll
        for (int h = 0; h < 2; ++h) { voA[h][i] = (unsigned)((h * HALF + R) * g.lda + C) * 2u; voN[h][i] = voA[h][i]; } }
    const size_t kstep = (size_t)(BK * 2);
    const size_t hstepB = (size_t)HALF * g.ldb * 2, tstepA = (size_t)BM * g.lda * 2, tstepB = (size_t)BM * g.ldb * 2;
    const unsigned ldsw = (unsigned)wid * 1024u;
    const int aoff = lds_byte(wr * 64 + fr, fq * 8), boff = lds_byte(wc * 32 + fr, fq * 8);
#define PG8_SA(b, h) (((b) * 2 + (h)) * HTB)
#define PG8_SB(b, h) ((4 + (b) * 2 + (h)) * HTB)
#define PG8_STAGE(bufoff, gbase, voff) do { _Pragma("unroll") for (int _i = 0; _i < 2; ++_i) \
        __builtin_amdgcn_global_load_lds((const unsigned*)((const char*)(gbase) + (voff)[_i]), (PG8_LAS unsigned*)(lds + (bufoff) + ldsw + _i * 8192), 16, 0, 0); } while (0)
#define PG8_LDA(dst, b, h) do { _Pragma("unroll") for (int m = 0; m < 4; ++m) _Pragma("unroll") for (int k = 0; k < 2; ++k) dst[m][k] = *(const PG8_LAS bf16x8*)(lds + PG8_SA(b, h) + aoff + m * 2048 + k * 1024); } while (0)
#define PG8_LDB(dst, b, h) do { _Pragma("unroll") for (int n = 0; n < 2; ++n) _Pragma("unroll") for (int k = 0; k < 2; ++k) dst[n][k] = *(const PG8_LAS bf16x8*)(lds + PG8_SB(b, h) + boff + n * 2048 + k * 1024); } while (0)
#define PG8_MMA(ai, bj, At, Bt) do { __builtin_amdgcn_s_setprio(1); _Pragma("unroll") for (int m = 0; m < 4; ++m) _Pragma("unroll") for (int n = 0; n < 2; ++n) _Pragma("unroll") for (int k = 0; k < 2; ++k) \
        acc[ai][bj][m][n] = __builtin_amdgcn_mfma_f32_16x16x32_bf16(Bt[n][k], At[m][k], acc[ai][bj][m][n], 0, 0, 0); __builtin_amdgcn_s_setprio(0); } while (0)
#define PG8_WAIT_V(n) asm volatile("s_waitcnt vmcnt(" #n ")" ::: "memory")
#define PG8_WAIT_L(n) asm volatile("s_waitcnt lgkmcnt(" #n ")" ::: "memory")
#define PG8_BAR __builtin_amdgcn_s_barrier()
#define PG8_SCHED __builtin_amdgcn_sched_barrier(0)
#define PG8_GATHER_OFFS(dst, pm_) do { _Pragma("unroll") for (int _h = 0; _h < 2; ++_h) _Pragma("unroll") for (int _i = 0; _i < 2; ++_i) \
        dst[_h][_i] = (unsigned)(g.rowidx[(pm_) * BM + _h * HALF + sR[_i]] * g.lda + sC[_i]) * 2u; \
        __builtin_amdgcn_s_waitcnt(0x0F70); _Pragma("unroll") for (int _h = 0; _h < 2; ++_h) _Pragma("unroll") for (int _i = 0; _i < 2; ++_i) asm volatile("" : "+v"(dst[_h][_i])); } while (0)
    Unit cur, nxt; int ui = 0;
    if (!S.next(0, cur)) return;
    f32x4 acc[2][2][4][2];
#pragma unroll
    for (int a = 0; a < 2; ++a)
#pragma unroll
        for (int b = 0; b < 2; ++b)
#pragma unroll
            for (int m = 0; m < 4; ++m)
#pragma unroll
                for (int n = 0; n < 2; ++n) acc[a][b][m][n] = (f32x4){0.f, 0.f, 0.f, 0.f};
    bf16x8 At[4][2], B0[2][2], B1[2][2];
    const char* cA = (const char*)g.A + (GATHER ? (size_t)0 : (size_t)cur.pm * tstepA);
    const char* cB = (const char*)g.Bt + ((size_t)cur.be * g.bstride) * 2 + (size_t)cur.pn * tstepB;
    if constexpr (GATHER) PG8_GATHER_OFFS(voA, cur.pm);
    PG8_STAGE(PG8_SB(0, 0), cB, voB); PG8_STAGE(PG8_SB(0, 1), cB + hstepB, voB); PG8_STAGE(PG8_SA(0, 0), cA, voA[0]); PG8_STAGE(PG8_SA(0, 1), cA, voA[1]);
    if (wr == 1) PG8_BAR;
    PG8_WAIT_V(2); PG8_BAR;
    PG8_STAGE(PG8_SB(1, 0), cB + kstep, voB); PG8_STAGE(PG8_SA(1, 0), cA + kstep, voA[0]); PG8_STAGE(PG8_SB(1, 1), cB + hstepB + kstep, voB);
    PG8_WAIT_V(6); PG8_BAR;
    for (;;) {
        const bool has_next = S.next(ui + 1, nxt);
        const char* nA = has_next ? (const char*)g.A + (GATHER ? (size_t)0 : (size_t)nxt.pm * tstepA) : cA;
        const char* nB = has_next ? (const char*)g.Bt + ((size_t)nxt.be * g.bstride) * 2 + (size_t)nxt.pn * tstepB : cB;
        if constexpr (GATHER) { if (has_next) PG8_GATHER_OFFS(voN, nxt.pm); else {
#pragma unroll
            for (int h = 0; h < 2; ++h)
#pragma unroll
                for (int i = 0; i < 2; ++i) voN[h][i] = voA[h][i]; } }
        for (int t = 0; t < nt; t += 2) {
            const bool last = (t == nt - 2);
            const char* a1 = cA + (size_t)(t + 1) * kstep;
            const char* a2 = last ? nA : cA + (size_t)(t + 2) * kstep; const char* b2 = last ? nB : cB + (size_t)(t + 2) * kstep;
            const char* a3 = a2 + kstep; const char* b3 = b2 + kstep;
            unsigned vo2[2][2];
#pragma unroll
            for (int h = 0; h < 2; ++h)
#pragma unroll
                for (int i = 0; i < 2; ++i) vo2[h][i] = (GATHER && last) ? voN[h][i] : voA[h][i];
            PG8_LDB(B0, 0, 0); PG8_LDB(B1, 0, 1); PG8_SCHED; PG8_LDA(At, 0, 0); PG8_STAGE(PG8_SA(1, 1), a1, voA[1]);
            PG8_WAIT_V(8); PG8_WAIT_L(0); PG8_BAR; PG8_MMA(0, 0, At, B0); PG8_MMA(0, 1, At, B1); PG8_BAR; PG8_SCHED;
            PG8_LDA(At, 0, 1); PG8_STAGE(PG8_SB(0, 0), b2, voB); PG8_STAGE(PG8_SB(0, 1), b2 + hstepB, voB); PG8_STAGE(PG8_SA(0, 0), a2, vo2[0]);
            PG8_WAIT_V(8); PG8_WAIT_L(0); PG8_BAR; PG8_MMA(1, 0, At, B0); PG8_MMA(1, 1, At, B1); PG8_BAR; PG8_SCHED;
            PG8_LDB(B0, 1, 0); PG8_LDB(B1, 1, 1); PG8_SCHED; PG8_LDA(At, 1, 0); PG8_STAGE(PG8_SA(0, 1), a2, vo2[1]);
            PG8_WAIT_V(8); PG8_WAIT_L(0); PG8_BAR; PG8_MMA(0, 0, At, B0); PG8_MMA(0, 1, At, B1); PG8_BAR; PG8_SCHED;
            PG8_LDA(At, 1, 1); PG8_STAGE(PG8_SB(1, 0), b3, voB); PG8_STAGE(PG8_SB(1, 1), b3 + hstepB, voB); PG8_STAGE(PG8_SA(1, 0), a3, vo2[0]);
            PG8_WAIT_V(8); PG8_WAIT_L(0); PG8_BAR; PG8_MMA(1, 0, At, B0); PG8_MMA(1, 1, At, B1); PG8_BAR; PG8_SCHED;
        }
        if (wr == 0) PG8_BAR;
        E(acc, cur, wr, wc, fr, fq);
        if (!has_next) break;
#pragma unroll
        for (int a = 0; a < 2; ++a)
#pragma unroll
            for (int b = 0; b < 2; ++b)
#pragma unroll
                for (int m = 0; m < 4; ++m)
#pragma unroll
                    for (int n = 0; n < 2; ++n) acc[a][b][m][n] = (f32x4){0.f, 0.f, 0.f, 0.f};
        cur = nxt; cA = nA; cB = nB; ++ui;
        if constexpr (GATHER) {
#pragma unroll
            for (int h = 0; h < 2; ++h)
#pragma unroll
                for (int i = 0; i < 2; ++i) voA[h][i] = voN[h][i]; }
        if (wr == 1) PG8_BAR;
    }
    PG8_WAIT_V(0);
    PG8_BAR;
#undef PG8_SA
#undef PG8_SB
#undef PG8_STAGE
#undef PG8_LDA
#undef PG8_LDB
#undef PG8_MMA
#undef PG8_WAIT_V
#undef PG8_WAIT_L
#undef PG8_BAR
#undef PG8_SCHED
#undef PG8_GATHER_OFFS
}
}

#define GAS __attribute__((address_space(1)))
#define LAS __attribute__((address_space(3)))
typedef unsigned v4u __attribute__((ext_vector_type(4)));
typedef unsigned v2u __attribute__((ext_vector_type(2)));
typedef float f32x4 __attribute__((ext_vector_type(4)));
typedef float f32x16 __attribute__((ext_vector_type(16)));
typedef short bf16x8 __attribute__((ext_vector_type(8)));
typedef short s16x4 __attribute__((ext_vector_type(4)));
typedef GAS unsigned gu32;
#define RLX_AGENT __ATOMIC_RELAXED, __HIP_MEMORY_SCOPE_AGENT
#define LDS_WAIT() asm volatile("s_waitcnt lgkmcnt(0)" ::: "memory")
#define VM_WAIT() asm volatile("s_waitcnt vmcnt(0)" ::: "memory")
constexpr int NWAVES = 8;
constexpr int RING_OFF = 0, RING_BYTES = 131072;
constexpr int LDSCTL_OFF = RING_BYTES;
constexpr int MISC_OFF = LDSCTL_OFF + 64;
constexpr int LMETA_OFF = LDSCTL_OFF + 256;
constexpr int LDS_BYTES = 147456;
constexpr int CW_TMO = 0, CW_BAR = 4096;

#define XB_TMO      128
#define XB_XCNT(j)  (256  + 64 * (j))
#define XB_XSUB(j)  (1280 + 64 * (j))
#define XB_XGEN(j)  (2304 + 64 * (j))
#define XB_TOP      3328
#define XB_TOPGEN   3392
#define XCD_BAR_WORDS 3456
#define XB_SPIN_CAP (1u << 18)
__device__ __forceinline__ unsigned xb_ld(unsigned* p)              { return __hip_atomic_load(p, __ATOMIC_RELAXED, __HIP_MEMORY_SCOPE_AGENT); }
__device__ __forceinline__ unsigned xb_add(unsigned* p, unsigned v) { return __hip_atomic_fetch_add(p, v, __ATOMIC_RELAXED, __HIP_MEMORY_SCOPE_AGENT); }
__device__ __forceinline__ unsigned xb_xcc_id() { return (unsigned)__builtin_amdgcn_s_getreg((3 << 11) | 20) & 0xFu; }
#define XB_SPIN(cond, bar) do { unsigned _sp = 0; while (cond) { __builtin_amdgcn_s_sleep(1); \
    if ((++_sp & 255u) == 0u) { if (xb_ld(&(bar)[XB_TMO])) break; if (_sp > XB_SPIN_CAP) { atomicAdd(&(bar)[XB_TMO], 1u); break; } } } } while (0)
struct XcdBarrier { unsigned* bar; unsigned x; volatile LAS unsigned* st; };
__device__ __forceinline__ XcdBarrier xcd_barrier_post(unsigned* bar, volatile LAS unsigned* st) {
    XcdBarrier b; b.bar = bar; b.x = xb_xcc_id(); b.st = st;
    if (threadIdx.x == 0) (void)xb_add(&bar[XB_XCNT(b.x)], 1u);
    return b;
}
__device__ __forceinline__ void xcd_barrier_complete(unsigned* bar, unsigned x, unsigned& nloc, unsigned& nx) {
    const unsigned G = gridDim.x * gridDim.y * gridDim.z;
    unsigned sum, cnt, mine, sp = 0u;
    for (;;) {
        sum = 0u; cnt = 0u; mine = 0u;
#pragma unroll
        for (unsigned j = 0; j < 16; ++j) { const unsigned c = xb_ld(&bar[XB_XCNT(j)]); sum += c; cnt += (c > 0u) ? 1u : 0u; mine = (j == x) ? c : mine; }
        if (sum == G) break;
        __builtin_amdgcn_s_sleep(1);
        if ((++sp & 255u) == 0u) { if (xb_ld(&bar[XB_TMO])) break; if (sp > XB_SPIN_CAP) { atomicAdd(&bar[XB_TMO], 1u); break; } }
    }
    nloc = mine > 0u ? mine : 1u; nx = cnt > 0u ? cnt : 1u;
}
__device__ __forceinline__ void xcd_barrier(const XcdBarrier& b) {
    asm volatile("s_waitcnt vmcnt(0)" ::: "memory");
    __syncthreads();
    if (threadIdx.x == 0) {
        unsigned* bar = b.bar;
        __builtin_amdgcn_s_waitcnt(0);
        unsigned nloc = b.st[0], nx = b.st[1];
        if (nloc == 0u) { xcd_barrier_complete(bar, b.x, nloc, nx); b.st[0] = nloc; b.st[1] = nx; }
        const unsigned old = xb_add(&bar[XB_XSUB(b.x)], 1u);
        const unsigned gen = old / nloc;
        if (old + 1u == (gen + 1u) * nloc) {
            __builtin_amdgcn_fence(__ATOMIC_RELEASE, "agent");
            asm volatile("s_waitcnt vmcnt(0)" ::: "memory");
            const unsigned og = xb_add(&bar[XB_TOP], 1u);
            const unsigned tg = og / nx;
            if (og + 1u == (tg + 1u) * nx) xb_add(&bar[XB_TOPGEN], 1u);
            else XB_SPIN(xb_ld(&bar[XB_TOPGEN]) == tg, bar);
            __builtin_amdgcn_fence(__ATOMIC_ACQUIRE, "agent");
            xb_add(&bar[XB_XGEN(b.x)], 1u);
            asm volatile("s_waitcnt vmcnt(0)" ::: "memory");
        } else {
            XB_SPIN(xb_ld(&bar[XB_XGEN(b.x)]) == gen, bar);
            __builtin_amdgcn_fence(__ATOMIC_ACQUIRE, "agent");
            asm volatile("s_waitcnt vmcnt(0)" ::: "memory");
        }
    }
    __syncthreads();
}

struct Args { const float* in[21]; float* out; unsigned char* ws; int ph_lo, ph_hi; };
struct Frame {
    LAS unsigned char* lds; volatile LAS unsigned* MISC; LAS int* LM; gu32* ctl;
    int tid, lane, wave, vcu, G;
    const float *x, *c, *w_ada, *b_ada, *g1, *w_in, *sinks, *w_pool, *pool_scale, *w_ab, *w_pb, *w_out, *g2, *w_rg, *b_rg, *w_re, *b_re, *w_eg, *w_eu, *w_ed, *fg;
    float* out; unsigned char* ws;
};

__device__ __forceinline__ unsigned pk2(float lo, float hi) { return f2bf(lo) | (f2bf(hi) << 16); }
__device__ __forceinline__ void p0_transpose_item(const float* W, int N, bf16* WT, int dpitch, int drow0, int k0, int n0, LAS float* scr, int lane) {
#pragma unroll 8
    for (int i = 0; i < 32; ++i) { const int kk = 2 * i + (lane >> 5); scr[kk * 33 + (lane & 31)] = W[(size_t)(k0 + kk) * N + n0 + (lane & 31)]; }
    LDS_WAIT(); asm volatile("" ::: "memory");
    const int c = lane & 7;
#pragma unroll
    for (int j = 0; j < 4; ++j) { const int n = (lane >> 3) + 8 * j; const LAS float* s = scr + (8 * c) * 33 + n;
        v4u o; o.x = pk2(s[0 * 33], s[1 * 33]); o.y = pk2(s[2 * 33], s[3 * 33]); o.z = pk2(s[4 * 33], s[5 * 33]); o.w = pk2(s[6 * 33], s[7 * 33]);
        *(GAS v4u*)(WT + (size_t)(drow0 + n) * dpitch + k0 + 8 * c) = o; }
    LDS_WAIT(); asm volatile("" ::: "memory");
}
__device__ __forceinline__ void p0_prologue(Frame& F) {
    LAS float* scr = (LAS float*)(F.lds + RING_OFF + F.wave * 16384);
    const int gw = F.vcu * NWAVES + F.wave, NGW = F.G * NWAVES, lane = F.lane;
    float* ADAP = (float*)(F.ws + WS_ADAP);
    for (int task = gw; task < ADA_SL * 48; task += NGW) { const int ks = task / 48, j = (task % 48) * 256 + 4 * lane; constexpr int KS = D / ADA_SL;
        f32x4 a0 = {0.f, 0.f, 0.f, 0.f}, a1 = {0.f, 0.f, 0.f, 0.f};
#pragma unroll 8
        for (int k = ks * KS; k < ks * KS + KS; ++k) { const f32x4 w = *(const f32x4*)(F.w_ada + (size_t)k * NADA + j); a0 += w * F.c[k]; a1 += w * F.c[D + k]; }
        *(f32x4*)(ADAP + ((size_t)ks * 2 + 0) * NADA + j) = a0; *(f32x4*)(ADAP + ((size_t)ks * 2 + 1) * NADA + j) = a1; }
    constexpr int I_IN = (D / 64) * (NPROJ / 32), I_BR = (1024 / 64) * (D / 32), I_OUT = (D / 64) * (D / 32), I_POOL = 4 * (256 / 64) * (256 / 32);
    constexpr int I_GE = (D / 64) * (FF / 32), I_DN = (FF / 64) * (D / 32);
    constexpr int NITEMS = I_IN + 2 * I_BR + I_OUT + I_POOL + NEXP * (2 * I_GE + I_DN);
    bf16* WIN = (bf16*)(F.ws + WS_WIN); bf16* WPB = (bf16*)(F.ws + WS_WPB); bf16* WAB = (bf16*)(F.ws + WS_WAB); bf16* WOUT = (bf16*)(F.ws + WS_WOUT);
    bf16* WPOOL = (bf16*)(F.ws + WS_WPOOL); bf16* WGU = (bf16*)(F.ws + WS_WGU); bf16* WDN = (bf16*)(F.ws + WS_WDN);
    for (int it = gw; it < NITEMS; it += NGW) {
        int r = it;
        if (r < I_IN) { const int nb = NPROJ / 32, k0 = 64 * (r / nb), n0 = 32 * (r % nb); p0_transpose_item(F.w_in, NPROJ, WIN, D, n0, k0, n0, scr, lane); continue; } r -= I_IN;
        if (r < I_BR) { const int nb = D / 32, k0 = 64 * (r / nb), n0 = 32 * (r % nb); p0_transpose_item(F.w_pb, D, WPB, 1024, n0, k0, n0, scr, lane); continue; } r -= I_BR;
        if (r < I_BR) { const int nb = D / 32, k0 = 64 * (r / nb), n0 = 32 * (r % nb); p0_transpose_item(F.w_ab, D, WAB, 1024, n0, k0, n0, scr, lane); continue; } r -= I_BR;
        if (r < I_OUT) { const int nb = D / 32, k0 = 64 * (r / nb), n0 = 32 * (r % nb); p0_transpose_item(F.w_out, D, WOUT, D, n0, k0, n0, scr, lane); continue; } r -= I_OUT;
        if (r < I_POOL) { const int g = r / 32, q = r % 32, k0 = 64 * (q / 8), n0 = 32 * (q % 8); p0_transpose_item(F.w_pool + (size_t)g * 65536, 256, WPOOL + (size_t)g * 65536, 256, n0, k0, n0, scr, lane); continue; } r -= I_POOL;
        if (r < NEXP * I_GE) { const int e = r / I_GE, q = r % I_GE, nb = FF / 32, k0 = 64 * (q / nb), n0 = 32 * (q % nb);
            p0_transpose_item(F.w_eg + (size_t)e * D * FF, FF, WGU + (size_t)e * 1024 * D, D, (n0 >> 7) * 256 + (n0 & 127), k0, n0, scr, lane); continue; } r -= NEXP * I_GE;
        if (r < NEXP * I_GE) { const int e = r / I_GE, q = r % I_GE, nb = FF / 32, k0 = 64 * (q / nb), n0 = 32 * (q % nb);
            p0_transpose_item(F.w_eu + (size_t)e * D * FF, FF, WGU + (size_t)e * 1024 * D, D, (n0 >> 7) * 256 + 128 + (n0 & 127), k0, n0, scr, lane); continue; } r -= NEXP * I_GE;
        { const int e = r / I_DN, q = r % I_DN, nb = D / 32, k0 = 64 * (q / nb), n0 = 32 * (q % nb);
            p0_transpose_item(F.w_ed + (size_t)e * FF * D, D, WDN + (size_t)e * D * FF, FF, n0, k0, n0, scr, lane); }
    }
}
__device__ __forceinline__ void p0b_h1(Frame& F) {
    const float* ADAP = (const float*)(F.ws + WS_ADAP); float* ADA = (float*)(F.ws + WS_ADA); bf16* H1 = (bf16*)(F.ws + WS_B);
    LAS float* gsL = (LAS float*)(F.lds + RING_OFF);
    LAS float* shL = gsL + 2 * D;
    for (int i = F.tid; i < 2 * D; i += NWAVES * 64) { const int b = i / D, d = i % D; float sh = F.b_ada[d], sc = F.b_ada[D + d];
#pragma unroll 4
        for (int ks = 0; ks < ADA_SL; ++ks) { sh += ADAP[((size_t)ks * 2 + b) * NADA + d]; sc += ADAP[((size_t)ks * 2 + b) * NADA + D + d]; }
        gsL[i] = F.g1[d] * (1.f + sc); shL[i] = sh; }
    { const int i = F.vcu * (NWAVES * 64) + F.tid; if (i < 2 * NADA) { const int b = i / NADA, j = i % NADA; float s = F.b_ada[j];
        for (int ks = 0; ks < ADA_SL; ++ks) s += ADAP[((size_t)ks * 2 + b) * NADA + j]; ADA[i] = s; } }
    LDS_WAIT(); __syncthreads();
    const int gw = F.vcu * NWAVES + F.wave, NGW = F.G * NWAVES, lane = F.lane;
    for (int row = gw; row < T; row += NGW) { const int b = row / SEQ;
        const GAS f32x4* xr = (const GAS f32x4*)(F.x + (size_t)row * D) + lane;
        f32x4 v[8]; float ss = 0.f;
#pragma unroll
        for (int j = 0; j < 8; ++j) { v[j] = xr[64 * j]; ss += (v[j].x * v[j].x + v[j].y * v[j].y) + (v[j].z * v[j].z + v[j].w * v[j].w); }
        const float rstd = rsqrtf(wave_sum(ss) * (1.0f / D) + EPS);
#pragma unroll
        for (int j = 0; j < 8; ++j) { const int d = 4 * lane + 256 * j; const f32x4 gs = *(const LAS f32x4*)(gsL + b * D + d), sh = *(const LAS f32x4*)(shL + b * D + d);
            const f32x4 o = v[j] * rstd * gs + sh; v2u w; w.x = pk2(o.x, o.y); w.y = pk2(o.z, o.w);
            *(GAS v2u*)(H1 + (size_t)row * D + d) = w; } }
    __syncthreads();
}

constexpr int AT_K = 0, AT_V = 24576, AT_WS = 49152, AT_OST = AT_WS + 2048, AT_BYTES = AT_OST + 32768;
__device__ __forceinline__ int crow(int r, int hi) { return (r & 3) + 8 * (r >> 2) + 4 * hi; }
__device__ __forceinline__ unsigned cvtpk_s(float lo, float hi) { typedef float f32x2_t __attribute__((ext_vector_type(2))); typedef __bf16 bf16x2_t __attribute__((ext_vector_type(2)));
    f32x2_t v = {lo, hi}; bf16x2_t b = __builtin_convertvector(v, bf16x2_t); return __builtin_bit_cast(unsigned, b); }
typedef short v4i16_t __attribute__((ext_vector_type(4)));
__device__ __forceinline__ s16x4 vtr(LAS const unsigned char* p) { return __builtin_bit_cast(s16x4, __builtin_amdgcn_ds_read_tr16_b64_v4i16((LAS v4i16_t*)p)); }
__device__ __forceinline__ void attn_unit(Frame& F, int unit) {
    const bf16* P = (const bf16*)(F.ws + WS_PROJ); bf16* AP = (bf16*)(F.ws + WS_B);
    const int tid = F.tid, lane = F.lane, wid = F.wave, r32 = lane & 31, hi = lane >> 5;
    const int qb = unit & 127, kvh = (unit >> 7) & 3, b = unit >> 9, q0 = qb * 64;
    LAS unsigned char* L = F.lds + RING_OFF;
    { const int key = tid >> 3, ch = tid & 7;
        v4u kv[3], vv[3];
#pragma unroll
        for (int t = 0; t < 3; ++t) { int kpos = q0 - 128 + 64 * t + key; if (kpos < 0) kpos = 0;
            const bf16* rp = P + ((size_t)b * SEQ + kpos) * NPROJ + kvh * 64 + ch * 8;
            kv[t] = *(const GAS v4u*)(rp + C_K); vv[t] = *(const GAS v4u*)(rp + C_V); }
#pragma unroll
        for (int t = 0; t < 3; ++t) {
            *(LAS v4u*)(L + AT_K + t * 8192 + ch * 1024 + key * 16) = kv[t];
            *(LAS v4u*)(L + AT_V + t * 8192 + ((ch >> 2) * 4 + (key >> 4)) * 1024 + (key & 15) * 64 + (ch & 3) * 16) = vv[t]; } }
    const int hq = kvh * 4 + (wid & 3), rh = wid >> 2;
    const size_t qrow = (size_t)b * SEQ + q0 + 32 * rh + r32;
    bf16x8 qr[4];
#pragma unroll
    for (int d0 = 0; d0 < 4; ++d0) qr[d0] = *(const GAS bf16x8*)(P + qrow * NPROJ + C_Q + hq * 64 + d0 * 16 + hi * 8);
    const float sink2 = F.sinks[hq] * LOG2E;
    LDS_WAIT(); __syncthreads();
    f32x16 p[3][2];
#pragma unroll
    for (int t = 0; t < 3; ++t)
#pragma unroll
        for (int hf = 0; hf < 2; ++hf) { f32x16 a = {};
#pragma unroll
            for (int d0 = 0; d0 < 4; ++d0) { const bf16x8 kf = *(const LAS bf16x8*)(L + AT_K + t * 8192 + (2 * d0 + hi) * 1024 + (hf * 32 + r32) * 16);
                a = __builtin_amdgcn_mfma_f32_32x32x16_bf16(kf, qr[d0], a, 0, 0, 0); }
            p[t][hf] = a; }
    float mx = sink2;
#pragma unroll
    for (int t = 0; t < 3; ++t) { const bool tile_ok = (q0 - 128 + 64 * t) >= 0;
#pragma unroll
        for (int hf = 0; hf < 2; ++hf) { const float basef = tile_ok ? (float)(128 + 32 * rh + r32 - 64 * t - 32 * hf - 4 * hi) : 300.0f;
#pragma unroll
            for (int r = 0; r < 16; ++r) { const float x = basef - (float)((r & 3) + 8 * (r >> 2)); const float v = fmaxf(fmaxf(-x, x - 127.0f), 0.0f);
                const float s = __builtin_fmaf(v, -1e30f, p[t][hf][r]); p[t][hf][r] = s; mx = fmaxf(mx, s); } } }
    mx = fmaxf(mx, __shfl_xor(mx, 32));
    float lsum = 0.f;
#pragma unroll
    for (int t = 0; t < 3; ++t)
#pragma unroll
        for (int hf = 0; hf < 2; ++hf)
#pragma unroll
            for (int r = 0; r < 16; ++r) { const float e = __builtin_amdgcn_exp2f(p[t][hf][r] - mx); p[t][hf][r] = e; lsum += e; }
    lsum += __shfl_xor(lsum, 32);
    lsum += __builtin_amdgcn_exp2f(sink2 - mx);
    f32x16 o[2]; o[0] = f32x16{}; o[1] = f32x16{};
    const int vb = AT_V + ((lane >> 4) & 1) * 32 + (lane & 3) * 8 + (4 * hi + ((lane & 15) >> 2)) * 64;
#pragma unroll
    for (int t = 0; t < 3; ++t) {
        v4u pw[4];
#pragma unroll
        for (int ks = 0; ks < 4; ++ks) { const int hf = ks >> 1, rb = (ks & 1) * 8;
            pw[ks].x = cvtpk_s(p[t][hf][rb + 0], p[t][hf][rb + 1]); pw[ks].y = cvtpk_s(p[t][hf][rb + 2], p[t][hf][rb + 3]);
            pw[ks].z = cvtpk_s(p[t][hf][rb + 4], p[t][hf][rb + 5]); pw[ks].w = cvtpk_s(p[t][hf][rb + 6], p[t][hf][rb + 7]); }
#pragma unroll
        for (int d0 = 0; d0 < 2; ++d0)
#pragma unroll
            for (int ks = 0; ks < 4; ++ks) { const s16x4 lo = vtr(L + vb + t * 8192 + d0 * 4096 + ks * 1024), hh = vtr(L + vb + t * 8192 + d0 * 4096 + ks * 1024 + 512);
                const bf16x8 vf = {lo[0], lo[1], lo[2], lo[3], hh[0], hh[1], hh[2], hh[3]};
                o[d0] = __builtin_amdgcn_mfma_f32_32x32x16_bf16(__builtin_bit_cast(bf16x8, pw[ks]), vf, o[d0], 0, 0, 0); }
        __builtin_amdgcn_sched_barrier(0); }
    LAS float* wsf = (LAS float*)(L + AT_WS) + wid * 64;
    if (hi == 0) wsf[r32] = lsum;
    LDS_WAIT();
    LAS bf16* stg = (LAS bf16*)(L + AT_OST) + wid * 2048;
#pragma unroll
    for (int r = 0; r < 16; ++r) { const int orow = crow(r, hi); const float rl = __builtin_amdgcn_rcpf(wsf[orow]);
#pragma unroll
        for (int d0 = 0; d0 < 2; ++d0) stg[orow * 64 + d0 * 32 + r32] = (bf16)f2bf(o[d0][r] * rl); }
    LDS_WAIT();
    bf16* Ow = AP + ((size_t)b * SEQ + q0 + 32 * rh) * D + 1024 + hq * 64;
#pragma unroll
    for (int i = 0; i < 4; ++i) { const int row = i * 8 + (lane >> 3), ch = lane & 7; const v4u v = *(const LAS v4u*)(stg + row * 64 + ch * 8); *(GAS v4u*)(Ow + (size_t)row * D + ch * 8) = v; }
    LDS_WAIT(); __syncthreads();
}
__device__ __forceinline__ void pooled_unit(Frame& F, int pm, int g) {
    const bf16* P = (const bf16*)(F.ws + WS_PROJ); bf16* PO = (bf16*)(F.ws + WS_C);
    const int chq = F.tid & 127, seg = F.tid >> 7, w = 2 << g;
    const int r0 = pm * 256 + seg * 64, t0 = r0 % SEQ;
    const bf16* up = P + C_U + 256 * g + 2 * chq;
    float s0 = 0.f, s1 = 0.f;
    for (int i = 1; i < w; ++i) if (t0 - i >= 0) { const unsigned v = *(const GAS unsigned*)(up + (size_t)(r0 - i) * NPROJ); s0 += bflo(v); s1 += bfhi(v); }
#pragma unroll 4
    for (int i = 0; i < 64; ++i) { const int row = r0 + i, t = t0 + i; const unsigned v = *(const GAS unsigned*)(up + (size_t)row * NPROJ); const float u0 = bflo(v), u1 = bfhi(v);
        s0 += u0; s1 += u1; const float cnt = (float)((t + 1) < w ? (t + 1) : w);
        *(GAS unsigned*)(PO + (size_t)row * 1024 + 256 * g + 2 * chq) = pk2(s0 / cnt - u0, s1 / cnt - u1);
        if (t - w + 1 >= 0) { const unsigned o = *(const GAS unsigned*)(up + (size_t)(row - w + 1) * NPROJ); s0 -= bflo(o); s1 -= bfhi(o); } }
}

__device__ __forceinline__ void p5b_fill(Frame& F) {
    unsigned char* rt = F.ws + WS_RT;
    const int* TOKE = (const int*)(rt + RT_TOKE); const float* TOKW = (const float*)(rt + RT_TOKW); const int* LRANK = (const int*)(rt + RT_LRANK); int* TOKSLOT = (int*)(rt + RT_TOKSLOT);
    const int* BLKCNT = (const int*)(rt + RT_BLKCNT); int* SLOTTOK = (int*)(rt + RT_SLOTTOK); float* SLOTW = (float*)(rt + RT_SLOTW); int* META = (int*)(rt + RT_META);
    LAS int* cntL = (LAS int*)(F.lds + RING_OFF);
    LAS int* totL = cntL + 4096;
    for (int i = F.tid; i < 4096; i += NWAVES * 64) cntL[i] = BLKCNT[i];
    LDS_WAIT(); __syncthreads();
    for (int blk = F.vcu; blk < 256; blk += F.G) {
        { const int e = F.tid >> 5, s = F.tid & 31; int pt = 0, pb = 0;
            for (int bb = 8 * s; bb < 8 * s + 8; ++bb) { const int c = cntL[bb * 16 + e]; pt += c; pb += (bb < blk) ? c : 0; }
#pragma unroll
            for (int o = 1; o < 32; o <<= 1) { pt += __shfl_xor(pt, o); pb += __shfl_xor(pb, o); }
            if (s == 0) { totL[e] = pt; totL[16 + e] = pb; } }
        LDS_WAIT(); __syncthreads();
        if (F.tid == 0) { int o = 0, nt = 0; for (int e = 0; e < 16; ++e) { totL[32 + e] = o; const int tl = (totL[e] + 255) >> 8;
                if (F.vcu == 0 && blk == 0) { META[e] = o; for (int i = 0; i < tl; ++i) META[32 + nt + i] = e; } nt += tl; o += tl * 256; }
            totL[48] = o; if (F.vcu == 0 && blk == 0) { META[16] = o; META[17] = o; META[18] = nt; } }
        LDS_WAIT(); __syncthreads();
        if (F.tid < 128) { const int i = blk * 128 + F.tid, e = TOKE[i]; const int slot = totL[32 + e] + totL[16 + e] + LRANK[i];
            SLOTTOK[slot] = i >> 1; SLOTW[slot] = TOKW[i]; TOKSLOT[i] = slot; }
        if (blk < 16) { const int e = blk; for (int s = totL[32 + e] + totL[e] + F.tid; s < totL[32 + e + 1]; s += NWAVES * 64) { SLOTTOK[s] = 0; SLOTW[s] = 0.f; } }
        __syncthreads();
    }
}

__global__ void __launch_bounds__(NWAVES * 64, 2) mk_fwd(Args args) {
    extern __shared__ __attribute__((aligned(16))) unsigned char lds[];
    Frame F;
    F.lds = (LAS unsigned char*)lds; F.MISC = (volatile LAS unsigned*)(F.lds + MISC_OFF); F.LM = (LAS int*)(F.lds + LMETA_OFF);
    F.tid = threadIdx.x; F.lane = F.tid & 63; F.wave = __builtin_amdgcn_readfirstlane(F.tid >> 6);
    F.G = gridDim.x; { const int bx = blockIdx.x; F.vcu = (F.G % 8 == 0) ? (bx % 8) * (F.G / 8) + bx / 8 : bx; }
    F.ws = args.ws; F.out = args.out; F.ctl = (gu32*)(args.ws + WS_CTL);
    F.x = args.in[0]; F.c = args.in[1]; F.w_ada = args.in[2]; F.b_ada = args.in[3]; F.g1 = args.in[4]; F.w_in = args.in[5]; F.sinks = args.in[6]; F.w_pool = args.in[7];
    F.pool_scale = args.in[8]; F.w_ab = args.in[9]; F.w_pb = args.in[10]; F.w_out = args.in[11]; F.g2 = args.in[12]; F.w_rg = args.in[13]; F.b_rg = args.in[14]; F.w_re = args.in[15];
    F.b_re = args.in[16]; F.w_eg = args.in[17]; F.w_eu = args.in[18]; F.w_ed = args.in[19]; F.fg = args.in[20];
    for (int u = F.tid; u < (LDS_BYTES - LDSCTL_OFF) / 4; u += NWAVES * 64) ((LAS unsigned*)(F.lds + LDSCTL_OFF))[u] = 0u;
    __syncthreads();
    const int lo = args.ph_lo, hi = args.ph_hi;
    XcdBarrier bar; bar.bar = (unsigned*)(F.ctl + CW_BAR); bar.x = 0; bar.st = nullptr;
    if (hi - lo > 1) bar = xcd_barrier_post((unsigned*)(F.ctl + CW_BAR), F.MISC);
#ifndef ENMASK
#define ENMASK 0x7FF
#endif
#define IN(k) (((ENMASK >> (k)) & 1) && lo <= (k) && (k) < hi)
#define SEAM(k) do { if (IN(k) && IN((k) + 1)) xcd_barrier(bar); } while (0)
    unsigned char* ws = args.ws; float* ADA = (float*)(ws + WS_ADA);
    bf16* PROJ = (bf16*)(ws + WS_PROJ); bf16* BUFB = (bf16*)(ws + WS_B); bf16* BUFC = (bf16*)(ws + WS_C);
    unsigned char* rt = ws + WS_RT;

    if (IN(0)) { p0_prologue(F); } SEAM(0);
    if (IN(1)) { p0b_h1(F); } SEAM(1);
    if (IN(2)) {
        pg8::Gemm g{BUFB, (const bf16*)(ws + WS_WIN), D, D, D, 0, nullptr}; pg8::StaticOrder S; S.init(T, NPROJ, F.G, (int)blockIdx.x);
        pg8::gemm_phase<pg8::EpProj, pg8::StaticOrder, false>(F.lds + RING_OFF, g, S, pg8::EpProj{PROJ});
    } SEAM(2);
    if (IN(3)) {
#ifndef NO_ATTN
        for (int u = F.vcu; u < BATCH * 4 * (SEQ / 64); u += F.G) attn_unit(F, u);
#endif
#ifndef NO_POOL
        for (int u = F.vcu; u < 256; u += F.G) { const int pm = u >> 2, g = u & 3;
            pooled_unit(F, pm, g);
            VM_WAIT(); __syncthreads();
            if (F.tid == 0) { __builtin_amdgcn_fence(__ATOMIC_ACQUIRE, "agent"); VM_WAIT(); }
            __syncthreads();
            pg8::Gemm gg{BUFC + 256 * g, (const bf16*)(ws + WS_WPOOL), 1024, 256, 256, 65536, nullptr};
            pg8::OneUnit S{{pm, 0, g}};
            pg8::gemm_phase<pg8::EpPoolMix, pg8::OneUnit, false>(F.lds + RING_OFF, gg, S, pg8::EpPoolMix{BUFB, F.pool_scale}); }
#endif
    } SEAM(3);
    if (IN(4)) {
        { pg8::Gemm g{BUFB, (const bf16*)(ws + WS_WPB), D, 1024, 1024, 0, nullptr}; pg8::StaticOrder S; S.init(T, D, F.G, (int)blockIdx.x);
          pg8::gemm_phase<pg8::EpT1, pg8::StaticOrder, false>(F.lds + RING_OFF, g, S, pg8::EpT1{BUFC, PROJ}); }
        VM_WAIT(); __syncthreads();
        { pg8::Gemm g{BUFB + 1024, (const bf16*)(ws + WS_WAB), D, 1024, 1024, 0, nullptr}; pg8::StaticOrder S; S.init(T, D, F.G, (int)blockIdx.x);
          pg8::gemm_phase<pg8::EpMerged, pg8::StaticOrder, false>(F.lds + RING_OFF, g, S, pg8::EpMerged{BUFC, PROJ}); }
    } SEAM(4);
    if (IN(5)) {
        pg8::Gemm g{BUFC, (const bf16*)(ws + WS_WOUT), D, D, D, 0, nullptr}; pg8::StaticOrder S; S.init(T, D, F.G, (int)blockIdx.x);
        pg8::gemm_phase<pg8::EpX1, pg8::StaticOrder, false>(F.lds + RING_OFF, g, S, pg8::EpX1{F.x, F.out, ADA, (float*)(ws + WS_SSQ)});
    } SEAM(5);
    if (IN(6)) {
        LAS int* eL = (LAS int*)(F.lds + RING_OFF);
        for (int blk = F.vcu; blk < 256; blk += F.G) {
            for (int i = 0; i < 8; ++i) { const int rl = F.wave * 8 + i, row = blk * 64 + rl; float w1, w2;
                const int ee = route_row(F.out, (const float*)(ws + WS_SSQ), F.g2, ADA, F.w_rg, F.b_rg, F.w_re, F.b_re, BUFB, row, F.lane, w1, w2);
                if (F.lane == 0) { eL[rl] = ee; ((int*)(rt + RT_TOKE))[row * 2] = ee & 255; ((int*)(rt + RT_TOKE))[row * 2 + 1] = ee >> 8;
                    ((float*)(rt + RT_TOKW))[row * 2] = w1; ((float*)(rt + RT_TOKW))[row * 2 + 1] = w2; } }
            LDS_WAIT(); __syncthreads();
            if (F.wave == 0) { const int ee = eL[F.lane]; int r1, r2; hist_wave(ee & 255, ee >> 8, F.lane, blk, (int*)(rt + RT_BLKCNT), r1, r2);
                ((int*)(rt + RT_LRANK))[(blk * 64 + F.lane) * 2] = r1; ((int*)(rt + RT_LRANK))[(blk * 64 + F.lane) * 2 + 1] = r2; }
            __syncthreads(); }
    } SEAM(6);
    if (IN(7)) { p5b_fill(F); } SEAM(7);
    if (IN(8) || IN(9)) {
        for (int i = F.tid; i < 256; i += NWAVES * 64) F.LM[i] = ((const int*)(rt + RT_META))[i];
        LDS_WAIT(); __syncthreads();
    }
    if (IN(8)) {
        pg8::Gemm g{BUFB, (const bf16*)(ws + WS_WGU), D, D, D, (size_t)1024 * D, (const int*)(rt + RT_SLOTTOK)};
        pg8::DynOrder S{F.LM[18] * 4, 4, F.G, F.vcu, F.LM + 32};
        pg8::gemm_phase<pg8::EpAct, pg8::DynOrder, true>(F.lds + RING_OFF, g, S, pg8::EpAct{(bf16*)(ws + WS_ACT), (const float*)(rt + RT_SLOTW)});
    } SEAM(8);
    if (IN(9)) {
        pg8::Gemm g{(const bf16*)(ws + WS_ACT), (const bf16*)(ws + WS_WDN), FF, FF, FF, (size_t)D * FF, nullptr};
        pg8::DynOrder S{F.LM[18] * 8, 8, F.G, F.vcu, F.LM + 32};
        pg8::gemm_phase<pg8::EpY, pg8::DynOrder, false>(F.lds + RING_OFF, g, S, pg8::EpY{(bf16*)(ws + WS_Y)});
    } SEAM(9);
    if (IN(10)) {
        const int gw = F.vcu * NWAVES + F.wave, NGW = F.G * NWAVES;
        for (int row = gw; row < T; row += NGW) final_row(F.out, (const bf16*)(ws + WS_Y), (const int*)(rt + RT_TOKSLOT), ADA, F.fg, row, F.lane);
    }
#undef IN
#undef SEAM
}

#ifndef FASTMASK
#define FASTMASK 0x7FF
#endif
#ifndef ONE_LAUNCH
#define ONE_LAUNCH 1
#endif
constexpr int NPHASE = 11;
extern "C" void kernel_launch(void* const* d_in, const int* in_sizes, int n_in, void* d_out, int out_size, void* d_ws, size_t ws_size, hipStream_t stream) {
    if (n_in != 21 || out_size != T * D || ws_size < WS_END) { fprintf(stderr, "kernel_launch: unexpected shapes (n_in %d out %d ws %zu)\n", n_in, out_size, ws_size); return; }
    static int grid = 0;
    if (grid == 0) {
        int dev = 0, cus = 0, per_cu = 0;
        if (hipGetDevice(&dev) != hipSuccess || hipDeviceGetAttribute(&cus, hipDeviceAttributeMultiprocessorCount, dev) != hipSuccess) { fprintf(stderr, "kernel_launch: device query failed\n"); grid = -1; return; }
        if (hipFuncSetAttribute((const void*)mk_fwd, hipFuncAttributeMaxDynamicSharedMemorySize, LDS_BYTES) != hipSuccess) { fprintf(stderr, "kernel_launch: hipFuncSetAttribute failed\n"); grid = -1; return; }
        if (hipOccupancyMaxActiveBlocksPerMultiprocessor(&per_cu, (const void*)mk_fwd, NWAVES * 64, LDS_BYTES) != hipSuccess || per_cu < 1) { fprintf(stderr, "kernel_launch: occupancy query says %d\n", per_cu); }
        (void)hipGetLastError();
        grid = cus;
    }
    if (grid < 0) return;
    const float* x = (const float*)d_in[0]; const float* c = (const float*)d_in[1]; const float* w_ada = (const float*)d_in[2]; const float* b_ada = (const float*)d_in[3];
    const float* norm1_g = (const float*)d_in[4]; const float* w_in = (const float*)d_in[5]; const float* sinks = (const float*)d_in[6]; const float* w_pool = (const float*)d_in[7];
    const float* pool_scale = (const float*)d_in[8]; const float* w_ab = (const float*)d_in[9]; const float* w_pb = (const float*)d_in[10]; const float* w_out = (const float*)d_in[11];
    const float* norm2_g = (const float*)d_in[12]; const float* w_rg = (const float*)d_in[13]; const float* b_rg = (const float*)d_in[14]; const float* w_re = (const float*)d_in[15];
    const float* b_re = (const float*)d_in[16]; const float* w_eg = (const float*)d_in[17]; const float* w_eu = (const float*)d_in[18]; const float* w_ed = (const float*)d_in[19];
    const float* final_g = (const float*)d_in[20];
    unsigned char* ws = (unsigned char*)d_ws; float* out = (float*)d_out;
    float* ADA = (float*)(ws + WS_ADA); float* ADAP = (float*)(ws + WS_ADAP); float* SSQ = (float*)(ws + WS_SSQ);
    bf16* PROJ = (bf16*)(ws + WS_PROJ); bf16* ACT = (bf16*)(ws + WS_ACT); bf16* Y = (bf16*)(ws + WS_Y);
    bf16* BUFB = (bf16*)(ws + WS_B); bf16* BUFC = (bf16*)(ws + WS_C);
    unsigned char* rt = ws + WS_RT;
    int* TOKE = (int*)(rt + RT_TOKE); float* TOKW = (float*)(rt + RT_TOKW); int* LRANK = (int*)(rt + RT_LRANK); int* TOKSLOT = (int*)(rt + RT_TOKSLOT);
    int* BLKCNT = (int*)(rt + RT_BLKCNT); int* BLKBASE = (int*)(rt + RT_BLKBASE); int* SLOTTOK = (int*)(rt + RT_SLOTTOK); float* SLOTW = (float*)(rt + RT_SLOTW); int* META = (int*)(rt + RT_META);

    (void)hipMemsetAsync(ws + WS_CTL, 0, 1 * MiB, stream);
    Args a{}; for (int i = 0; i < 21; ++i) a.in[i] = (const float*)d_in[i]; a.out = out; a.ws = ws;
    if (ONE_LAUNCH && FASTMASK == 0x7FF) { a.ph_lo = 0; a.ph_hi = NPHASE; hipLaunchKernelGGL(mk_fwd, dim3(grid), dim3(NWAVES * 64), LDS_BYTES, stream, a); return; }
    for (int ph = 0; ph < NPHASE; ++ph) {
        const bool fast = (FASTMASK >> ph) & 1;
        if (fast || (ph == 0 && (FASTMASK & 0x33C))) { a.ph_lo = ph; a.ph_hi = ph + 1; hipLaunchKernelGGL(mk_fwd, dim3(grid), dim3(NWAVES * 64), LDS_BYTES, stream, a); if (fast) continue; }
        switch (ph) {
        case 0: nv::ada_part<<<dim3(NADA / 256, ADA_SL), 256, 0, stream>>>(c, w_ada, ADAP); break;
        case 1: nv::ada_sum<<<2 * NADA / 256, 256, 0, stream>>>(ADAP, b_ada, ADA); nv::h1<<<T / 4, 256, 0, stream>>>(x, norm1_g, ADA, BUFB); break;
        case 2: nv::gemm<false><<<dim3(NPROJ / 64, T / 64), 256, 0, stream>>>(nv::ABf16{BUFB, D, 0}, nv::WPlain{w_in, NPROJ}, nv::WPlain{w_in, NPROJ}, nv::EpProj{PROJ}, D); break;
        case 3: nv::attn<<<dim3(SEQ / 16, 16, BATCH), 256, 0, stream>>>(PROJ, sinks, BUFB);
                nv::pooled<<<(unsigned)((size_t)T * 1024 / 256), 256, 0, stream>>>(PROJ, BUFC);
                for (int g = 0; g < 4; ++g) nv::gemm<false><<<dim3(256 / 64, T / 64), 256, 0, stream>>>(nv::ABf16{BUFC, 1024, g * 256}, nv::WPlain{w_pool + (size_t)g * 256 * 256, 256}, nv::WPlain{w_pool, 256}, nv::EpPool{BUFB, pool_scale, g}, 256);
                break;
        case 4: nv::gemm<false><<<dim3(D / 64, T / 64), 256, 0, stream>>>(nv::ABf16{BUFB, D, 0}, nv::WPlain{w_pb, D}, nv::WPlain{w_pb, D}, nv::EpT1{BUFC, PROJ}, 1024);
                nv::gemm<false><<<dim3(D / 64, T / 64), 256, 0, stream>>>(nv::ABf16{BUFB, D, 1024}, nv::WPlain{w_ab, D}, nv::WPlain{w_ab, D}, nv::EpMerged{BUFC, PROJ}, 1024); break;
        case 5: nv::gemm<false><<<dim3(D / 64, T / 64), 256, 0, stream>>>(nv::ABf16{BUFC, D, 0}, nv::WPlain{w_out, D}, nv::WPlain{w_out, D}, nv::EpX1{out, x, ADA}, D);
                nv::ssq<<<T / 4, 256, 0, stream>>>(out, SSQ); break;
        case 6: nv::route<<<T / 4, 256, 0, stream>>>(out, SSQ, norm2_g, ADA, w_rg, b_rg, w_re, b_re, BUFB, TOKE, TOKW); nv::hist<<<256, 64, 0, stream>>>(TOKE, BLKCNT, LRANK); break;
        case 7: nv::scan<<<1, 256, 0, stream>>>(BLKCNT, BLKBASE, META, SLOTTOK, SLOTW); nv::fill<<<2 * T / 256, 256, 0, stream>>>(TOKE, TOKW, LRANK, BLKBASE, META, SLOTTOK, SLOTW, TOKSLOT); break;
        case 8: nv::gemm<true><<<dim3(FF / 64, MAXSLOT / 64), 256, 0, stream>>>(nv::AGather{BUFB, D, SLOTTOK, META}, nv::WExpert{w_eg, FF, (size_t)D * FF, META}, nv::WExpert{w_eu, FF, (size_t)D * FF, META}, nv::EpAct{ACT, SLOTW}, D); break;
        case 9: nv::gemm<false><<<dim3(D / 64, MAXSLOT / 64), 256, 0, stream>>>(nv::ASlot{ACT, FF, META}, nv::WExpert{w_ed, D, (size_t)FF * D, META}, nv::WExpert{w_ed, D, (size_t)FF * D, META}, nv::EpY{Y}, FF); break;
        case 10: nv::final_<<<T / 4, 256, 0, stream>>>(out, Y, TOKSLOT, ADA, final_g); break;
        }
    }
}
```

```cpp
#include <hip/hip_runtime.h>
#include <stdint.h>
#include <cstdio>

constexpr int D = 2048, BATCH = 2, SEQ = 8192, T = BATCH * SEQ;
constexpr int NPROJ = 6656;
constexpr int C_Q = 0, C_K = 1024, C_V = 1280, C_U = 1536, C_GA = 2560, C_GP = 4608;
constexpr int NADA = 6 * D;
constexpr int NEXP = 16, FF = 512;
constexpr int MAXSLOT = 2 * T + NEXP * 256;
constexpr int ADA_SL = 16;
constexpr float EPS = 1e-6f;
constexpr float LOG2E = 1.4426950408889634f;
constexpr float C2 = 0.125f * LOG2E;

typedef unsigned short bf16;

constexpr size_t MiB = 1u << 20;
constexpr size_t WS_CTL = 0;
constexpr size_t WS_ADA = 1 * MiB;
constexpr size_t WS_WRT = WS_ADA + 512 * 1024;
constexpr size_t WS_LTOK = 2 * MiB;
constexpr size_t WS_LW = 3 * MiB;
constexpr size_t WS_ADAP = 2 * MiB;
constexpr size_t WS_WIN = 4 * MiB;
constexpr size_t WS_WTMP = 416 * MiB;
constexpr size_t WS_WPB = 30 * MiB;
constexpr size_t WS_WAB = 34 * MiB;
constexpr size_t WS_WOUT = 38 * MiB;
constexpr size_t WS_WPOOL = 46 * MiB;
constexpr size_t WS_WGU = 47 * MiB;
constexpr size_t WS_WDN = 111 * MiB;
constexpr size_t WS_PROJ = 144 * MiB;
constexpr size_t WS_ACT = 144 * MiB;
constexpr size_t WS_Y = 180 * MiB;
constexpr size_t WS_B = 352 * MiB;
constexpr size_t WS_C = 416 * MiB;
constexpr size_t WS_RT = 480 * MiB;
constexpr size_t WS_SSQ = 482 * MiB;
constexpr size_t WS_END = 484 * MiB;
constexpr size_t RT_TOKE = 0;
constexpr size_t RT_TOKW = RT_TOKE + (size_t)T * 2 * 4;
constexpr size_t RT_LRANK = RT_TOKW + (size_t)T * 2 * 4;
constexpr size_t RT_TOKSLOT = RT_LRANK + (size_t)T * 2 * 4;
constexpr size_t RT_BLKCNT = RT_TOKSLOT + (size_t)T * 2 * 4;
constexpr size_t RT_BLKBASE = RT_BLKCNT + 256 * 16 * 4;
constexpr size_t RT_SLOTTOK = RT_BLKBASE + 256 * 16 * 4;
constexpr size_t RT_SLOTW = RT_SLOTTOK + (size_t)MAXSLOT * 4;
constexpr size_t RT_META = RT_SLOTW + (size_t)MAXSLOT * 4;
static_assert(RT_META + 1024 * 4 <= 2 * MiB, "routing arrays");

__device__ __forceinline__ unsigned f2bf(float f) { unsigned u = __builtin_bit_cast(unsigned, f); return (u + 0x7fffu + ((u >> 16) & 1u)) >> 16; }
__device__ __forceinline__ float bf2f(unsigned h) { return __builtin_bit_cast(float, h << 16); }
__device__ __forceinline__ float bflo(unsigned w) { return __builtin_bit_cast(float, w << 16); }
__device__ __forceinline__ float bfhi(unsigned w) { return __builtin_bit_cast(float, w & 0xffff0000u); }
__device__ __forceinline__ float wave_sum(float v) {
#pragma unroll
    for (int o = 1; o < 64; o <<= 1) v += __shfl_xor(v, o);
    return v;
}
__device__ __forceinline__ float sigmoidf_(float v) { return 1.0f / (1.0f + __expf(-v)); }
__device__ __forceinline__ float sigmoid_fast(float v) { return __builtin_amdgcn_rcpf(1.0f + __builtin_amdgcn_exp2f(-LOG2E * v)); }

namespace nv {
__global__ __launch_bounds__(256) void ada_part(const float* __restrict__ c, const float* __restrict__ W, float* __restrict__ adap) {
    const int j = blockIdx.x * 256 + threadIdx.x, ks = blockIdx.y; constexpr int KS = D / ADA_SL;
    float a0 = 0.f, a1 = 0.f;
    for (int k = ks * KS; k < ks * KS + KS; ++k) { const float w = W[(size_t)k * NADA + j]; a0 += c[k] * w; a1 += c[D + k] * w; }
    adap[((size_t)ks * 2 + 0) * NADA + j] = a0; adap[((size_t)ks * 2 + 1) * NADA + j] = a1;
}
__global__ __launch_bounds__(256) void ada_sum(const float* __restrict__ adap, const float* __restrict__ bias, float* __restrict__ ada) {
    const int i = blockIdx.x * 256 + threadIdx.x;
    const int b = i / NADA, j = i % NADA; float s = bias[j];
    for (int ks = 0; ks < ADA_SL; ++ks) s += adap[((size_t)ks * 2 + b) * NADA + j];
    ada[i] = s;
}
__global__ __launch_bounds__(256) void h1(const float* __restrict__ x, const float* __restrict__ g1, const float* __restrict__ ada, bf16* __restrict__ H1) {
    const int lane = threadIdx.x & 63, row = blockIdx.x * 4 + (threadIdx.x >> 6), b = row / SEQ;
    const float4* xr = (const float4*)(x + (size_t)row * D) + lane;
    float4 v[8]; float ss = 0.f;
#pragma unroll
    for (int j = 0; j < 8; ++j) { v[j] = xr[64 * j]; ss += v[j].x * v[j].x + v[j].y * v[j].y + v[j].z * v[j].z + v[j].w * v[j].w; }
    const float rstd = rsqrtf(wave_sum(ss) * (1.0f / D) + EPS);
    const float* sh = ada + (size_t)b * NADA + 0 * D; const float* sc = ada + (size_t)b * NADA + 1 * D;
#pragma unroll
    for (int j = 0; j < 8; ++j) { const int d = 4 * lane + 256 * j;
        const float4 g = *(const float4*)(g1 + d), s = *(const float4*)(sc + d), h = *(const float4*)(sh + d);
        const float o0 = v[j].x * rstd * g.x * (1.f + s.x) + h.x, o1 = v[j].y * rstd * g.y * (1.f + s.y) + h.y;
        const float o2 = v[j].z * rstd * g.z * (1.f + s.z) + h.z, o3 = v[j].w * rstd * g.w * (1.f + s.w) + h.w;
        uint2 w; w.x = f2bf(o0) | (f2bf(o1) << 16); w.y = f2bf(o2) | (f2bf(o3) << 16);
        *(uint2*)(H1 + (size_t)row * D + d) = w; }
}
struct ABf16 { const bf16* A; long long lda; long long koff;
    __device__ bool init(int bm) { return true; }
    __device__ const bf16* rowptr(int m) const { return A + (size_t)m * lda + koff; } };
struct AGather { const bf16* A; long long lda; const int* slot_tok; const int* meta;
    __device__ bool init(int bm) { return bm < meta[17]; }
    __device__ const bf16* rowptr(int m) const { return A + (size_t)slot_tok[m] * lda; } };
struct ASlot { const bf16* A; long long lda; const int* meta;
    __device__ bool init(int bm) { return bm < meta[17]; }
    __device__ const bf16* rowptr(int m) const { return A + (size_t)m * lda; } };
struct WPlain { const float* W; long long ldw;
    __device__ const float* base(int bm) const { return W; } };
struct WExpert { const float* W; long long ldw; size_t estride; const int* meta;
    __device__ const float* base(int bm) const { return W + (size_t)meta[32 + (bm >> 8)] * estride; } };

template <bool DUAL, class AL, class WL, class EP>
__global__ __launch_bounds__(256) void gemm(AL al, WL wl, WL wl2, EP ep, long long K_) {
    const int K = (int)K_;
    __shared__ float As[16][68]; __shared__ float Ws[16][64]; __shared__ float Ws2[DUAL ? 16 : 1][64];
    const int tid = threadIdx.x, tx = tid & 15, ty = tid >> 4, bm = blockIdx.y * 64, bn = blockIdx.x * 64;
    if (!al.init(bm)) return;
    const float* Wb = wl.base(bm); const float* Wb2 = DUAL ? wl2.base(bm) : nullptr;
    const bf16* arow = al.rowptr(bm + (tid >> 2)); const int ak = (tid & 3) * 4;
    float acc[4][4], acc2[4][4];
#pragma unroll
    for (int i = 0; i < 4; ++i)
#pragma unroll
        for (int j = 0; j < 4; ++j) { acc[i][j] = 0.f; acc2[i][j] = 0.f; }
    for (int k0 = 0; k0 < K; k0 += 16) {
        const uint2 a = *(const uint2*)(arow + k0 + ak);
        As[ak + 0][tid >> 2] = bf2f(a.x & 0xffffu); As[ak + 1][tid >> 2] = bf2f(a.x >> 16); As[ak + 2][tid >> 2] = bf2f(a.y & 0xffffu); As[ak + 3][tid >> 2] = bf2f(a.y >> 16);
        *(float4*)&Ws[ty][tx * 4] = *(const float4*)(Wb + (size_t)(k0 + ty) * wl.ldw + bn + tx * 4);
        if (DUAL) *(float4*)&Ws2[ty][tx * 4] = *(const float4*)(Wb2 + (size_t)(k0 + ty) * wl.ldw + bn + tx * 4);
        __syncthreads();
#pragma unroll
        for (int kk = 0; kk < 16; ++kk) {
            const float4 av = *(const float4*)&As[kk][ty * 4]; const float4 wv = *(const float4*)&Ws[kk][tx * 4];
            const float a4[4] = {av.x, av.y, av.z, av.w}, w4[4] = {wv.x, wv.y, wv.z, wv.w};
#pragma unroll
            for (int i = 0; i < 4; ++i)
#pragma unroll
                for (int j = 0; j < 4; ++j) acc[i][j] += a4[i] * w4[j];
            if (DUAL) { const float4 wv2 = *(const float4*)&Ws2[kk][tx * 4]; const float u4[4] = {wv2.x, wv2.y, wv2.z, wv2.w};
#pragma unroll
                for (int i = 0; i < 4; ++i)
#pragma unroll
                    for (int j = 0; j < 4; ++j) acc2[i][j] += a4[i] * u4[j]; }
        }
        __syncthreads();
    }
#pragma unroll
    for (int i = 0; i < 4; ++i)
#pragma unroll
        for (int j = 0; j < 4; ++j) ep(bm + ty * 4 + i, bn + tx * 4 + j, acc[i][j], acc2[i][j]);
}
struct EpProj { bf16* P;
    __device__ void operator()(int m, int n, float v, float) const {
        if (n < C_K) v *= C2; else if (n >= C_GA) v = sigmoidf_(v);
        P[(size_t)m * NPROJ + n] = (bf16)f2bf(v); } };
struct EpPool { bf16* AP; const float* pool_scale; long long g;
    __device__ void operator()(int m, int n, float v, float) const { AP[(size_t)m * D + g * 256 + n] = (bf16)f2bf(v * pool_scale[g * 256 + n]); } };
struct EpT1 { bf16* T1; const bf16* P;
    __device__ void operator()(int m, int n, float v, float) const { T1[(size_t)m * D + n] = (bf16)f2bf(v * bf2f(P[(size_t)m * NPROJ + C_GP + n])); } };
struct EpMerged { bf16* T1; const bf16* P;
    __device__ void operator()(int m, int n, float v, float) const { const size_t o = (size_t)m * D + n; T1[o] = (bf16)f2bf(v * bf2f(P[(size_t)m * NPROJ + C_GA + n]) + bf2f(T1[o])); } };
struct EpX1 { float* X1; const float* x; const float* ada;
    __device__ void operator()(int m, int n, float v, float) const { const size_t o = (size_t)m * D + n; X1[o] = x[o] + ada[(size_t)(m / SEQ) * NADA + 2 * D + n] * v; } };
struct EpAct { bf16* ACT; const float* slot_w;
    __device__ void operator()(int m, int n, float g, float u) const { ACT[(size_t)m * FF + n] = (bf16)f2bf(g * sigmoidf_(g) * u * slot_w[m]); } };
struct EpY { bf16* Y;
    __device__ void operator()(int m, int n, float v, float) const { Y[(size_t)m * D + n] = (bf16)f2bf(v); } };

__global__ __launch_bounds__(256) void attn(const bf16* __restrict__ P, const float* __restrict__ sinks, bf16* __restrict__ AP) {
    __shared__ float Ps[16][129];
    const int tid = threadIdx.x, r = tid >> 4, part = tid & 15, h = blockIdx.y, b = blockIdx.z, kvh = h >> 2;
    const int t = blockIdx.x * 16 + r; const size_t rowq = (size_t)b * SEQ + t;
    uint4 q4[8];
#pragma unroll
    for (int c = 0; c < 8; ++c) q4[c] = *(const uint4*)(P + rowq * NPROJ + C_Q + h * 64 + c * 8);
    float s[8]; float mx = sinks[h] * LOG2E;
#pragma unroll
    for (int jj = 0; jj < 8; ++jj) { const int w = part + 16 * jj, kp = t - w; float dot = -1e30f;
        if (kp >= 0) { const bf16* kr = P + ((size_t)b * SEQ + kp) * NPROJ + C_K + kvh * 64; dot = 0.f;
#pragma unroll
            for (int c = 0; c < 8; ++c) { const uint4 k4 = *(const uint4*)(kr + c * 8);
                dot += bflo(q4[c].x) * bflo(k4.x) + bfhi(q4[c].x) * bfhi(k4.x) + bflo(q4[c].y) * bflo(k4.y) + bfhi(q4[c].y) * bfhi(k4.y)
                     + bflo(q4[c].z) * bflo(k4.z) + bfhi(q4[c].z) * bfhi(k4.z) + bflo(q4[c].w) * bflo(k4.w) + bfhi(q4[c].w) * bfhi(k4.w); } }
        s[jj] = dot; mx = fmaxf(mx, dot); }
    mx = fmaxf(mx, __shfl_xor(mx, 1)); mx = fmaxf(mx, __shfl_xor(mx, 2)); mx = fmaxf(mx, __shfl_xor(mx, 4)); mx = fmaxf(mx, __shfl_xor(mx, 8));
    float sum = 0.f;
#pragma unroll
    for (int jj = 0; jj < 8; ++jj) { const float p = exp2f(s[jj] - mx); sum += p; Ps[r][part + 16 * jj] = p; }
    sum += __shfl_xor(sum, 1); sum += __shfl_xor(sum, 2); sum += __shfl_xor(sum, 4); sum += __shfl_xor(sum, 8);
    sum += exp2f(sinks[h] * LOG2E - mx);
    __syncthreads();
    float o[4] = {0.f, 0.f, 0.f, 0.f};
    const int wmax = t < 127 ? t : 127;
    for (int w = 0; w <= wmax; ++w) { const float p = Ps[r][w]; const uint2 v2 = *(const uint2*)(P + ((size_t)b * SEQ + (t - w)) * NPROJ + C_V + kvh * 64 + part * 4);
        o[0] += p * bflo(v2.x); o[1] += p * bfhi(v2.x); o[2] += p * bflo(v2.y); o[3] += p * bfhi(v2.y); }
    const float inv = 1.0f / sum; uint2 w2; w2.x = f2bf(o[0] * inv) | (f2bf(o[1] * inv) << 16); w2.y = f2bf(o[2] * inv) | (f2bf(o[3] * inv) << 16);
    *(uint2*)(AP + rowq * D + 1024 + h * 64 + part * 4) = w2;
}
__global__ __launch_bounds__(256) void pooled(const bf16* __restrict__ P, bf16* __restrict__ PO) {
    const size_t idx = (size_t)blockIdx.x * 256 + threadIdx.x; const int row = (int)(idx >> 10), ch = (int)(idx & 1023), t = row % SEQ, g = ch >> 8, w = 2 << g;
    const int cnt = (t + 1) < w ? (t + 1) : w; float s = 0.f;
    for (int i = 0; i < cnt; ++i) s += bf2f(P[(size_t)(row - i) * NPROJ + C_U + ch]);
    PO[(size_t)row * 1024 + ch] = (bf16)f2bf(s / (float)cnt - bf2f(P[(size_t)row * NPROJ + C_U + ch]));
}
__global__ __launch_bounds__(256) void ssq(const float* __restrict__ X1, float* __restrict__ SSQ) {
    const int lane = threadIdx.x & 63, row = blockIdx.x * 4 + (threadIdx.x >> 6);
    const float* xr = X1 + (size_t)row * D;
    for (int p = 0; p < 32; ++p) { const float v = xr[64 * p + lane]; const float s = wave_sum(v * v); if (lane == 0) SSQ[(size_t)row * 32 + p] = s; }
}
}

__device__ __forceinline__ int route_row(const float* __restrict__ X1, const float* __restrict__ SSQ, const float* __restrict__ g2, const float* __restrict__ ada,
                                         const float* __restrict__ wrg, const float* __restrict__ brg, const float* __restrict__ wre, const float* __restrict__ bre,
                                         bf16* __restrict__ H2, int row, int lane, float& w1, float& w2) {
    const int b = row / SEQ;
    const float part = lane < 32 ? SSQ[(size_t)row * 32 + lane] : 0.f;
    const float rstd = rsqrtf(wave_sum(part) * (1.0f / D) + EPS);
    const float* sh = ada + (size_t)b * NADA + 3 * D; const float* sc = ada + (size_t)b * NADA + 4 * D;
    float acc[20];
#pragma unroll
    for (int o = 0; o < 20; ++o) acc[o] = 0.f;
#pragma unroll
    for (int j = 0; j < 8; ++j) { const int d = 4 * lane + 256 * j;
        const float4 xv = *(const float4*)(X1 + (size_t)row * D + d), g = *(const float4*)(g2 + d), s = *(const float4*)(sc + d), h = *(const float4*)(sh + d);
        const float hv[4] = {xv.x * rstd * g.x * (1.f + s.x) + h.x, xv.y * rstd * g.y * (1.f + s.y) + h.y, xv.z * rstd * g.z * (1.f + s.z) + h.z, xv.w * rstd * g.w * (1.f + s.w) + h.w};
        uint2 w; w.x = f2bf(hv[0]) | (f2bf(hv[1]) << 16); w.y = f2bf(hv[2]) | (f2bf(hv[3]) << 16);
        *(uint2*)(H2 + (size_t)row * D + d) = w;
#pragma unroll
        for (int e = 0; e < 4; ++e) { const float4 wg = *(const float4*)(wrg + (size_t)(d + e) * 4);
            acc[0] += hv[e] * wg.x; acc[1] += hv[e] * wg.y; acc[2] += hv[e] * wg.z; acc[3] += hv[e] * wg.w;
#pragma unroll
            for (int q = 0; q < 4; ++q) { const float4 we = *(const float4*)(wre + (size_t)(d + e) * 16 + q * 4);
                acc[4 + 4 * q] += hv[e] * we.x; acc[5 + 4 * q] += hv[e] * we.y; acc[6 + 4 * q] += hv[e] * we.z; acc[7 + 4 * q] += hv[e] * we.w; } } }
#pragma unroll
    for (int o = 0; o < 20; ++o) acc[o] = wave_sum(acc[o]);
    float gl[4]; int gi = 0;
#pragma unroll
    for (int o = 0; o < 4; ++o) gl[o] = acc[o] + brg[o];
#pragma unroll
    for (int o = 1; o < 4; ++o) if (gl[o] > gl[gi]) gi = o;
    float gsum = 0.f;
#pragma unroll
    for (int o = 0; o < 4; ++o) gsum += __expf(gl[o] - gl[gi]);
    const float gp = 1.0f / gsum;
    float el[4];
#pragma unroll
    for (int o = 0; o < 4; ++o) { float v = 0.f;
#pragma unroll
        for (int g = 0; g < 4; ++g) v = (g == gi) ? acc[4 + 4 * g + o] + bre[4 * g + o] : v;
        el[o] = v; }
    int i1 = 0;
#pragma unroll
    for (int o = 1; o < 4; ++o) if (el[o] > el[i1]) i1 = o;
    int i2 = (i1 == 0) ? 1 : 0;
#pragma unroll
    for (int o = 0; o < 4; ++o) if (o != i1 && el[o] > el[i2]) i2 = o;
    const float r = __expf(el[i2] - el[i1]);
    w1 = gp / (1.0f + r); w2 = gp * r / (1.0f + r);
    return (gi * 4 + i1) | ((gi * 4 + i2) << 8);
}
__device__ __forceinline__ int route_rows4(const float* __restrict__ X1, const float* __restrict__ SSQ, const float* __restrict__ g2, const float* __restrict__ ada,
                                           const float* __restrict__ wrg, const float* __restrict__ brg, const float* __restrict__ wre, const float* __restrict__ bre,
                                           bf16* __restrict__ H2, int row0, int lane, float& w1, float& w2) {
    typedef float f4 __attribute__((ext_vector_type(4)));
    const int b = row0 / SEQ;
    float rstd[4];
#pragma unroll
    for (int r = 0; r < 4; ++r) { const float part = lane < 32 ? SSQ[(size_t)(row0 + r) * 32 + lane] : 0.f; rstd[r] = rsqrtf(wave_sum(part) * (1.0f / D) + EPS); }
    const float* sh = ada + (size_t)b * NADA + 3 * D; const float* sc = ada + (size_t)b * NADA + 4 * D;
    float acc[4][20];
#pragma unroll
    for (int r = 0; r < 4; ++r)
#pragma unroll
        for (int o = 0; o < 20; ++o) acc[r][o] = 0.f;
#pragma unroll 1
    for (int j = 0; j < 8; ++j) { const int d = 4 * lane + 256 * j;
        const f4 g = *(const f4*)(g2 + d), s = *(const f4*)(sc + d), h = *(const f4*)(sh + d); const f4 gs = g * (1.f + s);
        f4 hv[4];
#pragma unroll
        for (int r = 0; r < 4; ++r) { const f4 xv = *(const f4*)(X1 + (size_t)(row0 + r) * D + d); hv[r] = xv * rstd[r] * gs + h;
            uint2 w; w.x = f2bf(hv[r].x) | (f2bf(hv[r].y) << 16); w.y = f2bf(hv[r].z) | (f2bf(hv[r].w) << 16); *(uint2*)(H2 + (size_t)(row0 + r) * D + d) = w; }
#pragma unroll
        for (int e = 0; e < 4; ++e) { const f4 wg = *(const f4*)(wrg + (size_t)(d + e) * 4);
            f4 we[4];
#pragma unroll
            for (int q = 0; q < 4; ++q) we[q] = *(const f4*)(wre + (size_t)(d + e) * 16 + q * 4);
#pragma unroll
            for (int r = 0; r < 4; ++r) { const float hx = hv[r][e];
                acc[r][0] += hx * wg.x; acc[r][1] += hx * wg.y; acc[r][2] += hx * wg.z; acc[r][3] += hx * wg.w;
#pragma unroll
                for (int q = 0; q < 4; ++q) { acc[r][4 + 4 * q] += hx * we[q].x; acc[r][5 + 4 * q] += hx * we[q].y; acc[r][6 + 4 * q] += hx * we[q].z; acc[r][7 + 4 * q] += hx * we[q].w; } } } }
    float t2[2][20], t1[20];
    { const bool up = (lane & 32) != 0;
#pragma unroll
        for (int r = 0; r < 2; ++r)
#pragma unroll
            for (int o = 0; o < 20; ++o) { const float keep = up ? acc[r + 2][o] : acc[r][o], send = up ? acc[r][o] : acc[r + 2][o]; t2[r][o] = keep + __shfl_xor(send, 32); } }
    { const bool up = (lane & 16) != 0;
#pragma unroll
        for (int o = 0; o < 20; ++o) { const float keep = up ? t2[1][o] : t2[0][o], send = up ? t2[0][o] : t2[1][o]; t1[o] = keep + __shfl_xor(send, 16); } }
#pragma unroll
    for (int o = 0; o < 20; ++o) { float v = t1[o]; v += __shfl_xor(v, 8); v += __shfl_xor(v, 4); v += __shfl_xor(v, 2); v += __shfl_xor(v, 1); t1[o] = v; }
    float gl[4]; int gi = 0;
#pragma unroll
    for (int o = 0; o < 4; ++o) gl[o] = t1[o] + brg[o];
#pragma unroll
    for (int o = 1; o < 4; ++o) if (gl[o] > gl[gi]) gi = o;
    float gsum = 0.f;
#pragma unroll
    for (int o = 0; o < 4; ++o) gsum += __expf(gl[o] - gl[gi]);
    const float gp = 1.0f / gsum;
    float el[4];
#pragma unroll
    for (int o = 0; o < 4; ++o) { float v = 0.f;
#pragma unroll
        for (int g = 0; g < 4; ++g) v = (g == gi) ? t1[4 + 4 * g + o] + bre[4 * g + o] : v;
        el[o] = v; }
    int i1 = 0;
#pragma unroll
    for (int o = 1; o < 4; ++o) if (el[o] > el[i1]) i1 = o;
    int i2 = (i1 == 0) ? 1 : 0;
#pragma unroll
    for (int o = 0; o < 4; ++o) if (o != i1 && el[o] > el[i2]) i2 = o;
    const float rr = __expf(el[i2] - el[i1]);
    w1 = gp / (1.0f + rr); w2 = gp * rr / (1.0f + rr);
    return (gi * 4 + i1) | ((gi * 4 + i2) << 8);
}
__device__ __forceinline__ void hist_wave(int e1, int e2, int lane, int blk, int* __restrict__ blkcnt, int& r1, int& r2) {
    const unsigned long long lt = (1ull << lane) - 1ull; r1 = 0; r2 = 0;
    for (int e = 0; e < NEXP; ++e) { const unsigned long long m1 = __ballot(e1 == e), m2 = __ballot(e2 == e);
        if (e1 == e) r1 = __popcll(m1 & lt); if (e2 == e) r2 = __popcll(m1) + __popcll(m2 & lt);
        if (lane == 0) blkcnt[blk * 16 + e] = __popcll(m1) + __popcll(m2); }
}
__device__ __forceinline__ void final_row(float* X1, const bf16* __restrict__ Y, const int* __restrict__ tokslot, const float* __restrict__ ada, const float* __restrict__ fg, int row, int lane, float* OUT = nullptr) {
    if (!OUT) OUT = X1;
    const int b = row / SEQ;
    const int s1 = tokslot[row * 2], s2 = tokslot[row * 2 + 1]; const float* g2 = ada + (size_t)b * NADA + 5 * D;
    float4 v[8]; float ss = 0.f;
#pragma unroll
    for (int j = 0; j < 8; ++j) { const int d = 4 * lane + 256 * j; const float4 xv = *(const float4*)(X1 + (size_t)row * D + d), g = *(const float4*)(g2 + d);
        const uint2 a = *(const uint2*)(Y + (size_t)s1 * D + d), c = *(const uint2*)(Y + (size_t)s2 * D + d);
        v[j].x = xv.x + g.x * (bflo(a.x) + bflo(c.x)); v[j].y = xv.y + g.y * (bfhi(a.x) + bfhi(c.x));
        v[j].z = xv.z + g.z * (bflo(a.y) + bflo(c.y)); v[j].w = xv.w + g.w * (bfhi(a.y) + bfhi(c.y));
        ss += v[j].x * v[j].x + v[j].y * v[j].y + v[j].z * v[j].z + v[j].w * v[j].w; }
    const float rstd = rsqrtf(wave_sum(ss) * (1.0f / D) + EPS);
#pragma unroll
    for (int j = 0; j < 8; ++j) { const int d = 4 * lane + 256 * j; const float4 g = *(const float4*)(fg + d);
        *(float4*)(OUT + (size_t)row * D + d) = make_float4(v[j].x * rstd * g.x, v[j].y * rstd * g.y, v[j].z * rstd * g.z, v[j].w * rstd * g.w); }
}
typedef unsigned fr_v2u __attribute__((ext_vector_type(2))); typedef float fr_f4 __attribute__((ext_vector_type(4)));
__device__ __forceinline__ void final_row_pos(const bf16* __restrict__ X1, float* __restrict__ OUT, const bf16* __restrict__ Y, const int* __restrict__ tokpos, const __attribute__((address_space(3))) int* offL, const float* __restrict__ ada, const float* __restrict__ fg, int row, int lane) {
    const int b = row / SEQ;
    const int p1 = tokpos[row * 2], p2 = tokpos[row * 2 + 1]; const int s1 = offL[p1 >> 14] + (p1 & 16383), s2 = offL[p2 >> 14] + (p2 & 16383); const float* g2 = ada + (size_t)b * NADA + 5 * D;
    float4 v[8]; float ss = 0.f;
#pragma unroll
    for (int j = 0; j < 8; ++j) { const int d = 4 * lane + 256 * j; const fr_v2u xb = __builtin_nontemporal_load((const fr_v2u*)(X1 + (size_t)row * D + d)); const float4 g = *(const float4*)(g2 + d);
        const fr_v2u a = __builtin_nontemporal_load((const fr_v2u*)(Y + (size_t)s1 * D + d)), c = __builtin_nontemporal_load((const fr_v2u*)(Y + (size_t)s2 * D + d));
        v[j].x = bflo(xb.x) + g.x * (bflo(a.x) + bflo(c.x)); v[j].y = bfhi(xb.x) + g.y * (bfhi(a.x) + bfhi(c.x));
        v[j].z = bflo(xb.y) + g.z * (bflo(a.y) + bflo(c.y)); v[j].w = bfhi(xb.y) + g.w * (bfhi(a.y) + bfhi(c.y));
        ss += v[j].x * v[j].x + v[j].y * v[j].y + v[j].z * v[j].z + v[j].w * v[j].w; }
    const float rstd = rsqrtf(wave_sum(ss) * (1.0f / D) + EPS);
#pragma unroll
    for (int j = 0; j < 8; ++j) { const int d = 4 * lane + 256 * j; const float4 g = *(const float4*)(fg + d);
        const fr_f4 ov = {v[j].x * rstd * g.x, v[j].y * rstd * g.y, v[j].z * rstd * g.z, v[j].w * rstd * g.w}; __builtin_nontemporal_store(ov, (fr_f4*)(OUT + (size_t)row * D + d)); }
}
namespace nv {
__global__ __launch_bounds__(256) void route(const float* X1, const float* SSQ, const float* g2, const float* ada, const float* wrg, const float* brg, const float* wre, const float* bre,
                                             bf16* H2, int* __restrict__ toke, float* __restrict__ tokw) {
    const int lane = threadIdx.x & 63, row = blockIdx.x * 4 + (threadIdx.x >> 6); float w1, w2;
    const int ee = route_row(X1, SSQ, g2, ada, wrg, brg, wre, bre, H2, row, lane, w1, w2);
    if (lane == 0) { toke[row * 2] = ee & 255; toke[row * 2 + 1] = ee >> 8; tokw[row * 2] = w1; tokw[row * 2 + 1] = w2; }
}
__global__ __launch_bounds__(64) void hist(const int* __restrict__ toke, int* __restrict__ blkcnt, int* __restrict__ lrank) {
    const int lane = threadIdx.x, tkn = blockIdx.x * 64 + lane; int r1, r2;
    hist_wave(toke[tkn * 2], toke[tkn * 2 + 1], lane, blockIdx.x, blkcnt, r1, r2);
    lrank[tkn * 2] = r1; lrank[tkn * 2 + 1] = r2;
}
__global__ __launch_bounds__(256) void scan(const int* __restrict__ blkcnt, int* __restrict__ blkbase, int* __restrict__ meta, int* __restrict__ slot_tok, float* __restrict__ slot_w) {
    __shared__ int cnt[16], off[17];
    const int tid = threadIdx.x;
    if (tid < 16) { int base = 0; for (int b = 0; b < 256; ++b) { blkbase[b * 16 + tid] = base; base += blkcnt[b * 16 + tid]; } cnt[tid] = base; }
    __syncthreads();
    if (tid == 0) { int o = 0, nt = 0; for (int e = 0; e < 16; ++e) { off[e] = o; meta[e] = o; const int tl = (cnt[e] + 255) >> 8; for (int i = 0; i < tl; ++i) meta[32 + nt++] = e; o += tl * 256; } off[16] = o; meta[16] = o; meta[17] = o; meta[18] = nt; }
    __syncthreads();
    for (int e = 0; e < 16; ++e) for (int s = off[e] + cnt[e] + tid; s < off[e + 1]; s += 256) { slot_tok[s] = 0; slot_w[s] = 0.f; }
}
__global__ __launch_bounds__(256) void fill(const int* __restrict__ toke, const float* __restrict__ tokw, const int* __restrict__ lrank, const int* __restrict__ blkbase, const int* __restrict__ meta,
                                            int* __restrict__ slot_tok, float* __restrict__ slot_w, int* __restrict__ tokslot) {
    const int i = blockIdx.x * 256 + threadIdx.x;
    const int tkn = i >> 1, e = toke[i], slot = meta[e] + blkbase[(tkn >> 6) * 16 + e] + lrank[i];
    slot_tok[slot] = tkn; slot_w[slot] = tokw[i]; tokslot[i] = slot;
}
__global__ __launch_bounds__(256) void final_(float* X1, const bf16* Y, const int* tokslot, const float* ada, const float* fg) {
    final_row(X1, Y, tokslot, ada, fg, blockIdx.x * 4 + (threadIdx.x >> 6), threadIdx.x & 63);
}
}

namespace pg8 {
#define PG8_LAS __attribute__((address_space(3)))
typedef unsigned short bf16_t;
typedef short bf16x8 __attribute__((ext_vector_type(8)));
typedef float f32x4 __attribute__((ext_vector_type(4)));
typedef unsigned u32x4 __attribute__((ext_vector_type(4)));
constexpr int BM = 256, BK = 64, HALF = 128, HTB = HALF * BK * 2, STAGE_BYTES = 8 * HTB, NXCD = 8, WGM = 8;
__host__ __device__ __forceinline__ int lds_byte(int r, int c) { const int st = (r >> 4) * 2 + (c >> 5), rr = r & 15, cc = c & 31, ob = rr * 64 + cc * 2; return st * 1024 + (ob ^ (((ob >> 9) & 1) << 5)); }
__host__ __device__ __forceinline__ void stage_rc(int b, int& R, int& C) { const int st = b / 1024, sb = b % 1024, swz = sb ^ (((sb >> 9) & 1) << 5); R = (st >> 1) * 16 + swz / 64; C = (st & 1) * 32 + (swz % 64) / 2; }
__host__ __device__ __forceinline__ int perm32(int rho) { const int n = rho >> 4, i = rho & 15; return 8 * (i >> 2) + 4 * n + (i & 3); }

struct Unit { int pm, pn, be; };
struct Gemm { const bf16_t* A; const bf16_t* Bt; int lda, ldb, K; size_t bstride; const int* rowidx; const PG8_LAS int* lm; };

struct StaticOrder {
    int nM, nN, nwg, G, c;
    __device__ void init(int M, int N, int G_, int c_) { nM = M / BM; nN = N / BM; nwg = nM * nN; G = G_; c = c_; }
    __device__ bool next(int i, Unit& u) const {
        const long L = (long)i * G + c; if (L >= nwg) return false;
        int wgid = (int)L; { const int q = nwg / NXCD, r = nwg % NXCD, xcd = wgid % NXCD, off = wgid / NXCD; wgid = (xcd < r ? xcd * (q + 1) : r * (q + 1) + (xcd - r) * q) + off; }
        const int nig = WGM * nN, gid = wgid / nig, fm = gid * WGM, gsz = (nM - fm) < WGM ? (nM - fm) : WGM;
        u.pm = fm + ((wgid % nig) % gsz); u.pn = (wgid % nig) / gsz; u.be = 0; return true;
    }
};
struct OneUnit { Unit u0; __device__ bool next(int i, Unit& u) const { if (i) return false; u = u0; return true; } };
struct DynOrder { int nunits, nN, G, c; const PG8_LAS int* tile_e;
    __device__ bool next(int i, Unit& u) const { const int L = i * G + c; if (L >= nunits) return false; u.pm = L / nN; u.pn = L % nN; u.be = tile_e[u.pm]; return true; } };

__device__ __forceinline__ unsigned cvt_pk_bf16(float lo, float hi) { unsigned r; asm volatile("v_cvt_pk_bf16_f32 %0, %1, %2" : "=v"(r) : "v"(lo), "v"(hi)); return r; }
__device__ __forceinline__ u32x4 pack8(f32x4 v0, f32x4 v1) { u32x4 w; w.x = cvt_pk_bf16(v0[0], v0[1]); w.y = cvt_pk_bf16(v0[2], v0[3]); w.z = cvt_pk_bf16(v1[0], v1[1]); w.w = cvt_pk_bf16(v1[2], v1[3]); return w; }

__device__ __forceinline__ unsigned gate_pack4(f32x4 v) {
    unsigned r = 0;
#pragma unroll
    for (int i = 0; i < 4; ++i) { const unsigned q = (unsigned)__builtin_fmaf(sigmoid_fast(v[i]), 255.0f, 0.5f); r |= q << (8 * i); }
    return r;
}
__device__ __forceinline__ void gate_unpack8(unsigned lo, unsigned hi, f32x4& a, f32x4& b) {
    const float k = 1.0f / 255.0f;
    a[0] = (float)(lo & 255u) * k; a[1] = (float)((lo >> 8) & 255u) * k; a[2] = (float)((lo >> 16) & 255u) * k; a[3] = (float)(lo >> 24) * k;
    b[0] = (float)(hi & 255u) * k; b[1] = (float)((hi >> 8) & 255u) * k; b[2] = (float)((hi >> 16) & 255u) * k; b[3] = (float)(hi >> 24) * k;
}
__device__ __forceinline__ size_t acc_slot(int tile, int wid, int ai, int m, int bj, int lane) { return ((size_t)(tile * 8 + wid) * 16 + ((ai * 4 + m) * 2 + bj)) * 64 + lane; }
struct EpProj { static constexpr bool PERM = true; bf16_t* O; unsigned char* G8;
    __device__ __forceinline__ void operator()(const f32x4 (&acc)[2][2][4][2], const Unit& u, int wr, int wc, int fr, int fq) const {
        const int row0 = u.pm * BM + wr * 64 + fr, col0 = u.pn * BM + wc * 32 + 8 * fq; const int mode = u.pn < 4 ? 0 : (u.pn < 10 ? 1 : 2);
        typedef unsigned u32x2 __attribute__((ext_vector_type(2))); const int lane = fq * 16 + fr, wid = wr * 4 + wc;
        if (mode == 2) {
            const int gt = u.pm * 16 + (u.pn - 10);
#pragma unroll
            for (int ai = 0; ai < 2; ++ai)
#pragma unroll
                for (int m = 0; m < 4; ++m)
#pragma unroll
                    for (int bj = 0; bj < 2; ++bj) { u32x2 w; w.x = gate_pack4(acc[ai][bj][m][0]); w.y = gate_pack4(acc[ai][bj][m][1]);
                        __builtin_nontemporal_store(w, (u32x2*)(G8 + acc_slot(gt, wid, ai, m, bj, lane) * 8)); }
        } else {
            const float sc = mode == 0 ? C2 : 1.0f;
#pragma unroll
            for (int ai = 0; ai < 2; ++ai)
#pragma unroll
                for (int m = 0; m < 4; ++m) { bf16_t* rowb = O + (size_t)(row0 + ai * HALF + m * 16) * NPROJ;
#pragma unroll
                    for (int bj = 0; bj < 2; ++bj) *(u32x4*)(rowb + col0 + bj * HALF) = pack8(acc[ai][bj][m][0] * sc, acc[ai][bj][m][1] * sc); }
        }
    } };
struct EpFold { static constexpr bool PERM = true; bf16_t* O;
    __device__ __forceinline__ void operator()(const f32x4 (&acc)[2][2][4][2], const Unit& u, int wr, int wc, int fr, int fq) const {
        const int row0 = u.pm * BM + wr * 64 + fr, col0 = u.be * 256 + wc * 32 + 8 * fq;
#pragma unroll
        for (int ai = 0; ai < 2; ++ai)
#pragma unroll
            for (int m = 0; m < 4; ++m) { bf16_t* rowp = O + (size_t)(row0 + ai * HALF + m * 16) * 2048 + col0;
#pragma unroll
                for (int bj = 0; bj < 2; ++bj) *(u32x4*)(rowp + bj * HALF) = pack8(acc[ai][bj][m][0], acc[ai][bj][m][1]); }
    } };
__device__ __forceinline__ void unpack8(u32x4 w, f32x4& a, f32x4& b) { a[0] = bflo(w.x); a[1] = bfhi(w.x); a[2] = bflo(w.y); a[3] = bfhi(w.y); b[0] = bflo(w.z); b[1] = bfhi(w.z); b[2] = bflo(w.w); b[3] = bfhi(w.w); }
struct EpT1 { static constexpr bool PERM = true; bf16_t* T1p; const unsigned char* G8;
    __device__ __forceinline__ void operator()(const f32x4 (&acc)[2][2][4][2], const Unit& u, int wr, int wc, int fr, int fq) const {
        typedef unsigned u32x2 __attribute__((ext_vector_type(2))); const int lane = fq * 16 + fr, wid = wr * 4 + wc;
        u32x2 gw[2][4][2];
#pragma unroll
        for (int ai = 0; ai < 2; ++ai)
#pragma unroll
            for (int m = 0; m < 4; ++m)
#pragma unroll
                for (int bj = 0; bj < 2; ++bj) gw[ai][m][bj] = *(const u32x2*)(G8 + acc_slot(u.pm * 16 + 8 + u.pn, wid, ai, m, bj, lane) * 8);
#pragma unroll
        for (int ai = 0; ai < 2; ++ai)
#pragma unroll
            for (int m = 0; m < 4; ++m)
#pragma unroll
                for (int bj = 0; bj < 2; ++bj) { f32x4 g0, g1; gate_unpack8(gw[ai][m][bj].x, gw[ai][m][bj].y, g0, g1);
                    *(u32x4*)(T1p + acc_slot(u.pm * 8 + u.pn, wid, ai, m, bj, lane) * 8) = pack8(acc[ai][bj][m][0] * g0, acc[ai][bj][m][1] * g1); }
    } };
struct EpMerged { static constexpr bool PERM = true; bf16_t* M; const bf16_t* T1p; const unsigned char* G8;
    __device__ __forceinline__ void operator()(const f32x4 (&acc)[2][2][4][2], const Unit& u, int wr, int wc, int fr, int fq) const {
        const int row0 = u.pm * BM + wr * 64 + fr, col0 = u.pn * BM + wc * 32 + 8 * fq;
        typedef unsigned u32x2 __attribute__((ext_vector_type(2))); const int lane = fq * 16 + fr, wid = wr * 4 + wc;
#pragma unroll
        for (int ai = 0; ai < 2; ++ai) {
            u32x2 gw[4][2]; u32x4 tw[4][2];
#pragma unroll
            for (int m = 0; m < 4; ++m)
#pragma unroll
                for (int bj = 0; bj < 2; ++bj) { gw[m][bj] = *(const u32x2*)(G8 + acc_slot(u.pm * 16 + u.pn, wid, ai, m, bj, lane) * 8); tw[m][bj] = *(const u32x4*)(T1p + acc_slot(u.pm * 8 + u.pn, wid, ai, m, bj, lane) * 8); }
#pragma unroll
            for (int m = 0; m < 4; ++m)
#pragma unroll
                for (int bj = 0; bj < 2; ++bj) { const size_t r = (size_t)(row0 + ai * HALF + m * 16); f32x4 g0, g1, t0, t1; gate_unpack8(gw[m][bj].x, gw[m][bj].y, g0, g1); unpack8(tw[m][bj], t0, t1);
                    *(u32x4*)(M + r * D + col0 + bj * HALF) = pack8(acc[ai][bj][m][0] * g0 + t0, acc[ai][bj][m][1] * g1 + t1); }
            asm volatile("" ::: "memory"); }
    } };
struct EpMergedR { static constexpr bool PERM = true; bf16_t* M; const unsigned char* G8;
    __device__ __forceinline__ void mid(f32x4 (&acc)[2][2][4][2], const Unit& u, int wr, int wc, int fr, int fq) const {
        typedef unsigned u32x2 __attribute__((ext_vector_type(2))); const int lane = fq * 16 + fr, wid = wr * 4 + wc;
        int gt = u.pm * 16 + u.pn; asm volatile("" : "+s"(gt));
#pragma unroll
        for (int ai = 0; ai < 2; ++ai) {
            u32x2 ga[4][2], gp[4][2];
#pragma unroll
            for (int m = 0; m < 4; ++m)
#pragma unroll
                for (int bj = 0; bj < 2; ++bj) { ga[m][bj] = *(const u32x2*)(G8 + acc_slot(gt, wid, ai, m, bj, lane) * 8); gp[m][bj] = __builtin_nontemporal_load((const u32x2*)(G8 + acc_slot(gt + 8, wid, ai, m, bj, lane) * 8)); }
#pragma unroll
            for (int m = 0; m < 4; ++m)
#pragma unroll
                for (int bj = 0; bj < 2; ++bj) {
#pragma unroll
                    for (int n = 0; n < 2; ++n) { const unsigned wa = n ? ga[m][bj].y : ga[m][bj].x, wp = n ? gp[m][bj].y : gp[m][bj].x;
#pragma unroll
                        for (int i = 0; i < 4; ++i) { const float qa = fmaxf((float)((wa >> (8 * i)) & 255u), 0.5f), qp = (float)((wp >> (8 * i)) & 255u); acc[ai][bj][m][n][i] *= qp * __builtin_amdgcn_rcpf(qa); } } }
            asm volatile("" ::: "memory"); }
    }
    __device__ __forceinline__ void operator()(const f32x4 (&acc)[2][2][4][2], const Unit& u, int wr, int wc, int fr, int fq) const {
        const int row0 = u.pm * BM + wr * 64 + fr, col0 = u.pn * BM + wc * 32 + 8 * fq;
        typedef unsigned u32x2 __attribute__((ext_vector_type(2))); const int lane = fq * 16 + fr, wid = wr * 4 + wc;
        u32x2 ga[2][4][2];
#pragma unroll
        for (int ai = 0; ai < 2; ++ai)
#pragma unroll
            for (int m = 0; m < 4; ++m)
#pragma unroll
                for (int bj = 0; bj < 2; ++bj) ga[ai][m][bj] = __builtin_nontemporal_load((const u32x2*)(G8 + acc_slot(u.pm * 16 + u.pn, wid, ai, m, bj, lane) * 8));
#pragma unroll
        for (int ai = 0; ai < 2; ++ai)
#pragma unroll
            for (int m = 0; m < 4; ++m)
#pragma unroll
                for (int bj = 0; bj < 2; ++bj) { const size_t r = (size_t)(row0 + ai * HALF + m * 16); f32x4 g[2];
#pragma unroll
                    for (int n = 0; n < 2; ++n) { const unsigned wa = n ? ga[ai][m][bj].y : ga[ai][m][bj].x;
#pragma unroll
                        for (int i = 0; i < 4; ++i) g[n][i] = fmaxf((float)((wa >> (8 * i)) & 255u), 0.5f) * (1.0f / 255.0f); }
                    *(u32x4*)(M + r * D + col0 + bj * HALF) = pack8(acc[ai][bj][m][0] * g[0], acc[ai][bj][m][1] * g[1]); }
    } };
struct EpX1 { static constexpr bool PERM = true; const float* x; bf16_t* X1; const float* ada; float* SSQ;
    __device__ __forceinline__ void operator()(const f32x4 (&acc)[2][2][4][2], const Unit& u, int wr, int wc, int fr, int fq) const {
        const int row0 = u.pm * BM + wr * 64 + fr, col0 = u.pn * BM + wc * 32 + 8 * fq; const float* g1 = ada + (size_t)(u.pm >> 5) * NADA + 2 * D;
        f32x4 gv[2][2];
#pragma unroll
        for (int bj = 0; bj < 2; ++bj)
#pragma unroll
            for (int n = 0; n < 2; ++n) gv[bj][n] = *(const f32x4*)(g1 + col0 + bj * HALF + 4 * n);
#pragma unroll
        for (int am = 0; am < 4; ++am) { const int ai = am >> 1, m0 = (am & 1) * 2;
            f32x4 xv[2][2][2];
#pragma unroll
            for (int mm = 0; mm < 2; ++mm)
#pragma unroll
                for (int bj = 0; bj < 2; ++bj)
#pragma unroll
                    for (int n = 0; n < 2; ++n) xv[mm][bj][n] = __builtin_nontemporal_load((const f32x4*)(x + (size_t)(row0 + ai * HALF + (m0 + mm) * 16) * D + col0 + bj * HALF + 4 * n));
#pragma unroll
            for (int mm = 0; mm < 2; ++mm) { const int m = m0 + mm; const size_t r = (size_t)(row0 + ai * HALF + m * 16); float s = 0.f;
#pragma unroll
                for (int bj = 0; bj < 2; ++bj) { const f32x4 v0 = xv[mm][bj][0] + gv[bj][0] * acc[ai][bj][m][0], v1 = xv[mm][bj][1] + gv[bj][1] * acc[ai][bj][m][1];
                    *(u32x4*)(X1 + r * D + col0 + bj * HALF) = pack8(v0, v1);
                    s += ((v0[0] * v0[0] + v0[1] * v0[1]) + (v0[2] * v0[2] + v0[3] * v0[3])) + ((v1[0] * v1[0] + v1[1] * v1[1]) + (v1[2] * v1[2] + v1[3] * v1[3])); }
                s += __shfl_xor(s, 16); s += __shfl_xor(s, 32);
                if (fq == 0) SSQ[r * 32 + u.pn * 4 + wc] = s; }
            asm volatile("" ::: "memory"); }
    } };
struct EpAct { static constexpr bool PERM = true; bf16_t* ACT; const float* lw; const PG8_LAS int* lm;
    __device__ __forceinline__ void operator()(const f32x4 (&acc)[2][2][4][2], const Unit& u, int wr, int wc, int fr, int fq) const {
        const int li0 = wr * 64 + fr, row0 = u.pm * BM + li0, col0 = u.pn * HALF + wc * 32 + 8 * fq;
        const int lt = u.pm - lm[208 + u.be], rb = u.be * 16384 + lt * BM, rc = lm[192 + u.be] - lt * BM;
        float wv[2][4];
#pragma unroll
        for (int ai = 0; ai < 2; ++ai)
#pragma unroll
            for (int m = 0; m < 4; ++m) { const int li = li0 + ai * HALF + m * 16; wv[ai][m] = li < rc ? lw[rb + li] : 0.f; }
#pragma unroll
        for (int ai = 0; ai < 2; ++ai)
#pragma unroll
            for (int m = 0; m < 4; ++m) { const size_t r = (size_t)(row0 + ai * HALF + m * 16); const float w = wv[ai][m]; f32x4 o[2];
#pragma unroll
                for (int n = 0; n < 2; ++n)
#pragma unroll
                    for (int i = 0; i < 4; ++i) { const float g = acc[ai][0][m][n][i], uu = acc[ai][1][m][n][i]; o[n][i] = g * sigmoid_fast(g) * uu * w; }
                *(u32x4*)(ACT + r * FF + col0) = pack8(o[0], o[1]); }
    } };
struct EpY { static constexpr bool PERM = true; bf16_t* Y;
    __device__ __forceinline__ void operator()(const f32x4 (&acc)[2][2][4][2], const Unit& u, int wr, int wc, int fr, int fq) const {
        const int row0 = u.pm * BM + wr * 64 + fr, col0 = u.pn * BM + wc * 32 + 8 * fq;
#pragma unroll
        for (int ai = 0; ai < 2; ++ai)
#pragma unroll
            for (int m = 0; m < 4; ++m) { bf16_t* rowp = Y + (size_t)(row0 + ai * HALF + m * 16) * D + col0;
#pragma unroll
                for (int bj = 0; bj < 2; ++bj) *(u32x4*)(rowp + bj * HALF) = pack8(acc[ai][bj][m][0], acc[ai][bj][m][1]); }
    } };

template <class Epi, class Sched, bool GATHER, bool MID = false>
__device__ __forceinline__ void gemm_phase(PG8_LAS unsigned char* lds, const Gemm g, const Sched& S, const Epi& E, int stagger = 0) {
    if (stagger > 0) { const unsigned long long t0 = __builtin_amdgcn_s_memrealtime(); const unsigned long long dl = (unsigned long long)stagger * (unsigned)blockIdx.x / gridDim.x;
        while (__builtin_amdgcn_s_memrealtime() - t0 < dl) __builtin_amdgcn_s_sleep(8); }
    const int tid = threadIdx.x, wid = __builtin_amdgcn_readfirstlane(tid >> 6), lane = tid & 63, wr = wid >> 2, wc = wid & 3, fr = lane & 15, fq = lane >> 4;
    int K = g.K; asm volatile("" : "+s"(K));
    const int nt = K / BK;
    int sR[2], sC[2]; unsigned voB[2], voA[2][2], voN[2][2];
#pragma unroll
    for (int i = 0; i < 2; ++i) { int R, C; stage_rc(tid * 16 + i * 8192, R, C); sR[i] = R; sC[i] = C; const int Rb = Epi::PERM ? ((R & ~31) + perm32(R & 31)) : R;
        voB[i] = (unsigned)(Rb * g.ldb + C) * 2u;
#pragma unroll
        for (int h = 0; h < 2; ++h) { voA[h][i] = (unsigned)((h * HALF + R) * g.lda + C) * 2u; voN[h][i] = voA[h][i]; } }
    const size_t kstep = (size_t)(BK * 2);
    const size_t hstepB = (size_t)HALF * g.ldb * 2, tstepA = (size_t)BM * g.lda * 2, tstepB = (size_t)BM * g.ldb * 2;
    const unsigned ldsw = (unsigned)wid * 1024u;
    const int aoff = lds_byte(wr * 64 + fr, fq * 8), boff = lds_byte(wc * 32 + fr, fq * 8);
#define PG8_SA(b, h) (((b) * 2 + (h)) * HTB)
#define PG8_SB(b, h) ((4 + (b) * 2 + (h)) * HTB)
#define PG8_STAGE(bufoff, gbase, voff) do { _Pragma("unroll") for (int _i = 0; _i < 2; ++_i) \
        __builtin_amdgcn_global_load_lds((const unsigned*)((const char*)(gbase) + (voff)[_i]), (PG8_LAS unsigned*)(lds + (bufoff) + ldsw + _i * 8192), 16, 0, 0); } while (0)
#define PG8_LDA(dst, b, h) do { _Pragma("unroll") for (int m = 0; m < 4; ++m) _Pragma("unroll") for (int k = 0; k < 2; ++k) dst[m][k] = *(const PG8_LAS bf16x8*)(lds + PG8_SA(b, h) + aoff + m * 2048 + k * 1024); } while (0)
#define PG8_LDB(dst, b, h) do { _Pragma("unroll") for (int n = 0; n < 2; ++n) _Pragma("unroll") for (int k = 0; k < 2; ++k) dst[n][k] = *(const PG8_LAS bf16x8*)(lds + PG8_SB(b, h) + boff + n * 2048 + k * 1024); } while (0)
#define PG8_MMA(ai, bj, At, Bt) do { __builtin_amdgcn_s_setprio(1); _Pragma("unroll") for (int m = 0; m < 4; ++m) _Pragma("unroll") for (int n = 0; n < 2; ++n) _Pragma("unroll") for (int k = 0; k < 2; ++k) \
        acc[ai][bj][m][n] = __builtin_amdgcn_mfma_f32_16x16x32_bf16(Bt[n][k], At[m][k], acc[ai][bj][m][n], 0, 0, 0); __builtin_amdgcn_s_setprio(0); } while (0)
#define PG8_WAIT_V(n) asm volatile("s_waitcnt vmcnt(" #n ")" ::: "memory")
#define PG8_WAIT_L(n) asm volatile("s_waitcnt lgkmcnt(" #n ")" ::: "memory")
#define PG8_BAR __builtin_amdgcn_s_barrier()
#define PG8_SCHED __builtin_amdgcn_sched_barrier(0)
#define PG8_GATHER_OFFS(dst, u_) do { const int _e = (u_).be, _lt = (u_).pm - g.lm[208 + _e], _rb = _e * 16384 + _lt * BM, _rc = g.lm[192 + _e] - _lt * BM;     \
        int _ri[2][2];     \
        _Pragma("unroll") for (int _h = 0; _h < 2; ++_h) _Pragma("unroll") for (int _i = 0; _i < 2; ++_i) { const int _ix = _h * HALF + sR[_i]; _ri[_h][_i] = g.rowidx[_rb + (_ix < _rc ? _ix : 0)]; } \
        _Pragma("unroll") for (int _h = 0; _h < 2; ++_h) _Pragma("unroll") for (int _i = 0; _i < 2; ++_i) { const int _ix = _h * HALF + sR[_i]; \
            dst[_h][_i] = (unsigned)((_ix < _rc ? _ri[_h][_i] : 0) * g.lda + sC[_i]) * 2u; } \
        __builtin_amdgcn_s_waitcnt(0x0F70); _Pragma("unroll") for (int _h = 0; _h < 2; ++_h) _Pragma("unroll") for (int _i = 0; _i < 2; ++_i) asm volatile("" : "+v"(dst[_h][_i])); } while (0)
    Unit cur, nxt; int ui = 0;
    if (!S.next(0, cur)) return;
    f32x4 acc[2][2][4][2];
#pragma unroll
    for (int a = 0; a < 2; ++a)
#pragma unroll
        for (int b = 0; b < 2; ++b)
#pragma unroll
            for (int m = 0; m < 4; ++m)
#pragma unroll
                for (int n = 0; n < 2; ++n) acc[a][b][m][n] = (f32x4){0.f, 0.f, 0.f, 0.f};
    bf16x8 At[4][2], B0[2][2], B1[2][2];
    const char* cA = (const char*)g.A + (GATHER ? (size_t)0 : (size_t)cur.pm * tstepA);
    const char* cB = (const char*)g.Bt + ((size_t)cur.be * g.bstride) * 2 + (size_t)cur.pn * tstepB;
    if constexpr (GATHER) PG8_GATHER_OFFS(voA, cur);
    PG8_STAGE(PG8_SB(0, 0), cB, voB); PG8_STAGE(PG8_SB(0, 1), cB + hstepB, voB); PG8_STAGE(PG8_SA(0, 0), cA, voA[0]); PG8_STAGE(PG8_SA(0, 1), cA, voA[1]);
    if (wr == 1) PG8_BAR;
    PG8_WAIT_V(2); PG8_BAR;
    PG8_STAGE(PG8_SB(1, 0), cB + kstep, voB); PG8_STAGE(PG8_SA(1, 0), cA + kstep, voA[0]); PG8_STAGE(PG8_SB(1, 1), cB + hstepB + kstep, voB);
    PG8_WAIT_V(6); PG8_BAR;
    for (;;) {
        const bool has_next = S.next(ui + 1, nxt);
        const char* nA = has_next ? (const char*)g.A + (GATHER ? (size_t)0 : (size_t)nxt.pm * tstepA) : cA;
        const char* nB = has_next ? (const char*)g.Bt + ((size_t)nxt.be * g.bstride) * 2 + (size_t)nxt.pn * tstepB : cB;
        if constexpr (GATHER) { if (has_next) PG8_GATHER_OFFS(voN, nxt); else {
#pragma unroll
            for (int h = 0; h < 2; ++h)
#pragma unroll
                for (int i = 0; i < 2; ++i) voN[h][i] = voA[h][i]; } }
        for (int t = 0; t < nt; t += 2) {
            const bool last = (t == nt - 2);
            if constexpr (MID) { if (t == (nt >> 1)) E.mid(acc, cur, wr, wc, fr, fq); }
            const char* a1 = cA + (size_t)(t + 1) * kstep;
            const char* a2 = last ? nA : cA + (size_t)(t + 2) * kstep; const char* b2 = last ? nB : cB + (size_t)(t + 2) * kstep;
            const char* a3 = a2 + kstep; const char* b3 = b2 + kstep;
            unsigned vo2[2][2];
#pragma unroll
            for (int h = 0; h < 2; ++h)
#pragma unroll
                for (int i = 0; i < 2; ++i) vo2[h][i] = (GATHER && last) ? voN[h][i] : voA[h][i];
            PG8_LDB(B0, 0, 0); PG8_LDB(B1, 0, 1); PG8_SCHED; PG8_LDA(At, 0, 0); PG8_STAGE(PG8_SA(1, 1), a1, voA[1]);
            PG8_WAIT_V(8); PG8_WAIT_L(0); PG8_BAR; PG8_MMA(0, 0, At, B0); PG8_MMA(0, 1, At, B1); PG8_BAR; PG8_SCHED;
            PG8_LDA(At, 0, 1); PG8_STAGE(PG8_SB(0, 0), b2, voB); PG8_STAGE(PG8_SB(0, 1), b2 + hstepB, voB); PG8_STAGE(PG8_SA(0, 0), a2, vo2[0]);
            PG8_WAIT_V(8); PG8_WAIT_L(0); PG8_BAR; PG8_MMA(1, 0, At, B0); PG8_MMA(1, 1, At, B1); PG8_BAR; PG8_SCHED;
            PG8_LDB(B0, 1, 0); PG8_LDB(B1, 1, 1); PG8_SCHED; PG8_LDA(At, 1, 0); PG8_STAGE(PG8_SA(0, 1), a2, vo2[1]);
            PG8_WAIT_V(8); PG8_WAIT_L(0); PG8_BAR; PG8_MMA(0, 0, At, B0); PG8_MMA(0, 1, At, B1); PG8_BAR; PG8_SCHED;
            PG8_LDA(At, 1, 1); PG8_STAGE(PG8_SB(1, 0), b3, voB); PG8_STAGE(PG8_SB(1, 1), b3 + hstepB, voB); PG8_STAGE(PG8_SA(1, 0), a3, vo2[0]);
            PG8_WAIT_V(8); PG8_WAIT_L(0); PG8_BAR; PG8_MMA(1, 0, At, B0); PG8_MMA(1, 1, At, B1); PG8_BAR; PG8_SCHED;
        }
        if (wr == 0) PG8_BAR;
        E(acc, cur, wr, wc, fr, fq);
        if (!has_next) break;
#pragma unroll
        for (int a = 0; a < 2; ++a)
#pragma unroll
            for (int b = 0; b < 2; ++b)
#pragma unroll
                for (int m = 0; m < 4; ++m)
#pragma unroll
                    for (int n = 0; n < 2; ++n) acc[a][b][m][n] = (f32x4){0.f, 0.f, 0.f, 0.f};
        cur = nxt; cA = nA; cB = nB; ++ui;
        if constexpr (GATHER) {
#pragma unroll
            for (int h = 0; h < 2; ++h)
#pragma unroll
                for (int i = 0; i < 2; ++i) voA[h][i] = voN[h][i]; }
        if (wr == 1) PG8_BAR;
    }
    PG8_WAIT_V(0);
    PG8_BAR;
#undef PG8_SA
#undef PG8_SB
#undef PG8_STAGE
#undef PG8_LDA
#undef PG8_LDB
#undef PG8_MMA
#undef PG8_WAIT_V
#undef PG8_WAIT_L
#undef PG8_BAR
#undef PG8_SCHED
#undef PG8_GATHER_OFFS
}
}

#define GAS __attribute__((address_space(1)))
#define LAS __attribute__((address_space(3)))
typedef unsigned v4u __attribute__((ext_vector_type(4)));
typedef unsigned v2u __attribute__((ext_vector_type(2)));
typedef float f32x4 __attribute__((ext_vector_type(4)));
typedef float f32x16 __attribute__((ext_vector_type(16)));
typedef short bf16x8 __attribute__((ext_vector_type(8)));
typedef short s16x4 __attribute__((ext_vector_type(4)));
typedef GAS unsigned gu32;
#define RLX_AGENT __ATOMIC_RELAXED, __HIP_MEMORY_SCOPE_AGENT
#define LDS_WAIT() asm volatile("s_waitcnt lgkmcnt(0)" ::: "memory")
#define VM_WAIT() asm volatile("s_waitcnt vmcnt(0)" ::: "memory")
constexpr int NWAVES = 8;
constexpr int STG_P1 = 0, STG_P3A = 0, STG_P3B = 0, STG_P4 = 0, STG_P7 = 0;
constexpr int RING_OFF = 0, RING_BYTES = 131072;
constexpr int LDSCTL_OFF = 139264;
constexpr int MISC_OFF = LDSCTL_OFF + 64;
constexpr int LMETA_OFF = LDSCTL_OFF + 256;
constexpr int LDS_BYTES = 147456;
constexpr int CW_TMO = 0, CW_BAR = 4096, CW_CNT = 8192;

#define XB_TMO      128
#define XB_XCNT(j)  (256  + 64 * (j))
#define XB_XSUB(j)  (1280 + 64 * (j))
#define XB_XGEN(j)  (2304 + 64 * (j))
#define XB_TOP      3328
#define XB_TOPGEN   3392
#define XCD_BAR_WORDS 3456
#define XB_SPIN_CAP (1u << 18)
__device__ __forceinline__ unsigned xb_ld(unsigned* p)              { return __hip_atomic_load(p, __ATOMIC_RELAXED, __HIP_MEMORY_SCOPE_AGENT); }
__device__ __forceinline__ unsigned xb_add(unsigned* p, unsigned v) { return __hip_atomic_fetch_add(p, v, __ATOMIC_RELAXED, __HIP_MEMORY_SCOPE_AGENT); }
__device__ __forceinline__ unsigned xb_xcc_id() { return (unsigned)__builtin_amdgcn_s_getreg((3 << 11) | 20) & 0xFu; }
#define XB_SPIN(cond, bar) do { unsigned _sp = 0; while (cond) { __builtin_amdgcn_s_sleep(1); \
    if ((++_sp & 255u) == 0u) { if (xb_ld(&(bar)[XB_TMO])) break; if (_sp > XB_SPIN_CAP) { atomicAdd(&(bar)[XB_TMO], 1u); break; } } } } while (0)
struct XcdBarrier { unsigned* bar; unsigned x; volatile LAS unsigned* st; };
__device__ __forceinline__ XcdBarrier xcd_barrier_post(unsigned* bar, volatile LAS unsigned* st) {
    XcdBarrier b; b.bar = bar; b.x = xb_xcc_id(); b.st = st;
    if (threadIdx.x == 0) (void)xb_add(&bar[XB_XCNT(b.x)], 1u);
    return b;
}
__device__ __forceinline__ void xcd_barrier_complete(unsigned* bar, unsigned x, unsigned& nloc, unsigned& nx) {
    const unsigned G = gridDim.x * gridDim.y * gridDim.z;
    unsigned sum, cnt, mine, sp = 0u;
    for (;;) {
        sum = 0u; cnt = 0u; mine = 0u;
#pragma unroll
        for (unsigned j = 0; j < 16; ++j) { const unsigned c = xb_ld(&bar[XB_XCNT(j)]); sum += c; cnt += (c > 0u) ? 1u : 0u; mine = (j == x) ? c : mine; }
        if (sum == G) break;
        __builtin_amdgcn_s_sleep(1);
        if ((++sp & 255u) == 0u) { if (xb_ld(&bar[XB_TMO])) break; if (sp > XB_SPIN_CAP) { atomicAdd(&bar[XB_TMO], 1u); break; } }
    }
    nloc = mine > 0u ? mine : 1u; nx = cnt > 0u ? cnt : 1u;
}
__device__ __forceinline__ void xcd_barrier(const XcdBarrier& b) {
    asm volatile("s_waitcnt vmcnt(0)" ::: "memory");
    __syncthreads();
    if (threadIdx.x == 0) {
        unsigned* bar = b.bar;
        __builtin_amdgcn_s_waitcnt(0);
        unsigned nloc = b.st[0], nx = b.st[1];
        if (nloc == 0u) { xcd_barrier_complete(bar, b.x, nloc, nx); b.st[0] = nloc; b.st[1] = nx; }
        const unsigned old = xb_add(&bar[XB_XSUB(b.x)], 1u);
        const unsigned gen = old / nloc;
        if (old + 1u == (gen + 1u) * nloc) {
            __builtin_amdgcn_fence(__ATOMIC_RELEASE, "agent");
            asm volatile("s_waitcnt vmcnt(0)" ::: "memory");
            const unsigned og = xb_add(&bar[XB_TOP], 1u);
            const unsigned tg = og / nx;
            if (og + 1u == (tg + 1u) * nx) xb_add(&bar[XB_TOPGEN], 1u);
            else XB_SPIN(xb_ld(&bar[XB_TOPGEN]) == tg, bar);
            __builtin_amdgcn_fence(__ATOMIC_ACQUIRE, "agent");
            xb_add(&bar[XB_XGEN(b.x)], 1u);
            asm volatile("s_waitcnt vmcnt(0)" ::: "memory");
        } else {
            XB_SPIN(xb_ld(&bar[XB_XGEN(b.x)]) == gen, bar);
            __builtin_amdgcn_fence(__ATOMIC_ACQUIRE, "agent");
            asm volatile("s_waitcnt vmcnt(0)" ::: "memory");
        }
    }
    __syncthreads();
}

struct Args { const float* in[21]; float* out; unsigned char* ws; int ph_lo, ph_hi; };
typedef const __attribute__((address_space(4))) Args* KArgs;
struct Frame {
    LAS unsigned char* lds; volatile LAS unsigned* MISC; LAS int* LM; gu32* ctl;
    int vcu, G;
    KArgs ka;
    __device__ __forceinline__ int tid() const { int t = threadIdx.x; asm volatile("" : "+v"(t)); return t; }
    __device__ __forceinline__ int lane() const { return tid() & 63; }
    __device__ __forceinline__ int wave() const { return __builtin_amdgcn_readfirstlane(tid() >> 6); }
    float* out; unsigned char* ws;
    __device__ __forceinline__ const float* x() const { return ka->in[0]; }
    __device__ __forceinline__ const float* c() const { return ka->in[1]; }
    __device__ __forceinline__ const float* w_ada() const { return ka->in[2]; }
    __device__ __forceinline__ const float* b_ada() const { return ka->in[3]; }
    __device__ __forceinline__ const float* g1() const { return ka->in[4]; }
    __device__ __forceinline__ const float* w_in() const { return ka->in[5]; }
    __device__ __forceinline__ const float* sinks() const { return ka->in[6]; }
    __device__ __forceinline__ const float* w_pool() const { return ka->in[7]; }
    __device__ __forceinline__ const float* pool_scale() const { return ka->in[8]; }
    __device__ __forceinline__ const float* w_ab() const { return ka->in[9]; }
    __device__ __forceinline__ const float* w_pb() const { return ka->in[10]; }
    __device__ __forceinline__ const float* w_out() const { return ka->in[11]; }
    __device__ __forceinline__ const float* g2() const { return ka->in[12]; }
    __device__ __forceinline__ const float* w_rg() const { return ka->in[13]; }
    __device__ __forceinline__ const float* b_rg() const { return ka->in[14]; }
    __device__ __forceinline__ const float* w_re() const { return ka->in[15]; }
    __device__ __forceinline__ const float* b_re() const { return ka->in[16]; }
    __device__ __forceinline__ const float* w_eg() const { return ka->in[17]; }
    __device__ __forceinline__ const float* w_eu() const { return ka->in[18]; }
    __device__ __forceinline__ const float* w_ed() const { return ka->in[19]; }
    __device__ __forceinline__ const float* fg() const { return ka->in[20]; }
};

__device__ __forceinline__ unsigned pk2(float lo, float hi) { return pg8::cvt_pk_bf16(lo, hi); }
struct P0Item { const float* W; bf16* WT; int N, dpitch, drow0, k0, n0, dk; };
__device__ __forceinline__ void p0_item_load(const P0Item& I, f32x4 (&a)[8], f32x4 (&b)[8], int lane) {
    const int nq = lane & 15, kr = lane >> 4;
#pragma unroll
    for (int it = 0; it < 8; ++it) { const float* p = I.W + (size_t)(I.k0 + 8 * it + 2 * kr) * I.N + I.n0 + 4 * nq; a[it] = __builtin_nontemporal_load((const GAS f32x4*)p); b[it] = __builtin_nontemporal_load((const GAS f32x4*)(p + I.N)); }
}
__device__ __forceinline__ void p0_item_store(const P0Item& I, const f32x4 (&a)[8], const f32x4 (&b)[8], LAS unsigned* scr, int lane) {
    const int nq = lane & 15, kr = lane >> 4;
#pragma unroll
    for (int it = 0; it < 8; ++it) { LAS unsigned* d = scr + (4 * it + kr) * 65 + 4 * nq;
        d[0] = pk2(a[it].x, b[it].x); d[1] = pk2(a[it].y, b[it].y); d[2] = pk2(a[it].z, b[it].z); d[3] = pk2(a[it].w, b[it].w); }
    LDS_WAIT(); asm volatile("" ::: "memory");
    const int c = lane & 7, nl = lane >> 3;
#pragma unroll
    for (int j = 0; j < 8; ++j) { const int n = nl + 8 * j; const LAS unsigned* sp = scr + (4 * c) * 65 + n;
        v4u o; o.x = sp[0]; o.y = sp[65]; o.z = sp[130]; o.w = sp[195];
        *(GAS v4u*)(I.WT + (size_t)(I.drow0 + n) * I.dpitch + I.k0 + I.dk + 8 * c) = o; }
    LDS_WAIT(); asm volatile("" ::: "memory");
}
namespace cv {
constexpr int I_IN = (D / 64) * (NPROJ / 64), I_BR = (1024 / 64) * (D / 64), I_OUT = (D / 64) * (D / 64), I_POOL = 0;
constexpr int I_GE = (D / 64) * (FF / 64), I_DN = (FF / 64) * (D / 64);
constexpr int G0 = I_IN + 2 * I_BR + I_OUT + I_POOL, U0 = G0 + NEXP * I_GE, DN0 = U0 + NEXP * I_GE, NITEMS = DN0 + NEXP * I_DN;
constexpr int E_LATE = 8;
constexpr int NP0 = G0 + (NEXP - E_LATE) * I_GE + (NEXP - E_LATE) * I_GE;
constexpr int NP1 = 2 * E_LATE * I_GE, NP6 = NEXP * I_DN;
__device__ __forceinline__ int map_p0(int j) { const int h = G0 + (NEXP - E_LATE) * I_GE; return j < h ? j : U0 + (j - h); }
__device__ __forceinline__ int map_p1(int j) { return j < E_LATE * I_GE ? G0 + (NEXP - E_LATE) * I_GE + j : U0 + (NEXP - E_LATE) * I_GE + (j - E_LATE * I_GE); }
__device__ __forceinline__ int map_p6(int j) { return DN0 + j; }
}
__device__ __forceinline__ P0Item p0_decode(Frame& F, int it) { using namespace cv; int r = it; P0Item I;
    bf16* WIN = (bf16*)(F.ws + WS_WIN); bf16* WPB = (bf16*)(F.ws + WS_WPB); bf16* WAB = (bf16*)(F.ws + WS_WTMP); bf16* WOUT = (bf16*)(F.ws + WS_WOUT);
    bf16* WPOOL = (bf16*)(F.ws + WS_WPOOL); bf16* WGU = (bf16*)(F.ws + WS_WGU); bf16* WDN = (bf16*)(F.ws + WS_WDN);
    if (r < I_IN) { const int nb = NPROJ / 64; I = {F.w_in(), WIN, NPROJ, D, 64 * (r % nb), 64 * (r / nb), 64 * (r % nb), 0}; return I; } r -= I_IN;
    if (r < I_BR) { const int nb = D / 64; I = {F.w_pb(), WAB, D, 1024, 64 * (r % nb), 64 * (r / nb), 64 * (r % nb), 0}; return I; } r -= I_BR;
    if (r < I_BR) { const int nb = D / 64; I = {F.w_ab(), WPB, D, 2048, 64 * (r % nb), 64 * (r / nb), 64 * (r % nb), 1024}; return I; } r -= I_BR;
    if (r < I_OUT) { const int nb = D / 64; I = {F.w_out(), WOUT, D, D, 64 * (r % nb), 64 * (r / nb), 64 * (r % nb), 0}; return I; } r -= I_OUT;
    if (r < I_POOL) { const int g = r / 16, q = r % 16; I = {F.w_pool() + (size_t)g * 65536, WPOOL + (size_t)g * 65536, 256, 256, 64 * (q % 4), 64 * (q / 4), 64 * (q % 4), 0}; return I; } r -= I_POOL;
    if (r < NEXP * I_GE) { const int e = r / I_GE, q = r % I_GE, nb = FF / 64, n0 = 64 * (q % nb); I = {F.w_eg() + (size_t)e * D * FF, WGU + (size_t)e * 1024 * D, FF, D, (n0 >> 7) * 256 + (n0 & 127), 64 * (q / nb), n0, 0}; return I; } r -= NEXP * I_GE;
    if (r < NEXP * I_GE) { const int e = r / I_GE, q = r % I_GE, nb = FF / 64, n0 = 64 * (q % nb); I = {F.w_eu() + (size_t)e * D * FF, WGU + (size_t)e * 1024 * D, FF, D, (n0 >> 7) * 256 + 128 + (n0 & 127), 64 * (q / nb), n0, 0}; return I; } r -= NEXP * I_GE;
    { const int e = r / I_DN, q = r % I_DN, nb = D / 64, n0 = 64 * (q % nb); I = {F.w_ed() + (size_t)e * FF * D, WDN + (size_t)e * D * FF, D, FF, n0, 64 * (q / nb), n0, 0}; return I; } }
template <class ItemOf> __device__ __forceinline__ void p0_convert(Frame& F, ItemOf item_of) {
    LAS unsigned* scr = (LAS unsigned*)(F.lds + RING_OFF + F.wave() * 16384); const int lane = F.lane();
    int k = 0, it0 = item_of(0);
    if (it0 >= 0) { f32x4 a0[8], b0[8], a1[8], b1[8]; P0Item I0 = p0_decode(F, it0), I1 = I0; p0_item_load(I0, a0, b0, lane);
        for (;;) { int it1 = item_of(++k); if (it1 >= 0) { I1 = p0_decode(F, it1); p0_item_load(I1, a1, b1, lane); }
            p0_item_store(I0, a0, b0, scr, lane); if (it1 < 0) break;
            it0 = item_of(++k); if (it0 >= 0) { I0 = p0_decode(F, it0); p0_item_load(I0, a0, b0, lane); }
            p0_item_store(I1, a1, b1, scr, lane); if (it0 < 0) break; } }
}
template <class Map> __device__ __forceinline__ void p0_convert_tail(Frame& F, int w, int nw, int n, Map map) {
    p0_convert(F, [&](int k) -> int { const int j = w + k * nw; return j < n ? map(j) : -1; });
}
__device__ __forceinline__ void p0_prologue(Frame& F) {
    const int gw = F.vcu * NWAVES + F.wave(), NGW = F.G * NWAVES, lane = F.lane();
    float* ADAP = (float*)(F.ws + WS_ADAP);
    constexpr int P0_TW = 3, P0_R1 = 1;
    const bool tw = F.wave() < P0_TW;
    if (tw) for (int task = F.vcu * P0_TW + F.wave(); task < ADA_SL * 48; task += F.G * P0_TW) { const int ks = task / 48, j = (task % 48) * 256 + 4 * lane; constexpr int KS = D / ADA_SL;
        f32x4 a0 = {0.f, 0.f, 0.f, 0.f}, a1 = {0.f, 0.f, 0.f, 0.f};
#pragma unroll 32
        for (int k = ks * KS; k < ks * KS + KS; ++k) { const f32x4 w = __builtin_nontemporal_load((const GAS f32x4*)(F.w_ada() + (size_t)k * NADA + j)); a0 += w * F.c()[k]; a1 += w * F.c()[D + k]; }
        *(GAS f32x4*)(ADAP + ((size_t)ks * 2 + 0) * NADA + j) = a0; *(GAS f32x4*)(ADAP + ((size_t)ks * 2 + 1) * NADA + j) = a1; }
    { bf16* WRT = (bf16*)(F.ws + WS_WRT);
      for (int idx = gw * 64 + lane; idx < 32 * D; idx += NGW * 64) { const int n = idx >> 11, d = idx & (D - 1);
          const float w = n < 4 ? F.w_rg()[(size_t)d * 4 + n] : (n < 20 ? F.w_re()[(size_t)d * 16 + (n - 4)] : 0.f);
          const unsigned hi = f2bf(w); const unsigned lo = f2bf(w - bf2f(hi));
          const size_t fi = ((size_t)(d >> 4) * 2) * 512 + (size_t)(((d >> 3) & 1) * 32 + n) * 8 + (d & 7);
          WRT[fi] = (bf16)hi; WRT[fi + 512] = (bf16)lo; } }
    { bf16* WPS = (bf16*)(F.ws + WS_WPOOL);
      for (int idx = (gw * 64 + lane) * 4; idx < 4 * 65536; idx += NGW * 64 * 4) { const int g = idx >> 16, d = idx & 255;
          const f32x4 w = *(const GAS f32x4*)(F.w_pool() + idx), sc = *(const GAS f32x4*)(F.pool_scale() + 256 * g + d);
          v2u o; o.x = pk2(w.x * sc.x, w.y * sc.y); o.y = pk2(w.z * sc.z, w.w * sc.w); *(GAS v2u*)(WPS + idx) = o; } }
    { const int NTW = F.G * P0_TW, NCW = F.G * (NWAVES - P0_TW), HEAD = NTW * P0_R1 < cv::NP0 ? NTW * P0_R1 : 0;
      const int twi = F.vcu * P0_TW + F.wave(), cwi = F.vcu * (NWAVES - P0_TW) + (F.wave() - P0_TW);
      p0_convert(F, [&](int k) -> int { int j;
          if (tw) j = (HEAD && k < P0_R1) ? k * NTW + twi : cv::NP0; else j = HEAD + k * NCW + cwi;
          return j < cv::NP0 ? cv::map_p0(j) : -1; }); }
}
__device__ __forceinline__ void p0b_h1(Frame& F) {
    const float* ADAP = (const float*)(F.ws + WS_ADAP); float* ADA = (float*)(F.ws + WS_ADA); bf16* H1 = (bf16*)(F.ws + WS_B);
    LAS float* gsL = (LAS float*)(F.lds + RING_OFF);
    LAS float* shL = gsL + 2 * D;
    const bool split = (F.G & 1) == 0; const int hg = F.G >> 1, b0 = split ? (F.vcu >= hg ? 1 : 0) : 0, nent = split ? D : 2 * D;
    for (int i = F.tid(); i < nent; i += NWAVES * 64) { const int b = b0 + i / D, d = i % D; float ps[ADA_SL], pc[ADA_SL];
#pragma unroll
        for (int ks = 0; ks < ADA_SL; ++ks) { ps[ks] = ADAP[((size_t)ks * 2 + b) * NADA + d]; pc[ks] = ADAP[((size_t)ks * 2 + b) * NADA + D + d]; }
        float sh = F.b_ada()[d], sc = F.b_ada()[D + d];
#pragma unroll
        for (int ks = 0; ks < ADA_SL; ++ks) { sh += ps[ks]; sc += pc[ks]; }
        gsL[b * D + d] = F.g1()[d] * (1.f + sc); shL[b * D + d] = sh; }
    { const int i = F.vcu * (NWAVES * 64) + F.tid(); if (i < 2 * NADA) { const int b = i / NADA, j = i % NADA; float pp[ADA_SL];
#pragma unroll
        for (int ks = 0; ks < ADA_SL; ++ks) pp[ks] = ADAP[((size_t)ks * 2 + b) * NADA + j];
        float s = F.b_ada()[j];
#pragma unroll
        for (int ks = 0; ks < ADA_SL; ++ks) s += pp[ks];
        ADA[i] = s; } }
    LDS_WAIT(); __syncthreads();
    const int lane = F.lane();
    const int gw = split ? (F.vcu - b0 * hg) * NWAVES + F.wave() : F.vcu * NWAVES + F.wave(), NGW = split ? hg * NWAVES : F.G * NWAVES;
    const int rbase = split ? b0 * SEQ : 0, rend = split ? rbase + SEQ : T;
    auto ld = [&](int row, f32x4 (&v)[8]) { int r = row; asm volatile("" : "+s"(r)); const GAS f32x4* xr = (const GAS f32x4*)(F.x() + (size_t)r * D) + lane;
#pragma unroll
        for (int j = 0; j < 8; ++j) v[j] = __builtin_nontemporal_load(xr + 64 * j); };
    auto fin = [&](int row, const f32x4 (&v)[8]) { const int b = row / SEQ; float ss = 0.f;
#pragma unroll
        for (int j = 0; j < 8; ++j) ss += (v[j].x * v[j].x + v[j].y * v[j].y) + (v[j].z * v[j].z + v[j].w * v[j].w);
        const float rstd = rsqrtf(wave_sum(ss) * (1.0f / D) + EPS);
#pragma unroll
        for (int j = 0; j < 8; ++j) { const int d = 4 * lane + 256 * j; const f32x4 gs = *(const LAS f32x4*)(gsL + b * D + d), sh = *(const LAS f32x4*)(shL + b * D + d);
            const f32x4 o = v[j] * rstd * gs + sh; v2u w; w.x = pk2(o.x, o.y); w.y = pk2(o.z, o.w);
            *(GAS v2u*)(H1 + (size_t)row * D + d) = w; } };
    { f32x4 va[8], vb[8]; int row = rbase + gw;
      if (row < rend) { ld(row, va);
#pragma unroll 1
          for (;;) { const int r1 = row + NGW; if (r1 < rend) ld(r1, vb);
              fin(row, va); if (r1 >= rend) break;
              const int r2 = r1 + NGW; if (r2 < rend) ld(r2, va);
              fin(r1, vb); if (r2 >= rend) break; row = r2; } } }
    __syncthreads();
}

constexpr int AT_BUF = 49152, AT_K = 0, AT_V = 24576, AT_WS = 2 * AT_BUF, AT_OST = AT_WS + 2048, AT_BYTES = AT_OST + 32768;
static_assert(AT_BYTES <= LDSCTL_OFF, "attention LDS map");
__device__ __forceinline__ int crow(int r, int hi) { return (r & 3) + 8 * (r >> 2) + 4 * hi; }
__device__ __forceinline__ unsigned cvtpk_s(float lo, float hi) { typedef float f32x2_t __attribute__((ext_vector_type(2))); typedef __bf16 bf16x2_t __attribute__((ext_vector_type(2)));
    f32x2_t v = {lo, hi}; bf16x2_t b = __builtin_convertvector(v, bf16x2_t); return __builtin_bit_cast(unsigned, b); }
typedef short v4i16_t __attribute__((ext_vector_type(4)));
__device__ __forceinline__ s16x4 vtr(LAS const unsigned char* p) { return __builtin_bit_cast(s16x4, __builtin_amdgcn_ds_read_tr16_b64_v4i16((LAS v4i16_t*)p)); }
struct AttnU { int b, kvh, q0; };
__device__ __forceinline__ AttnU attn_decode(int unit) { AttnU u; u.q0 = (unit & 127) * 64; u.kvh = (unit >> 7) & 3; u.b = unit >> 9; return u; }
__device__ __forceinline__ void attn_dma(Frame& F, const AttnU u, int buf, int wid, int lane) {
    const bf16* P = (const bf16*)(F.ws + WS_PROJ); LAS unsigned char* L = F.lds + RING_OFF + buf * AT_BUF;
#pragma unroll
    for (int t = 0; t < 3; ++t) {
        int kk = u.q0 - 128 + 64 * t + lane; if (kk < 0) kk = 0;
        int kv = u.q0 - 128 + 64 * t + 16 * (wid & 3) + (lane >> 2); if (kv < 0) kv = 0;
        const bf16* ks = P + ((size_t)u.b * SEQ + kk) * NPROJ + C_K + u.kvh * 64 + wid * 8;
        const bf16* vs = P + ((size_t)u.b * SEQ + kv) * NPROJ + C_V + u.kvh * 64 + (wid >> 2) * 32 + (lane & 3) * 8;
        __builtin_amdgcn_global_load_lds((const unsigned*)ks, (LAS unsigned*)(L + AT_K + t * 8192 + wid * 1024), 16, 0, 0);
        __builtin_amdgcn_global_load_lds((const unsigned*)vs, (LAS unsigned*)(L + AT_V + t * 8192 + wid * 1024), 16, 0, 0); }
}
__device__ __forceinline__ void attn_q(Frame& F, const AttnU u, bf16x8 (&qr)[4], int wid, int lane) {
    const bf16* P = (const bf16*)(F.ws + WS_PROJ); const int hq = u.kvh * 4 + (wid & 3), rh = wid >> 2, r32 = lane & 31, hi = lane >> 5;
    const size_t qrow = (size_t)u.b * SEQ + u.q0 + 32 * rh + r32;
#pragma unroll
    for (int d0 = 0; d0 < 4; ++d0) qr[d0] = __builtin_nontemporal_load((const GAS bf16x8*)(P + qrow * NPROJ + C_Q + hq * 64 + d0 * 16 + hi * 8));
}
__device__ __forceinline__ void attn_compute(Frame& F, const AttnU u, int buf, const bf16x8 (&qr)[4], int wid, int lane, float sink2) {
    bf16* AP = (bf16*)(F.ws + WS_B);
    const int r32 = lane & 31, hi = lane >> 5, q0 = u.q0, hq = u.kvh * 4 + (wid & 3), rh = wid >> 2;
    LAS unsigned char* L = F.lds + RING_OFF + buf * AT_BUF; LAS unsigned char* L0 = F.lds + RING_OFF;
    f32x16 p[5];
#pragma unroll
    for (int s = 0; s < 5; ++s) { const int j = rh + s; f32x16 a;
        if (q0 - 128 + 32 * j >= 0) { a = f32x16{};
            const int ko = AT_K + (j >> 1) * 8192 + (j & 1) * 512;
#pragma unroll
            for (int d0 = 0; d0 < 4; ++d0) { const bf16x8 kf = *(const LAS bf16x8*)(L + ko + (2 * d0 + hi) * 1024 + r32 * 16);
                a = __builtin_amdgcn_mfma_f32_32x32x16_bf16(kf, qr[d0], a, 0, 0, 0); } }
        else {
#pragma unroll
            for (int r = 0; r < 16; ++r) a[r] = -1e30f; }
        p[s] = a; }
    const float xf = (float)(r32 - 4 * hi);
#pragma unroll
    for (int r = 0; r < 16; ++r) { const float dlt = xf - (float)((r & 3) + 8 * (r >> 2));
        p[0][r] = __builtin_fmaf(fmaxf(dlt + 1.0f, 0.0f), -1e30f, p[0][r]);
        p[4][r] = __builtin_fmaf(fmaxf(-dlt, 0.0f), -1e30f, p[4][r]); }
    float mx = sink2;
#pragma unroll
    for (int s = 0; s < 5; ++s)
#pragma unroll
        for (int r = 0; r < 16; ++r) mx = fmaxf(mx, p[s][r]);
    mx = fmaxf(mx, __shfl_xor(mx, 32));
    float lsum = 0.f;
#pragma unroll
    for (int s = 0; s < 5; ++s)
#pragma unroll
        for (int r = 0; r < 16; ++r) { const float e = __builtin_amdgcn_exp2f(p[s][r] - mx); p[s][r] = e; lsum += e; }
    lsum += __shfl_xor(lsum, 32);
    lsum += __builtin_amdgcn_exp2f(sink2 - mx);
    f32x16 o[2]; o[0] = f32x16{}; o[1] = f32x16{};
    const int vb = AT_V + ((lane >> 4) & 1) * 32 + (lane & 3) * 8 + (4 * hi + ((lane & 15) >> 2)) * 64;
#pragma unroll
    for (int s = 0; s < 5; ++s) { const int j = rh + s; const int vo = vb + (j >> 1) * 8192 + (j & 1) * 2048;
        v4u pw[2];
#pragma unroll
        for (int kk = 0; kk < 2; ++kk) { const int rb = kk * 8;
            pw[kk].x = cvtpk_s(p[s][rb + 0], p[s][rb + 1]); pw[kk].y = cvtpk_s(p[s][rb + 2], p[s][rb + 3]);
            pw[kk].z = cvtpk_s(p[s][rb + 4], p[s][rb + 5]); pw[kk].w = cvtpk_s(p[s][rb + 6], p[s][rb + 7]); }
#pragma unroll
        for (int d0 = 0; d0 < 2; ++d0)
#pragma unroll
            for (int kk = 0; kk < 2; ++kk) { const s16x4 lo = vtr(L + vo + d0 * 4096 + kk * 1024), hh = vtr(L + vo + d0 * 4096 + kk * 1024 + 512);
                const bf16x8 vf = {lo[0], lo[1], lo[2], lo[3], hh[0], hh[1], hh[2], hh[3]};
                o[d0] = __builtin_amdgcn_mfma_f32_32x32x16_bf16(__builtin_bit_cast(bf16x8, pw[kk]), vf, o[d0], 0, 0, 0); }
        __builtin_amdgcn_sched_barrier(0); }
    LAS float* wsf = (LAS float*)(L0 + AT_WS) + wid * 64;
    if (hi == 0) wsf[r32] = lsum;
    LDS_WAIT();
    LAS bf16* stg = (LAS bf16*)(L0 + AT_OST) + wid * 2048;
#pragma unroll
    for (int r = 0; r < 16; ++r) { const int orow = crow(r, hi); const float rl = __builtin_amdgcn_rcpf(wsf[orow]);
#pragma unroll
        for (int d0 = 0; d0 < 2; ++d0) stg[orow * 64 + d0 * 32 + r32] = (bf16)f2bf(o[d0][r] * rl); }
    LDS_WAIT();
    bf16* Ow = AP + ((size_t)u.b * SEQ + q0 + 32 * rh) * D + 1024 + hq * 64;
#pragma unroll
    for (int i = 0; i < 4; ++i) { const int row = i * 8 + (lane >> 3), ch = lane & 7; const v4u v = *(const LAS v4u*)(stg + row * 64 + ch * 8); *(GAS v4u*)(Ow + (size_t)row * D + ch * 8) = v; }
}
__device__ __forceinline__ void attn_phase(Frame& F) {
    constexpr int NU = BATCH * 4 * (SEQ / 64);
    const int wid = F.wave(), lane = F.lane();
    int unit = F.vcu; if (unit >= NU) return;
    bf16x8 qc[4], qn[4];
    float sk[4];
#pragma unroll
    for (int k = 0; k < 4; ++k) sk[k] = F.sinks()[k * 4 + (wid & 3)] * LOG2E;
    attn_dma(F, attn_decode(unit), 0, wid, lane); attn_q(F, attn_decode(unit), qc, wid, lane);
    VM_WAIT(); __syncthreads();
    int buf = 0;
#pragma unroll 1
    for (;; unit += F.G, buf ^= 1) {
        const int nu = unit + F.G; const bool more = nu < NU;
        if (more) { attn_dma(F, attn_decode(nu), buf ^ 1, wid, lane); attn_q(F, attn_decode(nu), qn, wid, lane); }
        { const AttnU cu = attn_decode(unit); const float sk2 = cu.kvh == 0 ? sk[0] : cu.kvh == 1 ? sk[1] : cu.kvh == 2 ? sk[2] : sk[3];
          attn_compute(F, cu, buf, qc, wid, lane, sk2); }
        asm volatile("s_waitcnt vmcnt(4)" ::: "memory"); LDS_WAIT(); __builtin_amdgcn_s_barrier(); asm volatile("" ::: "memory");
        if (!more) break;
#pragma unroll
        for (int d0 = 0; d0 < 4; ++d0) qc[d0] = qn[d0];
    }
}
template <int W> __device__ __forceinline__ void pooled_rows(const bf16* up, bf16* po, int r0, int t0) {
    constexpr int H = W - 1;
    v2u v[32 + H];
#pragma unroll
    for (int k = 0; k < 32 + H; ++k) { v[k].x = 0u; v[k].y = 0u; if (t0 + k - H >= 0) v[k] = __builtin_nontemporal_load((const GAS v2u*)(up + (size_t)(r0 + k - H) * NPROJ)); }
    float s0 = 0.f, s1 = 0.f, s2 = 0.f, s3 = 0.f;
#pragma unroll
    for (int k = 0; k < H; ++k) { s0 += bflo(v[k].x); s1 += bfhi(v[k].x); s2 += bflo(v[k].y); s3 += bfhi(v[k].y); }
#pragma unroll
    for (int i = 0; i < 32; ++i) { const float x0 = bflo(v[i + H].x), x1 = bfhi(v[i + H].x), x2 = bflo(v[i + H].y), x3 = bfhi(v[i + H].y);
        s0 += x0; s1 += x1; s2 += x2; s3 += x3;
        const int t = t0 + i; const float rc = (t + 1) < W ? 1.0f / (float)(t + 1) : 1.0f / (float)W;
        v2u o; o.x = pk2(s0 * rc - x0, s1 * rc - x1); o.y = pk2(s2 * rc - x2, s3 * rc - x3);
        *(GAS v2u*)(po + (size_t)(r0 + i) * D) = o;
        s0 -= bflo(v[i].x); s1 -= bfhi(v[i].x); s2 -= bflo(v[i].y); s3 -= bfhi(v[i].y); }
}
__device__ __forceinline__ void pooled_unit(Frame& F, int pm, int g) {
    const bf16* P = (const bf16*)(F.ws + WS_PROJ); bf16* PO = (bf16*)(F.ws + WS_B);
    const int tid = F.tid(), c4 = tid & 63, seg = tid >> 6;
    const int r0 = pm * 256 + seg * 32, t0 = r0 % SEQ;
    const bf16* up = P + C_U + 256 * g + 4 * c4; bf16* po = PO + 256 * g + 4 * c4;
    if (g == 0) pooled_rows<2>(up, po, r0, t0); else if (g == 1) pooled_rows<4>(up, po, r0, t0); else if (g == 2) pooled_rows<8>(up, po, r0, t0); else pooled_rows<16>(up, po, r0, t0);
}

__device__ __forceinline__ int p5_row(int blk, int j) { return (blk >> 7) * SEQ + 128 * j + (blk & 127); }
__device__ __forceinline__ void p5b_fill(Frame& F) {
    unsigned char* rt = F.ws + WS_RT;
    const int* TOKE = (const int*)(rt + RT_TOKE); const float* TOKW = (const float*)(rt + RT_TOKW); const int* LRANK = (const int*)(rt + RT_LRANK); int* TOKSLOT = (int*)(rt + RT_TOKSLOT);
    const int* BLKCNT = (const int*)(rt + RT_BLKCNT); int* SLOTTOK = (int*)(rt + RT_SLOTTOK); float* SLOTW = (float*)(rt + RT_SLOTW); int* META = (int*)(rt + RT_META);
    LAS int* cntL = (LAS int*)(F.lds + RING_OFF);
    LAS int* totL = cntL + 4096;
    for (int i = F.tid(); i < 4096; i += NWAVES * 64) cntL[i] = BLKCNT[i];
    LDS_WAIT(); __syncthreads();
    for (int blk = F.vcu; blk < 256; blk += F.G) {
        { const int e = F.tid() >> 5, s = F.tid() & 31; int pt = 0, pb = 0;
            for (int bb = 8 * s; bb < 8 * s + 8; ++bb) { const int c = cntL[bb * 16 + e]; pt += c; pb += (bb < blk) ? c : 0; }
#pragma unroll
            for (int o = 1; o < 32; o <<= 1) { pt += __shfl_xor(pt, o); pb += __shfl_xor(pb, o); }
            if (s == 0) { totL[e] = pt; totL[16 + e] = pb; } }
        LDS_WAIT(); __syncthreads();
        if (F.tid() == 0) { int o = 0, nt = 0; for (int e = 0; e < 16; ++e) { totL[32 + e] = o; const int tl = (totL[e] + 255) >> 8;
                if (F.vcu == 0 && blk == 0) { META[e] = o; for (int i = 0; i < tl; ++i) META[32 + nt + i] = e; } nt += tl; o += tl * 256; }
            totL[48] = o; if (F.vcu == 0 && blk == 0) { META[16] = o; META[17] = o; META[18] = nt; } }
        LDS_WAIT(); __syncthreads();
        if (F.tid() < 128) { const int t = F.tid(), i = p5_row(blk, t >> 1) * 2 + (t & 1), e = TOKE[i]; const int slot = totL[32 + e] + totL[16 + e] + LRANK[i];
            SLOTTOK[slot] = i >> 1; SLOTW[slot] = TOKW[i]; TOKSLOT[i] = slot; }
        if (blk < 16) { const int e = blk; for (int s = totL[32 + e] + totL[e] + F.tid(); s < totL[32 + e + 1]; s += NWAVES * 64) { SLOTTOK[s] = 0; SLOTW[s] = 0.f; } }
        __syncthreads();
    }
}

__device__ __forceinline__ float swap32_add(float a, float b) { const auto r = __builtin_amdgcn_permlane32_swap(__float_as_uint(a), __float_as_uint(b), false, false); return __uint_as_float(r[0]) + __uint_as_float(r[1]); }
__device__ __forceinline__ float swap16_add(float a, float b) { const auto r = __builtin_amdgcn_permlane16_swap(__float_as_uint(a), __float_as_uint(b), false, false); return __uint_as_float(r[0]) + __uint_as_float(r[1]); }
template <int CTRL> __device__ __forceinline__ float dpp_add(float v) { return v + __uint_as_float((unsigned)__builtin_amdgcn_update_dpp(0, (int)__float_as_uint(v), CTRL, 0xf, 0xf, false)); }
__device__ __forceinline__ float row16_sum(float v) { v = dpp_add<0x128>(v); v = dpp_add<0x124>(v); v = dpp_add<0x122>(v); v = dpp_add<0x121>(v); return v; }
#define P5_BAR() do { LDS_WAIT(); __builtin_amdgcn_s_barrier(); asm volatile("" ::: "memory"); } while (0)
constexpr int P5_AP = 528, P5_HI = 4096, P5_LO = P5_HI + 64 * P5_AP, P5_PART = 73728;
__device__ __forceinline__ void p5a_block(Frame& F, int blk, LAS int* eL) {
    typedef float f4 __attribute__((ext_vector_type(4)));
    const bf16* X1 = (const bf16*)(F.ws + WS_B); const float* SSQ = (const float*)(F.ws + WS_SSQ); const float* ada = (const float*)(F.ws + WS_ADA); bf16* H2 = (bf16*)(F.ws + WS_C);
    const bf16* WRT = (const bf16*)(F.ws + WS_WRT);
    unsigned char* rt = F.ws + WS_RT;
    LAS unsigned char* L = F.lds + RING_OFF;
    LAS float* partL = (LAS float*)(L + P5_PART);
    const int lane = F.lane(), wid = F.wave(), r32 = lane & 31, hl = lane >> 5;
    const int b = blk >> 7, rowb = p5_row(blk, 0);
    const float* sh = ada + (size_t)b * NADA + 3 * D; const float* sc = ada + (size_t)b * NADA + 4 * D;
    LAS float* gsL = (LAS float*)(L + 110592); LAS float* hL = (LAS float*)(L + 118784);
    { const int d0 = 4 * F.tid(); const f4 g = *(const GAS f4*)(F.g2() + d0), s = *(const GAS f4*)(sc + d0), h = *(const GAS f4*)(sh + d0);
      *(LAS f4*)(gsL + d0) = g * (1.f + s); *(LAS f4*)(hL + d0) = h; }
    const int rot = blk & 7;
    if (wid < 4) {
        float rs[16];
#pragma unroll
        for (int i = 0; i < 16; ++i) rs[i] = SSQ[(size_t)(rowb + 128 * (wid * 16 + i)) * 32 + (lane & 31)];
        v2u xa[16], xb[16], xc[16], xd[16];
#pragma unroll
        for (int i = 0; i < 16; ++i) { const bf16* xp = X1 + (size_t)(rowb + 128 * (wid * 16 + i)) * D + 4 * lane; xa[i] = __builtin_nontemporal_load((const GAS v2u*)(xp + 256 * (rot & 7))); xb[i] = __builtin_nontemporal_load((const GAS v2u*)(xp + 256 * ((rot + 1) & 7))); xc[i] = __builtin_nontemporal_load((const GAS v2u*)(xp + 256 * ((rot + 2) & 7))); xd[i] = __builtin_nontemporal_load((const GAS v2u*)(xp + 256 * ((rot + 3) & 7))); }
#pragma unroll
        for (int i = 0; i < 16; ++i) rs[i] = rsqrtf(wave_sum(lane < 32 ? rs[i] : 0.f) * (1.0f / D) + EPS);
        P5_BAR();
        auto xstep = [&](int j, v2u (&xn)[16]) { int d = 4 * lane + 256 * ((j + rot) & 7), dn = 4 * lane + 256 * ((j + 4 + rot) & 7); asm volatile("" : "+v"(d), "+v"(dn));
            const f4 gs = *(const LAS f4*)(gsL + d), h = *(const LAS f4*)(hL + d);
#pragma unroll
            for (int i = 0; i < 16; ++i) { const int rl = wid * 16 + i; const f4 xf = {bflo(xn[i].x), bfhi(xn[i].x), bflo(xn[i].y), bfhi(xn[i].y)}; const f4 hv = xf * rs[i] * gs + h;
                v2u whi; whi.x = pk2(hv.x, hv.y); whi.y = pk2(hv.z, hv.w);
                v2u wlo; wlo.x = pk2(hv.x - bflo(whi.x), hv.y - bfhi(whi.x)); wlo.y = pk2(hv.z - bflo(whi.y), hv.w - bfhi(whi.y));
                *(LAS v2u*)(L + P5_HI + rl * P5_AP + 8 * lane) = whi; *(LAS v2u*)(L + P5_LO + rl * P5_AP + 8 * lane) = wlo;
                *(GAS v2u*)(H2 + (size_t)(rowb + 128 * rl) * D + d) = whi; }
            if (j < 4) {
#pragma unroll
                for (int i = 0; i < 16; ++i) xn[i] = __builtin_nontemporal_load((const GAS v2u*)(X1 + (size_t)(rowb + 128 * (wid * 16 + i)) * D + dn)); }
            P5_BAR();
            P5_BAR(); };
#pragma unroll 1
        for (int jj = 0; jj < 8; jj += 4) { xstep(jj, xa); xstep(jj + 1, xb); xstep(jj + 2, xc); xstep(jj + 3, xd); }
    } else {
        const int kq = wid - 4;
        f32x16 acc0 = {}, acc1 = {};
        auto wload = [&](int j, bf16x8 (&bh)[4], bf16x8 (&bl)[4]) { int jq = (j + rot) & 7; asm volatile("" : "+s"(jq));
#pragma unroll
            for (int s4 = 0; s4 < 4; ++s4) { const bf16* wp = WRT + ((size_t)((jq * 4 + kq) * 4 + s4) * 2) * 512 + lane * 8; bh[s4] = *(const GAS bf16x8*)wp; bl[s4] = *(const GAS bf16x8*)(wp + 512); } };
        bf16x8 wah[4], wal[4], wbh[4], wbl[4];
        wload(0, wah, wal);
        P5_BAR();
        auto mstep = [&](int j, const bf16x8 (&bh)[4], const bf16x8 (&bl)[4], bf16x8 (&nh)[4], bf16x8 (&nl)[4]) {
            if (j < 7) wload(j + 1, nh, nl);
            P5_BAR();
#pragma unroll
            for (int s4 = 0; s4 < 4; ++s4) { const int ao = r32 * P5_AP + (64 * kq + 16 * s4 + 8 * hl) * 2;
                const bf16x8 ah0 = *(const LAS bf16x8*)(L + P5_HI + ao), al0 = *(const LAS bf16x8*)(L + P5_LO + ao);
                const bf16x8 ah1 = *(const LAS bf16x8*)(L + P5_HI + 32 * P5_AP + ao), al1 = *(const LAS bf16x8*)(L + P5_LO + 32 * P5_AP + ao);
                acc0 = __builtin_amdgcn_mfma_f32_32x32x16_bf16(ah0, bh[s4], acc0, 0, 0, 0); acc1 = __builtin_amdgcn_mfma_f32_32x32x16_bf16(ah1, bh[s4], acc1, 0, 0, 0);
                acc0 = __builtin_amdgcn_mfma_f32_32x32x16_bf16(ah0, bl[s4], acc0, 0, 0, 0); acc1 = __builtin_amdgcn_mfma_f32_32x32x16_bf16(ah1, bl[s4], acc1, 0, 0, 0);
                acc0 = __builtin_amdgcn_mfma_f32_32x32x16_bf16(al0, bh[s4], acc0, 0, 0, 0); acc1 = __builtin_amdgcn_mfma_f32_32x32x16_bf16(al1, bh[s4], acc1, 0, 0, 0); }
            P5_BAR(); };
#pragma unroll 1
        for (int jj = 0; jj < 8; jj += 4) { mstep(jj, wah, wal, wbh, wbl); mstep(jj + 1, wbh, wbl, wah, wal); mstep(jj + 2, wah, wal, wbh, wbl); mstep(jj + 3, wbh, wbl, wah, wal); }
#pragma unroll
        for (int r = 0; r < 16; ++r) { const int ro = ((r & 3) + 8 * (r >> 2) + 4 * hl) * 33 + r32; partL[(2 * kq) * 1056 + ro] = acc0[r]; partL[(2 * kq + 1) * 1056 + ro] = acc1[r]; }
    }
    P5_BAR();
    if (wid == 4) {
        float lg[20]; const int prb = lane >> 5, prow = lane & 31;
#pragma unroll
        for (int o = 0; o < 20; ++o) { float v = 0.f;
#pragma unroll
            for (int q = 0; q < 4; ++q) v += partL[(2 * q + prb) * 1056 + prow * 33 + o];
            lg[o] = v; }
        float gl[4]; int gi = 0;
#pragma unroll
        for (int o = 0; o < 4; ++o) gl[o] = lg[o] + F.b_rg()[o];
#pragma unroll
        for (int o = 1; o < 4; ++o) if (gl[o] > gl[gi]) gi = o;
        float gsum = 0.f;
#pragma unroll
        for (int o = 0; o < 4; ++o) gsum += __expf(gl[o] - gl[gi]);
        const float gp = 1.0f / gsum;
        float el[4];
#pragma unroll
        for (int o = 0; o < 4; ++o) { float v = 0.f;
#pragma unroll
            for (int g = 0; g < 4; ++g) v = (g == gi) ? lg[4 + 4 * g + o] + F.b_re()[4 * g + o] : v;
            el[o] = v; }
        int i1 = 0;
#pragma unroll
        for (int o = 1; o < 4; ++o) if (el[o] > el[i1]) i1 = o;
        int i2 = (i1 == 0) ? 1 : 0;
#pragma unroll
        for (int o = 0; o < 4; ++o) if (o != i1 && el[o] > el[i2]) i2 = o;
        const float rr = __expf(el[i2] - el[i1]);
        const float w1 = gp / (1.0f + rr), w2 = gp * rr / (1.0f + rr);
        const int row = rowb + 128 * lane, e1 = gi * 4 + i1, e2 = gi * 4 + i2;
        const unsigned long long lt = (1ull << lane) - 1ull; int r1 = 0, r2 = 0, mycnt = 0;
        for (int e = 0; e < NEXP; ++e) { const unsigned long long m1 = __ballot(e1 == e), m2 = __ballot(e2 == e);
            if (e1 == e) r1 = __popcll(m1 & lt); if (e2 == e) r2 = __popcll(m1) + __popcll(m2 & lt);
            if (lane == e) mycnt = __popcll(m1) + __popcll(m2); }
        int base = 0; if (lane < NEXP) base = (int)__hip_atomic_fetch_add((unsigned*)(F.ctl + CW_CNT) + lane, (unsigned)mycnt, __ATOMIC_RELAXED, __HIP_MEMORY_SCOPE_AGENT);
        const int p1 = e1 * T + __shfl(base, e1) + r1, p2 = e2 * T + __shfl(base, e2) + r2;
        int* LTOK = (int*)(F.ws + WS_LTOK); float* LW = (float*)(F.ws + WS_LW);
        LTOK[p1] = row; LW[p1] = w1; LTOK[p2] = row; LW[p2] = w2;
        ((int*)(rt + RT_TOKSLOT))[row * 2] = p1; ((int*)(rt + RT_TOKSLOT))[row * 2 + 1] = p2;
    }
}

__global__ void __launch_bounds__(NWAVES * 64, 2) mk_fwd(Args args) {
    extern __shared__ __attribute__((aligned(16))) unsigned char lds[];
    Frame F;
    F.lds = (LAS unsigned char*)lds; F.MISC = (volatile LAS unsigned*)(F.lds + MISC_OFF); F.LM = (LAS int*)(F.lds + LMETA_OFF);
    F.G = gridDim.x; { const int bx = blockIdx.x; F.vcu = (F.G % 8 == 0) ? (bx % 8) * (F.G / 8) + bx / 8 : bx; }
    F.ws = args.ws; F.out = args.out; F.ctl = (gu32*)(args.ws + WS_CTL);
    F.ka = (KArgs)__builtin_amdgcn_kernarg_segment_ptr();
    { int zt = F.tid(); asm volatile("" : "+v"(zt));
      for (int u = zt; u < (LDS_BYTES - LDSCTL_OFF) / 4; u += NWAVES * 64) ((LAS unsigned*)(F.lds + LDSCTL_OFF))[u] = 0u; }
    __syncthreads();
    const int lo = args.ph_lo, hi = args.ph_hi;
    XcdBarrier bar; bar.bar = (unsigned*)(F.ctl + CW_BAR); bar.x = 0; bar.st = nullptr;
    if (hi - lo > 1) bar = xcd_barrier_post((unsigned*)(F.ctl + CW_BAR), F.MISC);
#ifndef ENMASK
#define ENMASK 0x7FF
#endif
#define IN(k) (((ENMASK >> (k)) & 1) && lo <= (k) && (k) < hi)
#define SEAM(k) do { if (IN(k) && IN((k) + 1)) xcd_barrier(bar); } while (0)
#ifndef REPMASK
#define REPMASK 0
#endif
#define REP(k) _Pragma("unroll 1") for (int rep_ = 0; rep_ < 1 + ((REPMASK >> (k)) & 1); ++rep_)
    unsigned char* ws = args.ws; float* ADA = (float*)(ws + WS_ADA);
    bf16* PROJ = (bf16*)(ws + WS_PROJ); bf16* BUFB = (bf16*)(ws + WS_B); bf16* BUFC = (bf16*)(ws + WS_C);
    unsigned char* rt = ws + WS_RT;

    if (IN(0)) REP(0) { p0_prologue(F); } SEAM(0);
    if (IN(1)) REP(1) { p0b_h1(F); } SEAM(1);
    if (IN(2)) REP(2) {
        pg8::Gemm g{BUFB, (const bf16*)(ws + WS_WIN), D, D, D, 0, nullptr, nullptr}; pg8::StaticOrder S; S.init(T, NPROJ, F.G, (int)blockIdx.x);
        pg8::gemm_phase<pg8::EpProj, pg8::StaticOrder, false>(F.lds + RING_OFF, g, S, pg8::EpProj{PROJ, (unsigned char*)F.out + 64 * MiB}, STG_P1);
        { const int nwg = (T / 256) * (NPROJ / 256), rem = nwg % F.G, c = (int)blockIdx.x;
          const int nidle = rem ? F.G - rem : F.G, first = rem ? rem : 0;
          if (c >= first) {
              for (int j = c - first; j < 32; j += nidle) { const int gq = j >> 3;
                  pg8::Gemm gf{(const bf16*)(ws + WS_WTMP) + 256 * gq, (const bf16*)(ws + WS_WPOOL), 1024, 256, 256, 65536, nullptr, nullptr};
                  pg8::OneUnit SF{{j & 7, 0, gq}};
                  pg8::gemm_phase<pg8::EpFold, pg8::OneUnit, false>(F.lds + RING_OFF, gf, SF, pg8::EpFold{(bf16*)(ws + WS_WPB)}); }
              { const int nfold = nidle > 64 ? 32 : 0, ci = c - first;
                if (ci >= nfold) p0_convert_tail(F, (ci - nfold) * NWAVES + F.wave(), (nidle - nfold) * NWAVES, cv::NP1, [](int j) { return cv::map_p1(j); }); } }
          __syncthreads(); }
    } SEAM(2);
    if (IN(3)) REP(3) {
        attn_phase(F);
        for (int u = F.vcu; u < 256; u += F.G) pooled_unit(F, u >> 2, u & 3);
    } SEAM(3);
    if (IN(4)) REP(4) {
        pg8::Gemm g{BUFB, (const bf16*)(ws + WS_WPB), D, D, D, 0, nullptr, nullptr}; pg8::StaticOrder S; S.init(T, D, F.G, (int)blockIdx.x);
        pg8::gemm_phase<pg8::EpMergedR, pg8::StaticOrder, false, true>(F.lds + RING_OFF, g, S, pg8::EpMergedR{BUFC, (const unsigned char*)F.out + 64 * MiB});
    } SEAM(4);
    if (IN(5)) REP(5) {
        pg8::Gemm g{BUFC, (const bf16*)(ws + WS_WOUT), D, D, D, 0, nullptr, nullptr}; pg8::StaticOrder S; S.init(T, D, F.G, (int)blockIdx.x);
        pg8::gemm_phase<pg8::EpX1, pg8::StaticOrder, false>(F.lds + RING_OFF, g, S, pg8::EpX1{F.x(), BUFB, ADA, (float*)(ws + WS_SSQ)}, STG_P4);
    } SEAM(5);
    if (IN(6)) REP(6) {
        LAS int* eL = (LAS int*)(F.lds + RING_OFF);
        for (int blk = F.vcu; blk < 256; blk += F.G) { p5a_block(F, blk, eL); LDS_WAIT(); __syncthreads(); }
    } SEAM(6);
    if (IN(8) || IN(9) || IN(10)) {
        if (F.wave() == 0) { const int l = F.lane(); int c = 0;
            if (l < NEXP) c = (int)__hip_atomic_load((unsigned*)(F.ctl + CW_CNT) + l, __ATOMIC_RELAXED, __HIP_MEMORY_SCOPE_AGENT);
            const int tl = (c + 255) >> 8; int incl = tl;
#pragma unroll
            for (int d = 1; d < NEXP; d <<= 1) { const int v = __shfl_up(incl, d); if (l >= d) incl += v; }
            const int nt0 = incl - tl, total = __shfl(incl, NEXP - 1);
            if (l < NEXP) { F.LM[l] = nt0 * 256; F.LM[192 + l] = c; F.LM[208 + l] = nt0; for (int i = 0; i < tl; ++i) F.LM[32 + nt0 + i] = l; }
            if (l == 0) { F.LM[16] = total * 256; F.LM[18] = total; } }
        LDS_WAIT(); __syncthreads();
    }
    if (IN(8)) REP(8) {
        pg8::Gemm g{BUFC, (const bf16*)(ws + WS_WGU), D, D, D, (size_t)1024 * D, (const int*)(ws + WS_LTOK), F.LM};
        pg8::DynOrder S{F.LM[18] * 4, 4, F.G, F.vcu, F.LM + 32};
        pg8::gemm_phase<pg8::EpAct, pg8::DynOrder, true>(F.lds + RING_OFF, g, S, pg8::EpAct{(bf16*)(ws + WS_ACT), (const float*)(ws + WS_LW), F.LM});
        { const int nun = F.LM[18] * 4, rem = nun % F.G, c = F.vcu;
          const int nidle = rem ? F.G - rem : F.G, first = rem ? rem : 0;
          if (c >= first) p0_convert_tail(F, (c - first) * NWAVES + F.wave(), nidle * NWAVES, cv::NP6, [](int j) { return cv::map_p6(j); });
          __syncthreads(); }
    } SEAM(8);
    if (IN(9)) REP(9) {
        pg8::Gemm g{(const bf16*)(ws + WS_ACT), (const bf16*)(ws + WS_WDN), FF, FF, FF, (size_t)D * FF, nullptr, nullptr};
        pg8::DynOrder S{F.LM[18] * 8, 8, F.G, F.vcu, F.LM + 32};
        pg8::gemm_phase<pg8::EpY, pg8::DynOrder, false>(F.lds + RING_OFF, g, S, pg8::EpY{(bf16*)(ws + WS_Y)}, STG_P7);
    } SEAM(9);
    if (IN(10)) {
        const int gw = F.vcu * NWAVES + F.wave(), NGW = F.G * NWAVES;
        for (int row = gw; row < T; row += NGW) final_row_pos(BUFB, F.out, (const bf16*)(ws + WS_Y), (const int*)(rt + RT_TOKSLOT), F.LM, ADA, F.fg(), row, F.lane());
    }
#undef IN
#undef SEAM
}

#ifndef FASTMASK
#define FASTMASK 0x7FF
#endif
#ifndef ONE_LAUNCH
#define ONE_LAUNCH 1
#endif
constexpr int NPHASE = 11;
extern "C" void kernel_launch(void* const* d_in, const int* in_sizes, int n_in, void* d_out, int out_size, void* d_ws, size_t ws_size, hipStream_t stream) {
    if (n_in != 21 || out_size != T * D || ws_size < WS_END) { fprintf(stderr, "kernel_launch: unexpected shapes (n_in %d out %d ws %zu)\n", n_in, out_size, ws_size); return; }
    static int grid = 0;
    if (grid == 0) {
        int dev = 0, cus = 0, per_cu = 0;
        if (hipGetDevice(&dev) != hipSuccess || hipDeviceGetAttribute(&cus, hipDeviceAttributeMultiprocessorCount, dev) != hipSuccess) { fprintf(stderr, "kernel_launch: device query failed\n"); grid = -1; return; }
        if (hipFuncSetAttribute((const void*)mk_fwd, hipFuncAttributeMaxDynamicSharedMemorySize, LDS_BYTES) != hipSuccess) { fprintf(stderr, "kernel_launch: hipFuncSetAttribute failed\n"); grid = -1; return; }
        if (hipOccupancyMaxActiveBlocksPerMultiprocessor(&per_cu, (const void*)mk_fwd, NWAVES * 64, LDS_BYTES) != hipSuccess || per_cu < 1) { fprintf(stderr, "kernel_launch: occupancy query says %d\n", per_cu); }
        (void)hipGetLastError();
        grid = cus;
    }
    if (grid < 0) return;
    const float* x = (const float*)d_in[0]; const float* c = (const float*)d_in[1]; const float* w_ada = (const float*)d_in[2]; const float* b_ada = (const float*)d_in[3];
    const float* norm1_g = (const float*)d_in[4]; const float* w_in = (const float*)d_in[5]; const float* sinks = (const float*)d_in[6]; const float* w_pool = (const float*)d_in[7];
    const float* pool_scale = (const float*)d_in[8]; const float* w_ab = (const float*)d_in[9]; const float* w_pb = (const float*)d_in[10]; const float* w_out = (const float*)d_in[11];
    const float* norm2_g = (const float*)d_in[12]; const float* w_rg = (const float*)d_in[13]; const float* b_rg = (const float*)d_in[14]; const float* w_re = (const float*)d_in[15];
    const float* b_re = (const float*)d_in[16]; const float* w_eg = (const float*)d_in[17]; const float* w_eu = (const float*)d_in[18]; const float* w_ed = (const float*)d_in[19];
    const float* final_g = (const float*)d_in[20];
    unsigned char* ws = (unsigned char*)d_ws; float* out = (float*)d_out;
    float* ADA = (float*)(ws + WS_ADA); float* ADAP = (float*)(ws + WS_ADAP); float* SSQ = (float*)(ws + WS_SSQ);
    bf16* PROJ = (bf16*)(ws + WS_PROJ); bf16* ACT = (bf16*)(ws + WS_ACT); bf16* Y = (bf16*)(ws + WS_Y);
    bf16* BUFB = (bf16*)(ws + WS_B); bf16* BUFC = (bf16*)(ws + WS_C);
    unsigned char* rt = ws + WS_RT;
    int* TOKE = (int*)(rt + RT_TOKE); float* TOKW = (float*)(rt + RT_TOKW); int* LRANK = (int*)(rt + RT_LRANK); int* TOKSLOT = (int*)(rt + RT_TOKSLOT);
    int* BLKCNT = (int*)(rt + RT_BLKCNT); int* BLKBASE = (int*)(rt + RT_BLKBASE); int* SLOTTOK = (int*)(rt + RT_SLOTTOK); float* SLOTW = (float*)(rt + RT_SLOTW); int* META = (int*)(rt + RT_META);

    (void)hipMemsetAsync(ws + WS_CTL, 0, 1 * MiB, stream);
    Args a{}; for (int i = 0; i < 21; ++i) a.in[i] = (const float*)d_in[i]; a.out = out; a.ws = ws;
    if (ONE_LAUNCH && FASTMASK == 0x7FF) { a.ph_lo = 0; a.ph_hi = NPHASE; hipLaunchKernelGGL(mk_fwd, dim3(grid), dim3(NWAVES * 64), LDS_BYTES, stream, a);
#ifdef EXTRA_PHASE
        a.ph_lo = EXTRA_PHASE; a.ph_hi = EXTRA_PHASE + 1; hipLaunchKernelGGL(mk_fwd, dim3(grid), dim3(NWAVES * 64), LDS_BYTES, stream, a);
#endif
        return; }
    for (int ph = 0; ph < NPHASE; ++ph) {
        const bool fast = (FASTMASK >> ph) & 1;
        if (fast || (ph == 0 && (FASTMASK & 0x33C))) { a.ph_lo = ph; a.ph_hi = ph + 1; hipLaunchKernelGGL(mk_fwd, dim3(grid), dim3(NWAVES * 64), LDS_BYTES, stream, a); if (fast) continue; }
        switch (ph) {
        case 0: nv::ada_part<<<dim3(NADA / 256, ADA_SL), 256, 0, stream>>>(c, w_ada, ADAP); break;
        case 1: nv::ada_sum<<<2 * NADA / 256, 256, 0, stream>>>(ADAP, b_ada, ADA); nv::h1<<<T / 4, 256, 0, stream>>>(x, norm1_g, ADA, BUFB); break;
        case 2: nv::gemm<false><<<dim3(NPROJ / 64, T / 64), 256, 0, stream>>>(nv::ABf16{BUFB, D, 0}, nv::WPlain{w_in, NPROJ}, nv::WPlain{w_in, NPROJ}, nv::EpProj{PROJ}, D); break;
        case 3: nv::attn<<<dim3(SEQ / 16, 16, BATCH), 256, 0, stream>>>(PROJ, sinks, BUFB);
                nv::pooled<<<(unsigned)((size_t)T * 1024 / 256), 256, 0, stream>>>(PROJ, BUFC);
                for (int g = 0; g < 4; ++g) nv::gemm<false><<<dim3(256 / 64, T / 64), 256, 0, stream>>>(nv::ABf16{BUFC, 1024, g * 256}, nv::WPlain{w_pool + (size_t)g * 256 * 256, 256}, nv::WPlain{w_pool, 256}, nv::EpPool{BUFB, pool_scale, g}, 256);
                break;
        case 4: nv::gemm<false><<<dim3(D / 64, T / 64), 256, 0, stream>>>(nv::ABf16{BUFB, D, 0}, nv::WPlain{w_pb, D}, nv::WPlain{w_pb, D}, nv::EpT1{BUFC, PROJ}, 1024);
                nv::gemm<false><<<dim3(D / 64, T / 64), 256, 0, stream>>>(nv::ABf16{BUFB, D, 1024}, nv::WPlain{w_ab, D}, nv::WPlain{w_ab, D}, nv::EpMerged{BUFC, PROJ}, 1024); break;
        case 5: nv::gemm<false><<<dim3(D / 64, T / 64), 256, 0, stream>>>(nv::ABf16{BUFC, D, 0}, nv::WPlain{w_out, D}, nv::WPlain{w_out, D}, nv::EpX1{out, x, ADA}, D);
                nv::ssq<<<T / 4, 256, 0, stream>>>(out, SSQ); break;
        case 6: nv::route<<<T / 4, 256, 0, stream>>>(out, SSQ, norm2_g, ADA, w_rg, b_rg, w_re, b_re, BUFB, TOKE, TOKW); nv::hist<<<256, 64, 0, stream>>>(TOKE, BLKCNT, LRANK); break;
        case 7: nv::scan<<<1, 256, 0, stream>>>(BLKCNT, BLKBASE, META, SLOTTOK, SLOTW); nv::fill<<<2 * T / 256, 256, 0, stream>>>(TOKE, TOKW, LRANK, BLKBASE, META, SLOTTOK, SLOTW, TOKSLOT); break;
        case 8: nv::gemm<true><<<dim3(FF / 64, MAXSLOT / 64), 256, 0, stream>>>(nv::AGather{BUFB, D, SLOTTOK, META}, nv::WExpert{w_eg, FF, (size_t)D * FF, META}, nv::WExpert{w_eu, FF, (size_t)D * FF, META}, nv::EpAct{ACT, SLOTW}, D); break;
        case 9: nv::gemm<false><<<dim3(D / 64, MAXSLOT / 64), 256, 0, stream>>>(nv::ASlot{ACT, FF, META}, nv::WExpert{w_ed, D, (size_t)FF * D, META}, nv::WExpert{w_ed, D, (size_t)FF * D, META}, nv::EpY{Y}, FF); break;
        case 10: nv::final_<<<T / 4, 256, 0, stream>>>(out, Y, TOKSLOT, ADA, final_g); break;
        }
    }
}
```

```cpp
#include <hip/hip_runtime.h>
#include <stdint.h>
#include <cstdio>

constexpr int D = 2048, BATCH = 2, SEQ = 8192, T = BATCH * SEQ;
constexpr int NPROJ = 6656;
constexpr int C_Q = 0, C_K = 1024, C_V = 1280, C_U = 1536, C_GA = 2560, C_GP = 4608;
constexpr int NADA = 6 * D;
constexpr int NEXP = 16, FF = 512;
constexpr int MAXSLOT = 2 * T + NEXP * 256;
constexpr int ADA_SL = 16;
constexpr float EPS = 1e-6f;
constexpr float LOG2E = 1.4426950408889634f;
constexpr float C2 = 0.125f * LOG2E;

typedef unsigned short bf16;

constexpr size_t MiB = 1u << 20;
constexpr size_t WS_CTL = 0;
constexpr size_t WS_ADA = 1 * MiB;
constexpr size_t WS_WRT = WS_ADA + 512 * 1024;
constexpr size_t WS_LTOK = 2 * MiB;
constexpr size_t WS_LW = 3 * MiB;
constexpr size_t WS_ADAP = 2 * MiB;
constexpr size_t WS_WIN = 4 * MiB;
constexpr size_t WS_WTMP = 416 * MiB;
constexpr size_t WS_WPB = 30 * MiB;
constexpr size_t WS_WAB = 34 * MiB;
constexpr size_t WS_WOUT = 38 * MiB;
constexpr size_t WS_WPOOL = 46 * MiB;
constexpr size_t WS_WGU = 47 * MiB;
constexpr size_t WS_WDN = 111 * MiB;
constexpr size_t WS_PROJ = 144 * MiB;
constexpr size_t WS_ACT = 144 * MiB;
constexpr size_t WS_Y = 180 * MiB;
constexpr size_t WS_B = 352 * MiB;
constexpr size_t WS_C = 416 * MiB;
constexpr size_t WS_RT = 480 * MiB;
constexpr size_t WS_SSQ = 482 * MiB;
constexpr size_t WS_END = 484 * MiB;
constexpr size_t RT_TOKE = 0;
constexpr size_t RT_TOKW = RT_TOKE + (size_t)T * 2 * 4;
constexpr size_t RT_LRANK = RT_TOKW + (size_t)T * 2 * 4;
constexpr size_t RT_TOKSLOT = RT_LRANK + (size_t)T * 2 * 4;
constexpr size_t RT_BLKCNT = RT_TOKSLOT + (size_t)T * 2 * 4;
constexpr size_t RT_BLKBASE = RT_BLKCNT + 256 * 16 * 4;
constexpr size_t RT_SLOTTOK = RT_BLKBASE + 256 * 16 * 4;
constexpr size_t RT_SLOTW = RT_SLOTTOK + (size_t)MAXSLOT * 4;
constexpr size_t RT_META = RT_SLOTW + (size_t)MAXSLOT * 4;
static_assert(RT_META + 1024 * 4 <= 2 * MiB, "routing arrays");

__device__ __forceinline__ unsigned f2bf(float f) { unsigned u = __builtin_bit_cast(unsigned, f); return (u + 0x7fffu + ((u >> 16) & 1u)) >> 16; }
__device__ __forceinline__ float bf2f(unsigned h) { return __builtin_bit_cast(float, h << 16); }
__device__ __forceinline__ float bflo(unsigned w) { return __builtin_bit_cast(float, w << 16); }
__device__ __forceinline__ float bfhi(unsigned w) { return __builtin_bit_cast(float, w & 0xffff0000u); }
__device__ __forceinline__ float wave_sum(float v) {
#pragma unroll
    for (int o = 1; o < 64; o <<= 1) v += __shfl_xor(v, o);
    return v;
}
__device__ __forceinline__ float sigmoidf_(float v) { return 1.0f / (1.0f + __expf(-v)); }
__device__ __forceinline__ float sigmoid_fast(float v) { return __builtin_amdgcn_rcpf(1.0f + __builtin_amdgcn_exp2f(-LOG2E * v)); }

namespace nv {
__global__ __launch_bounds__(256) void ada_part(const float* __restrict__ c, const float* __restrict__ W, float* __restrict__ adap) {
    const int j = blockIdx.x * 256 + threadIdx.x, ks = blockIdx.y; constexpr int KS = D / ADA_SL;
    float a0 = 0.f, a1 = 0.f;
    for (int k = ks * KS; k < ks * KS + KS; ++k) { const float w = W[(size_t)k * NADA + j]; a0 += c[k] * w; a1 += c[D + k] * w; }
    adap[((size_t)ks * 2 + 0) * NADA + j] = a0; adap[((size_t)ks * 2 + 1) * NADA + j] = a1;
}
__global__ __launch_bounds__(256) void ada_sum(const float* __restrict__ adap, const float* __restrict__ bias, float* __restrict__ ada) {
    const int i = blockIdx.x * 256 + threadIdx.x;
    const int b = i / NADA, j = i % NADA; float s = bias[j];
    for (int ks = 0; ks < ADA_SL; ++ks) s += adap[((size_t)ks * 2 + b) * NADA + j];
    ada[i] = s;
}
__global__ __launch_bounds__(256) void h1(const float* __restrict__ x, const float* __restrict__ g1, const float* __restrict__ ada, bf16* __restrict__ H1) {
    const int lane = threadIdx.x & 63, row = blockIdx.x * 4 + (threadIdx.x >> 6), b = row / SEQ;
    const float4* xr = (const float4*)(x + (size_t)row * D) + lane;
    float4 v[8]; float ss = 0.f;
#pragma unroll
    for (int j = 0; j < 8; ++j) { v[j] = xr[64 * j]; ss += v[j].x * v[j].x + v[j].y * v[j].y + v[j].z * v[j].z + v[j].w * v[j].w; }
    const float rstd = rsqrtf(wave_sum(ss) * (1.0f / D) + EPS);
    const float* sh = ada + (size_t)b * NADA + 0 * D; const float* sc = ada + (size_t)b * NADA + 1 * D;
#pragma unroll
    for (int j = 0; j < 8; ++j) { const int d = 4 * lane + 256 * j;
        const float4 g = *(const float4*)(g1 + d), s = *(const float4*)(sc + d), h = *(const float4*)(sh + d);
        const float o0 = v[j].x * rstd * g.x * (1.f + s.x) + h.x, o1 = v[j].y * rstd * g.y * (1.f + s.y) + h.y;
        const float o2 = v[j].z * rstd * g.z * (1.f + s.z) + h.z, o3 = v[j].w * rstd * g.w * (1.f + s.w) + h.w;
        uint2 w; w.x = f2bf(o0) | (f2bf(o1) << 16); w.y = f2bf(o2) | (f2bf(o3) << 16);
        *(uint2*)(H1 + (size_t)row * D + d) = w; }
}
struct ABf16 { const bf16* A; long long lda; long long koff;
    __device__ bool init(int bm) { return true; }
    __device__ const bf16* rowptr(int m) const { return A + (size_t)m * lda + koff; } };
struct AGather { const bf16* A; long long lda; const int* slot_tok; const int* meta;
    __device__ bool init(int bm) { return bm < meta[17]; }
    __device__ const bf16* rowptr(int m) const { return A + (size_t)slot_tok[m] * lda; } };
struct ASlot { const bf16* A; long long lda; const int* meta;
    __device__ bool init(int bm) { return bm < meta[17]; }
    __device__ const bf16* rowptr(int m) const { return A + (size_t)m * lda; } };
struct WPlain { const float* W; long long ldw;
    __device__ const float* base(int bm) const { return W; } };
struct WExpert { const float* W; long long ldw; size_t estride; const int* meta;
    __device__ const float* base(int bm) const { return W + (size_t)meta[32 + (bm >> 8)] * estride; } };

template <bool DUAL, class AL, class WL, class EP>
__global__ __launch_bounds__(256) void gemm(AL al, WL wl, WL wl2, EP ep, long long K_) {
    const int K = (int)K_;
    __shared__ float As[16][68]; __shared__ float Ws[16][64]; __shared__ float Ws2[DUAL ? 16 : 1][64];
    const int tid = threadIdx.x, tx = tid & 15, ty = tid >> 4, bm = blockIdx.y * 64, bn = blockIdx.x * 64;
    if (!al.init(bm)) return;
    const float* Wb = wl.base(bm); const float* Wb2 = DUAL ? wl2.base(bm) : nullptr;
    const bf16* arow = al.rowptr(bm + (tid >> 2)); const int ak = (tid & 3) * 4;
    float acc[4][4], acc2[4][4];
#pragma unroll
    for (int i = 0; i < 4; ++i)
#pragma unroll
        for (int j = 0; j < 4; ++j) { acc[i][j] = 0.f; acc2[i][j] = 0.f; }
    for (int k0 = 0; k0 < K; k0 += 16) {
        const uint2 a = *(const uint2*)(arow + k0 + ak);
        As[ak + 0][tid >> 2] = bf2f(a.x & 0xffffu); As[ak + 1][tid >> 2] = bf2f(a.x >> 16); As[ak + 2][tid >> 2] = bf2f(a.y & 0xffffu); As[ak + 3][tid >> 2] = bf2f(a.y >> 16);
        *(float4*)&Ws[ty][tx * 4] = *(const float4*)(Wb + (size_t)(k0 + ty) * wl.ldw + bn + tx * 4);
        if (DUAL) *(float4*)&Ws2[ty][tx * 4] = *(const float4*)(Wb2 + (size_t)(k0 + ty) * wl.ldw + bn + tx * 4);
        __syncthreads();
#pragma unroll
        for (int kk = 0; kk < 16; ++kk) {
            const float4 av = *(const float4*)&As[kk][ty * 4]; const float4 wv = *(const float4*)&Ws[kk][tx * 4];
            const float a4[4] = {av.x, av.y, av.z, av.w}, w4[4] = {wv.x, wv.y, wv.z, wv.w};
#pragma unroll
            for (int i = 0; i < 4; ++i)
#pragma unroll
                for (int j = 0; j < 4; ++j) acc[i][j] += a4[i] * w4[j];
            if (DUAL) { const float4 wv2 = *(const float4*)&Ws2[kk][tx * 4]; const float u4[4] = {wv2.x, wv2.y, wv2.z, wv2.w};
#pragma unroll
                for (int i = 0; i < 4; ++i)
#pragma unroll
                    for (int j = 0; j < 4; ++j) acc2[i][j] += a4[i] * u4[j]; }
        }
        __syncthreads();
    }
#pragma unroll
    for (int i = 0; i < 4; ++i)
#pragma unroll
        for (int j = 0; j < 4; ++j) ep(bm + ty * 4 + i, bn + tx * 4 + j, acc[i][j], acc2[i][j]);
}
struct EpProj { bf16* P;
    __device__ void operator()(int m, int n, float v, float) const {
        if (n < C_K) v *= C2; else if (n >= C_GA) v = sigmoidf_(v);
        P[(size_t)m * NPROJ + n] = (bf16)f2bf(v); } };
struct EpPool { bf16* AP; const float* pool_scale; long long g;
    __device__ void operator()(int m, int n, float v, float) const { AP[(size_t)m * D + g * 256 + n] = (bf16)f2bf(v * pool_scale[g * 256 + n]); } };
struct EpT1 { bf16* T1; const bf16* P;
    __device__ void operator()(int m, int n, float v, float) const { T1[(size_t)m * D + n] = (bf16)f2bf(v * bf2f(P[(size_t)m * NPROJ + C_GP + n])); } };
struct EpMerged { bf16* T1; const bf16* P;
    __device__ void operator()(int m, int n, float v, float) const { const size_t o = (size_t)m * D + n; T1[o] = (bf16)f2bf(v * bf2f(P[(size_t)m * NPROJ + C_GA + n]) + bf2f(T1[o])); } };
struct EpX1 { float* X1; const float* x; const float* ada;
    __device__ void operator()(int m, int n, float v, float) const { const size_t o = (size_t)m * D + n; X1[o] = x[o] + ada[(size_t)(m / SEQ) * NADA + 2 * D + n] * v; } };
struct EpAct { bf16* ACT; const float* slot_w;
    __device__ void operator()(int m, int n, float g, float u) const { ACT[(size_t)m * FF + n] = (bf16)f2bf(g * sigmoidf_(g) * u * slot_w[m]); } };
struct EpY { bf16* Y;
    __device__ void operator()(int m, int n, float v, float) const { Y[(size_t)m * D + n] = (bf16)f2bf(v); } };

__global__ __launch_bounds__(256) void attn(const bf16* __restrict__ P, const float* __restrict__ sinks, bf16* __restrict__ AP) {
    __shared__ float Ps[16][129];
    const int tid = threadIdx.x, r = tid >> 4, part = tid & 15, h = blockIdx.y, b = blockIdx.z, kvh = h >> 2;
    const int t = blockIdx.x * 16 + r; const size_t rowq = (size_t)b * SEQ + t;
    uint4 q4[8];
#pragma unroll
    for (int c = 0; c < 8; ++c) q4[c] = *(const uint4*)(P + rowq * NPROJ + C_Q + h * 64 + c * 8);
    float s[8]; float mx = sinks[h] * LOG2E;
#pragma unroll
    for (int jj = 0; jj < 8; ++jj) { const int w = part + 16 * jj, kp = t - w; float dot = -1e30f;
        if (kp >= 0) { const bf16* kr = P + ((size_t)b * SEQ + kp) * NPROJ + C_K + kvh * 64; dot = 0.f;
#pragma unroll
            for (int c = 0; c < 8; ++c) { const uint4 k4 = *(const uint4*)(kr + c * 8);
                dot += bflo(q4[c].x) * bflo(k4.x) + bfhi(q4[c].x) * bfhi(k4.x) + bflo(q4[c].y) * bflo(k4.y) + bfhi(q4[c].y) * bfhi(k4.y)
                     + bflo(q4[c].z) * bflo(k4.z) + bfhi(q4[c].z) * bfhi(k4.z) + bflo(q4[c].w) * bflo(k4.w) + bfhi(q4[c].w) * bfhi(k4.w); } }
        s[jj] = dot; mx = fmaxf(mx, dot); }
    mx = fmaxf(mx, __shfl_xor(mx, 1)); mx = fmaxf(mx, __shfl_xor(mx, 2)); mx = fmaxf(mx, __shfl_xor(mx, 4)); mx = fmaxf(mx, __shfl_xor(mx, 8));
    float sum = 0.f;
#pragma unroll
    for (int jj = 0; jj < 8; ++jj) { const float p = exp2f(s[jj] - mx); sum += p; Ps[r][part + 16 * jj] = p; }
    sum += __shfl_xor(sum, 1); sum += __shfl_xor(sum, 2); sum += __shfl_xor(sum, 4); sum += __shfl_xor(sum, 8);
    sum += exp2f(sinks[h] * LOG2E - mx);
    __syncthreads();
    float o[4] = {0.f, 0.f, 0.f, 0.f};
    const int wmax = t < 127 ? t : 127;
    for (int w = 0; w <= wmax; ++w) { const float p = Ps[r][w]; const uint2 v2 = *(const uint2*)(P + ((size_t)b * SEQ + (t - w)) * NPROJ + C_V + kvh * 64 + part * 4);
        o[0] += p * bflo(v2.x); o[1] += p * bfhi(v2.x); o[2] += p * bflo(v2.y); o[3] += p * bfhi(v2.y); }
    const float inv = 1.0f / sum; uint2 w2; w2.x = f2bf(o[0] * inv) | (f2bf(o[1] * inv) << 16); w2.y = f2bf(o[2] * inv) | (f2bf(o[3] * inv) << 16);
    *(uint2*)(AP + rowq * D + 1024 + h * 64 + part * 4) = w2;
}
__global__ __launch_bounds__(256) void pooled(const bf16* __restrict__ P, bf16* __restrict__ PO) {
    const size_t idx = (size_t)blockIdx.x * 256 + threadIdx.x; const int row = (int)(idx >> 10), ch = (int)(idx & 1023), t = row % SEQ, g = ch >> 8, w = 2 << g;
    const int cnt = (t + 1) < w ? (t + 1) : w; float s = 0.f;
    for (int i = 0; i < cnt; ++i) s += bf2f(P[(size_t)(row - i) * NPROJ + C_U + ch]);
    PO[(size_t)row * 1024 + ch] = (bf16)f2bf(s / (float)cnt - bf2f(P[(size_t)row * NPROJ + C_U + ch]));
}
__global__ __launch_bounds__(256) void ssq(const float* __restrict__ X1, float* __restrict__ SSQ) {
    const int lane = threadIdx.x & 63, row = blockIdx.x * 4 + (threadIdx.x >> 6);
    const float* xr = X1 + (size_t)row * D;
    for (int p = 0; p < 32; ++p) { const float v = xr[64 * p + lane]; const float s = wave_sum(v * v); if (lane == 0) SSQ[(size_t)row * 32 + p] = s; }
}
}

__device__ __forceinline__ int route_row(const float* __restrict__ X1, const float* __restrict__ SSQ, const float* __restrict__ g2, const float* __restrict__ ada,
                                         const float* __restrict__ wrg, const float* __restrict__ brg, const float* __restrict__ wre, const float* __restrict__ bre,
                                         bf16* __restrict__ H2, int row, int lane, float& w1, float& w2) {
    const int b = row / SEQ;
    const float part = lane < 32 ? SSQ[(size_t)row * 32 + lane] : 0.f;
    const float rstd = rsqrtf(wave_sum(part) * (1.0f / D) + EPS);
    const float* sh = ada + (size_t)b * NADA + 3 * D; const float* sc = ada + (size_t)b * NADA + 4 * D;
    float acc[20];
#pragma unroll
    for (int o = 0; o < 20; ++o) acc[o] = 0.f;
#pragma unroll
    for (int j = 0; j < 8; ++j) { const int d = 4 * lane + 256 * j;
        const float4 xv = *(const float4*)(X1 + (size_t)row * D + d), g = *(const float4*)(g2 + d), s = *(const float4*)(sc + d), h = *(const float4*)(sh + d);
        const float hv[4] = {xv.x * rstd * g.x * (1.f + s.x) + h.x, xv.y * rstd * g.y * (1.f + s.y) + h.y, xv.z * rstd * g.z * (1.f + s.z) + h.z, xv.w * rstd * g.w * (1.f + s.w) + h.w};
        uint2 w; w.x = f2bf(hv[0]) | (f2bf(hv[1]) << 16); w.y = f2bf(hv[2]) | (f2bf(hv[3]) << 16);
        *(uint2*)(H2 + (size_t)row * D + d) = w;
#pragma unroll
        for (int e = 0; e < 4; ++e) { const float4 wg = *(const float4*)(wrg + (size_t)(d + e) * 4);
            acc[0] += hv[e] * wg.x; acc[1] += hv[e] * wg.y; acc[2] += hv[e] * wg.z; acc[3] += hv[e] * wg.w;
#pragma unroll
            for (int q = 0; q < 4; ++q) { const float4 we = *(const float4*)(wre + (size_t)(d + e) * 16 + q * 4);
                acc[4 + 4 * q] += hv[e] * we.x; acc[5 + 4 * q] += hv[e] * we.y; acc[6 + 4 * q] += hv[e] * we.z; acc[7 + 4 * q] += hv[e] * we.w; } } }
#pragma unroll
    for (int o = 0; o < 20; ++o) acc[o] = wave_sum(acc[o]);
    float gl[4]; int gi = 0;
#pragma unroll
    for (int o = 0; o < 4; ++o) gl[o] = acc[o] + brg[o];
#pragma unroll
    for (int o = 1; o < 4; ++o) if (gl[o] > gl[gi]) gi = o;
    float gsum = 0.f;
#pragma unroll
    for (int o = 0; o < 4; ++o) gsum += __expf(gl[o] - gl[gi]);
    const float gp = 1.0f / gsum;
    float el[4];
#pragma unroll
    for (int o = 0; o < 4; ++o) { float v = 0.f;
#pragma unroll
        for (int g = 0; g < 4; ++g) v = (g == gi) ? acc[4 + 4 * g + o] + bre[4 * g + o] : v;
        el[o] = v; }
    int i1 = 0;
#pragma unroll
    for (int o = 1; o < 4; ++o) if (el[o] > el[i1]) i1 = o;
    int i2 = (i1 == 0) ? 1 : 0;
#pragma unroll
    for (int o = 0; o < 4; ++o) if (o != i1 && el[o] > el[i2]) i2 = o;
    const float r = __expf(el[i2] - el[i1]);
    w1 = gp / (1.0f + r); w2 = gp * r / (1.0f + r);
    return (gi * 4 + i1) | ((gi * 4 + i2) << 8);
}
__device__ __forceinline__ int route_rows4(const float* __restrict__ X1, const float* __restrict__ SSQ, const float* __restrict__ g2, const float* __restrict__ ada,
                                           const float* __restrict__ wrg, const float* __restrict__ brg, const float* __restrict__ wre, const float* __restrict__ bre,
                                           bf16* __restrict__ H2, int row0, int lane, float& w1, float& w2) {
    typedef float f4 __attribute__((ext_vector_type(4)));
    const int b = row0 / SEQ;
    float rstd[4];
#pragma unroll
    for (int r = 0; r < 4; ++r) { const float part = lane < 32 ? SSQ[(size_t)(row0 + r) * 32 + lane] : 0.f; rstd[r] = rsqrtf(wave_sum(part) * (1.0f / D) + EPS); }
    const float* sh = ada + (size_t)b * NADA + 3 * D; const float* sc = ada + (size_t)b * NADA + 4 * D;
    float acc[4][20];
#pragma unroll
    for (int r = 0; r < 4; ++r)
#pragma unroll
        for (int o = 0; o < 20; ++o) acc[r][o] = 0.f;
#pragma unroll 1
    for (int j = 0; j < 8; ++j) { const int d = 4 * lane + 256 * j;
        const f4 g = *(const f4*)(g2 + d), s = *(const f4*)(sc + d), h = *(const f4*)(sh + d); const f4 gs = g * (1.f + s);
        f4 hv[4];
#pragma unroll
        for (int r = 0; r < 4; ++r) { const f4 xv = *(const f4*)(X1 + (size_t)(row0 + r) * D + d); hv[r] = xv * rstd[r] * gs + h;
            uint2 w; w.x = f2bf(hv[r].x) | (f2bf(hv[r].y) << 16); w.y = f2bf(hv[r].z) | (f2bf(hv[r].w) << 16); *(uint2*)(H2 + (size_t)(row0 + r) * D + d) = w; }
#pragma unroll
        for (int e = 0; e < 4; ++e) { const f4 wg = *(const f4*)(wrg + (size_t)(d + e) * 4);
            f4 we[4];
#pragma unroll
            for (int q = 0; q < 4; ++q) we[q] = *(const f4*)(wre + (size_t)(d + e) * 16 + q * 4);
#pragma unroll
            for (int r = 0; r < 4; ++r) { const float hx = hv[r][e];
                acc[r][0] += hx * wg.x; acc[r][1] += hx * wg.y; acc[r][2] += hx * wg.z; acc[r][3] += hx * wg.w;
#pragma unroll
                for (int q = 0; q < 4; ++q) { acc[r][4 + 4 * q] += hx * we[q].x; acc[r][5 + 4 * q] += hx * we[q].y; acc[r][6 + 4 * q] += hx * we[q].z; acc[r][7 + 4 * q] += hx * we[q].w; } } } }
    float t2[2][20], t1[20];
    { const bool up = (lane & 32) != 0;
#pragma unroll
        for (int r = 0; r < 2; ++r)
#pragma unroll
            for (int o = 0; o < 20; ++o) { const float keep = up ? acc[r + 2][o] : acc[r][o], send = up ? acc[r][o] : acc[r + 2][o]; t2[r][o] = keep + __shfl_xor(send, 32); } }
    { const bool up = (lane & 16) != 0;
#pragma unroll
        for (int o = 0; o < 20; ++o) { const float keep = up ? t2[1][o] : t2[0][o], send = up ? t2[0][o] : t2[1][o]; t1[o] = keep + __shfl_xor(send, 16); } }
#pragma unroll
    for (int o = 0; o < 20; ++o) { float v = t1[o]; v += __shfl_xor(v, 8); v += __shfl_xor(v, 4); v += __shfl_xor(v, 2); v += __shfl_xor(v, 1); t1[o] = v; }
    float gl[4]; int gi = 0;
#pragma unroll
    for (int o = 0; o < 4; ++o) gl[o] = t1[o] + brg[o];
#pragma unroll
    for (int o = 1; o < 4; ++o) if (gl[o] > gl[gi]) gi = o;
    float gsum = 0.f;
#pragma unroll
    for (int o = 0; o < 4; ++o) gsum += __expf(gl[o] - gl[gi]);
    const float gp = 1.0f / gsum;
    float el[4];
#pragma unroll
    for (int o = 0; o < 4; ++o) { float v = 0.f;
#pragma unroll
        for (int g = 0; g < 4; ++g) v = (g == gi) ? t1[4 + 4 * g + o] + bre[4 * g + o] : v;
        el[o] = v; }
    int i1 = 0;
#pragma unroll
    for (int o = 1; o < 4; ++o) if (el[o] > el[i1]) i1 = o;
    int i2 = (i1 == 0) ? 1 : 0;
#pragma unroll
    for (int o = 0; o < 4; ++o) if (o != i1 && el[o] > el[i2]) i2 = o;
    const float rr = __expf(el[i2] - el[i1]);
    w1 = gp / (1.0f + rr); w2 = gp * rr / (1.0f + rr);
    return (gi * 4 + i1) | ((gi * 4 + i2) << 8);
}
__device__ __forceinline__ void hist_wave(int e1, int e2, int lane, int blk, int* __restrict__ blkcnt, int& r1, int& r2) {
    const unsigned long long lt = (1ull << lane) - 1ull; r1 = 0; r2 = 0;
    for (int e = 0; e < NEXP; ++e) { const unsigned long long m1 = __ballot(e1 == e), m2 = __ballot(e2 == e);
        if (e1 == e) r1 = __popcll(m1 & lt); if (e2 == e) r2 = __popcll(m1) + __popcll(m2 & lt);
        if (lane == 0) blkcnt[blk * 16 + e] = __popcll(m1) + __popcll(m2); }
}
__device__ __forceinline__ void final_row(float* X1, const bf16* __restrict__ Y, const int* __restrict__ tokslot, const float* __restrict__ ada, const float* __restrict__ fg, int row, int lane, float* OUT = nullptr) {
    if (!OUT) OUT = X1;
    const int b = row / SEQ;
    const int s1 = tokslot[row * 2], s2 = tokslot[row * 2 + 1]; const float* g2 = ada + (size_t)b * NADA + 5 * D;
    float4 v[8]; float ss = 0.f;
#pragma unroll
    for (int j = 0; j < 8; ++j) { const int d = 4 * lane + 256 * j; const float4 xv = *(const float4*)(X1 + (size_t)row * D + d), g = *(const float4*)(g2 + d);
        const uint2 a = *(const uint2*)(Y + (size_t)s1 * D + d), c = *(const uint2*)(Y + (size_t)s2 * D + d);
        v[j].x = xv.x + g.x * (bflo(a.x) + bflo(c.x)); v[j].y = xv.y + g.y * (bfhi(a.x) + bfhi(c.x));
        v[j].z = xv.z + g.z * (bflo(a.y) + bflo(c.y)); v[j].w = xv.w + g.w * (bfhi(a.y) + bfhi(c.y));
        ss += v[j].x * v[j].x + v[j].y * v[j].y + v[j].z * v[j].z + v[j].w * v[j].w; }
    const float rstd = rsqrtf(wave_sum(ss) * (1.0f / D) + EPS);
#pragma unroll
    for (int j = 0; j < 8; ++j) { const int d = 4 * lane + 256 * j; const float4 g = *(const float4*)(fg + d);
        *(float4*)(OUT + (size_t)row * D + d) = make_float4(v[j].x * rstd * g.x, v[j].y * rstd * g.y, v[j].z * rstd * g.z, v[j].w * rstd * g.w); }
}
typedef unsigned fr_v2u __attribute__((ext_vector_type(2))); typedef float fr_f4 __attribute__((ext_vector_type(4)));
__device__ __forceinline__ void final_row_pos(const bf16* __restrict__ X1, float* __restrict__ OUT, const bf16* __restrict__ Y, const int* __restrict__ tokpos, const __attribute__((address_space(3))) int* offL, const float* __restrict__ ada, const float* __restrict__ fg, int row, int lane) {
    const int b = row / SEQ;
    const int p1 = tokpos[row * 2], p2 = tokpos[row * 2 + 1]; const int s1 = offL[p1 >> 14] + (p1 & 16383), s2 = offL[p2 >> 14] + (p2 & 16383); const float* g2 = ada + (size_t)b * NADA + 5 * D;
    float4 v[8]; float ss = 0.f;
#pragma unroll
    for (int j = 0; j < 8; ++j) { const int d = 4 * lane + 256 * j; const fr_v2u xb = __builtin_nontemporal_load((const fr_v2u*)(X1 + (size_t)row * D + d)); const float4 g = *(const float4*)(g2 + d);
        const fr_v2u a = __builtin_nontemporal_load((const fr_v2u*)(Y + (size_t)s1 * D + d)), c = __builtin_nontemporal_load((const fr_v2u*)(Y + (size_t)s2 * D + d));
        v[j].x = bflo(xb.x) + g.x * (bflo(a.x) + bflo(c.x)); v[j].y = bfhi(xb.x) + g.y * (bfhi(a.x) + bfhi(c.x));
        v[j].z = bflo(xb.y) + g.z * (bflo(a.y) + bflo(c.y)); v[j].w = bfhi(xb.y) + g.w * (bfhi(a.y) + bfhi(c.y));
        ss += v[j].x * v[j].x + v[j].y * v[j].y + v[j].z * v[j].z + v[j].w * v[j].w; }
    const float rstd = rsqrtf(wave_sum(ss) * (1.0f / D) + EPS);
#pragma unroll
    for (int j = 0; j < 8; ++j) { const int d = 4 * lane + 256 * j; const float4 g = *(const float4*)(fg + d);
        const fr_f4 ov = {v[j].x * rstd * g.x, v[j].y * rstd * g.y, v[j].z * rstd * g.z, v[j].w * rstd * g.w}; __builtin_nontemporal_store(ov, (fr_f4*)(OUT + (size_t)row * D + d)); }
}
namespace nv {
__global__ __launch_bounds__(256) void route(const float* X1, const float* SSQ, const float* g2, const float* ada, const float* wrg, const float* brg, const float* wre, const float* bre,
                                             bf16* H2, int* __restrict__ toke, float* __restrict__ tokw) {
    const int lane = threadIdx.x & 63, row = blockIdx.x * 4 + (threadIdx.x >> 6); float w1, w2;
    const int ee = route_row(X1, SSQ, g2, ada, wrg, brg, wre, bre, H2, row, lane, w1, w2);
    if (lane == 0) { toke[row * 2] = ee & 255; toke[row * 2 + 1] = ee >> 8; tokw[row * 2] = w1; tokw[row * 2 + 1] = w2; }
}
__global__ __launch_bounds__(64) void hist(const int* __restrict__ toke, int* __restrict__ blkcnt, int* __restrict__ lrank) {
    const int lane = threadIdx.x, tkn = blockIdx.x * 64 + lane; int r1, r2;
    hist_wave(toke[tkn * 2], toke[tkn * 2 + 1], lane, blockIdx.x, blkcnt, r1, r2);
    lrank[tkn * 2] = r1; lrank[tkn * 2 + 1] = r2;
}
__global__ __launch_bounds__(256) void scan(const int* __restrict__ blkcnt, int* __restrict__ blkbase, int* __restrict__ meta, int* __restrict__ slot_tok, float* __restrict__ slot_w) {
    __shared__ int cnt[16], off[17];
    const int tid = threadIdx.x;
    if (tid < 16) { int base = 0; for (int b = 0; b < 256; ++b) { blkbase[b * 16 + tid] = base; base += blkcnt[b * 16 + tid]; } cnt[tid] = base; }
    __syncthreads();
    if (tid == 0) { int o = 0, nt = 0; for (int e = 0; e < 16; ++e) { off[e] = o; meta[e] = o; const int tl = (cnt[e] + 255) >> 8; for (int i = 0; i < tl; ++i) meta[32 + nt++] = e; o += tl * 256; } off[16] = o; meta[16] = o; meta[17] = o; meta[18] = nt; }
    __syncthreads();
    for (int e = 0; e < 16; ++e) for (int s = off[e] + cnt[e] + tid; s < off[e + 1]; s += 256) { slot_tok[s] = 0; slot_w[s] = 0.f; }
}
__global__ __launch_bounds__(256) void fill(const int* __restrict__ toke, const float* __restrict__ tokw, const int* __restrict__ lrank, const int* __restrict__ blkbase, const int* __restrict__ meta,
                                            int* __restrict__ slot_tok, float* __restrict__ slot_w, int* __restrict__ tokslot) {
    const int i = blockIdx.x * 256 + threadIdx.x;
    const int tkn = i >> 1, e = toke[i], slot = meta[e] + blkbase[(tkn >> 6) * 16 + e] + lrank[i];
    slot_tok[slot] = tkn; slot_w[slot] = tokw[i]; tokslot[i] = slot;
}
__global__ __launch_bounds__(256) void final_(float* X1, const bf16* Y, const int* tokslot, const float* ada, const float* fg) {
    final_row(X1, Y, tokslot, ada, fg, blockIdx.x * 4 + (threadIdx.x >> 6), threadIdx.x & 63);
}
}

namespace pg8 {
#define PG8_LAS __attribute__((address_space(3)))
typedef unsigned short bf16_t;
typedef short bf16x8 __attribute__((ext_vector_type(8)));
typedef float f32x4 __attribute__((ext_vector_type(4)));
typedef unsigned u32x4 __attribute__((ext_vector_type(4)));
constexpr int BM = 256, BK = 64, HALF = 128, HTB = HALF * BK * 2, STAGE_BYTES = 8 * HTB, NXCD = 8, WGM = 8;
__host__ __device__ __forceinline__ int lds_byte(int r, int c) { const int st = (r >> 4) * 2 + (c >> 5), rr = r & 15, cc = c & 31, ob = rr * 64 + cc * 2; return st * 1024 + (ob ^ (((ob >> 9) & 1) << 5)); }
__host__ __device__ __forceinline__ void stage_rc(int b, int& R, int& C) { const int st = b / 1024, sb = b % 1024, swz = sb ^ (((sb >> 9) & 1) << 5); R = (st >> 1) * 16 + swz / 64; C = (st & 1) * 32 + (swz % 64) / 2; }
__host__ __device__ __forceinline__ int perm32(int rho) { const int n = rho >> 4, i = rho & 15; return 8 * (i >> 2) + 4 * n + (i & 3); }

struct Unit { int pm, pn, be; };
struct Gemm { const bf16_t* A; const bf16_t* Bt; int lda, ldb, K; size_t bstride; const int* rowidx; const PG8_LAS int* lm; };

struct StaticOrder {
    int nM, nN, nwg, G, c;
    __device__ void init(int M, int N, int G_, int c_) { nM = M / BM; nN = N / BM; nwg = nM * nN; G = G_; c = c_; }
    __device__ bool next(int i, Unit& u) const {
        const long L = (long)i * G + c; if (L >= nwg) return false;
        int wgid = (int)L; { const int q = nwg / NXCD, r = nwg % NXCD, xcd = wgid % NXCD, off = wgid / NXCD; wgid = (xcd < r ? xcd * (q + 1) : r * (q + 1) + (xcd - r) * q) + off; }
        const int nig = WGM * nN, gid = wgid / nig, fm = gid * WGM, gsz = (nM - fm) < WGM ? (nM - fm) : WGM;
        u.pm = fm + ((wgid % nig) % gsz); u.pn = (wgid % nig) / gsz; u.be = 0; return true;
    }
};
struct OneUnit { Unit u0; __device__ bool next(int i, Unit& u) const { if (i) return false; u = u0; return true; } };
struct DynOrder { int nunits, nN, G, c; const PG8_LAS int* tile_e; int skip_lo = 0, skip_n = 0;
    __device__ bool next(int i, Unit& u) const { int L = i * G + c; if (L >= nunits) return false; if (L >= skip_lo) L += skip_n; u.pm = L / nN; u.pn = L % nN; u.be = tile_e[u.pm]; return true; } };

__device__ __forceinline__ unsigned cvt_pk_bf16(float lo, float hi) { unsigned r; asm volatile("v_cvt_pk_bf16_f32 %0, %1, %2" : "=v"(r) : "v"(lo), "v"(hi)); return r; }
__device__ __forceinline__ u32x4 pack8(f32x4 v0, f32x4 v1) { u32x4 w; w.x = cvt_pk_bf16(v0[0], v0[1]); w.y = cvt_pk_bf16(v0[2], v0[3]); w.z = cvt_pk_bf16(v1[0], v1[1]); w.w = cvt_pk_bf16(v1[2], v1[3]); return w; }

__device__ __forceinline__ unsigned gate_pack4(f32x4 v) {
    unsigned r = 0;
#pragma unroll
    for (int i = 0; i < 4; ++i) { const unsigned q = (unsigned)__builtin_fmaf(sigmoid_fast(v[i]), 255.0f, 0.5f); r |= q << (8 * i); }
    return r;
}
__device__ __forceinline__ void gate_unpack8(unsigned lo, unsigned hi, f32x4& a, f32x4& b) {
    const float k = 1.0f / 255.0f;
    a[0] = (float)(lo & 255u) * k; a[1] = (float)((lo >> 8) & 255u) * k; a[2] = (float)((lo >> 16) & 255u) * k; a[3] = (float)(lo >> 24) * k;
    b[0] = (float)(hi & 255u) * k; b[1] = (float)((hi >> 8) & 255u) * k; b[2] = (float)((hi >> 16) & 255u) * k; b[3] = (float)(hi >> 24) * k;
}
__device__ __forceinline__ size_t acc_slot(int tile, int wid, int ai, int m, int bj, int lane) { return ((size_t)(tile * 8 + wid) * 16 + ((ai * 4 + m) * 2 + bj)) * 64 + lane; }
struct EpProj { static constexpr bool PERM = true; bf16_t* O; unsigned char* G8;
    __device__ __forceinline__ void operator()(const f32x4 (&acc)[2][2][4][2], const Unit& u, int wr, int wc, int fr, int fq) const {
        const int row0 = u.pm * BM + wr * 64 + fr, col0 = u.pn * BM + wc * 32 + 8 * fq; const int mode = u.pn < 4 ? 0 : (u.pn < 10 ? 1 : 2);
        typedef unsigned u32x2 __attribute__((ext_vector_type(2))); const int lane = fq * 16 + fr, wid = wr * 4 + wc;
        if (mode == 2) {
            const int gt = u.pm * 16 + (u.pn - 10);
#pragma unroll
            for (int ai = 0; ai < 2; ++ai)
#pragma unroll
                for (int m = 0; m < 4; ++m)
#pragma unroll
                    for (int bj = 0; bj < 2; ++bj) { u32x2 w; w.x = gate_pack4(acc[ai][bj][m][0]); w.y = gate_pack4(acc[ai][bj][m][1]);
                        __builtin_nontemporal_store(w, (u32x2*)(G8 + acc_slot(gt, wid, ai, m, bj, lane) * 8)); }
        } else {
            const float sc = mode == 0 ? C2 : 1.0f;
#pragma unroll
            for (int ai = 0; ai < 2; ++ai)
#pragma unroll
                for (int m = 0; m < 4; ++m) { bf16_t* rowb = O + (size_t)(row0 + ai * HALF + m * 16) * NPROJ;
#pragma unroll
                    for (int bj = 0; bj < 2; ++bj) *(u32x4*)(rowb + col0 + bj * HALF) = pack8(acc[ai][bj][m][0] * sc, acc[ai][bj][m][1] * sc); }
        }
    } };
struct EpFold { static constexpr bool PERM = true; bf16_t* O;
    __device__ __forceinline__ void operator()(const f32x4 (&acc)[2][2][4][2], const Unit& u, int wr, int wc, int fr, int fq) const {
        const int row0 = u.pm * BM + wr * 64 + fr, col0 = u.be * 256 + wc * 32 + 8 * fq;
#pragma unroll
        for (int ai = 0; ai < 2; ++ai)
#pragma unroll
            for (int m = 0; m < 4; ++m) { bf16_t* rowp = O + (size_t)(row0 + ai * HALF + m * 16) * 2048 + col0;
#pragma unroll
                for (int bj = 0; bj < 2; ++bj) *(u32x4*)(rowp + bj * HALF) = pack8(acc[ai][bj][m][0], acc[ai][bj][m][1]); }
    } };
__device__ __forceinline__ void unpack8(u32x4 w, f32x4& a, f32x4& b) { a[0] = bflo(w.x); a[1] = bfhi(w.x); a[2] = bflo(w.y); a[3] = bfhi(w.y); b[0] = bflo(w.z); b[1] = bfhi(w.z); b[2] = bflo(w.w); b[3] = bfhi(w.w); }
struct EpT1 { static constexpr bool PERM = true; bf16_t* T1p; const unsigned char* G8;
    __device__ __forceinline__ void operator()(const f32x4 (&acc)[2][2][4][2], const Unit& u, int wr, int wc, int fr, int fq) const {
        typedef unsigned u32x2 __attribute__((ext_vector_type(2))); const int lane = fq * 16 + fr, wid = wr * 4 + wc;
        u32x2 gw[2][4][2];
#pragma unroll
        for (int ai = 0; ai < 2; ++ai)
#pragma unroll
            for (int m = 0; m < 4; ++m)
#pragma unroll
                for (int bj = 0; bj < 2; ++bj) gw[ai][m][bj] = *(const u32x2*)(G8 + acc_slot(u.pm * 16 + 8 + u.pn, wid, ai, m, bj, lane) * 8);
#pragma unroll
        for (int ai = 0; ai < 2; ++ai)
#pragma unroll
            for (int m = 0; m < 4; ++m)
#pragma unroll
                for (int bj = 0; bj < 2; ++bj) { f32x4 g0, g1; gate_unpack8(gw[ai][m][bj].x, gw[ai][m][bj].y, g0, g1);
                    *(u32x4*)(T1p + acc_slot(u.pm * 8 + u.pn, wid, ai, m, bj, lane) * 8) = pack8(acc[ai][bj][m][0] * g0, acc[ai][bj][m][1] * g1); }
    } };
struct EpMerged { static constexpr bool PERM = true; bf16_t* M; const bf16_t* T1p; const unsigned char* G8;
    __device__ __forceinline__ void operator()(const f32x4 (&acc)[2][2][4][2], const Unit& u, int wr, int wc, int fr, int fq) const {
        const int row0 = u.pm * BM + wr * 64 + fr, col0 = u.pn * BM + wc * 32 + 8 * fq;
        typedef unsigned u32x2 __attribute__((ext_vector_type(2))); const int lane = fq * 16 + fr, wid = wr * 4 + wc;
#pragma unroll
        for (int ai = 0; ai < 2; ++ai) {
            u32x2 gw[4][2]; u32x4 tw[4][2];
#pragma unroll
            for (int m = 0; m < 4; ++m)
#pragma unroll
                for (int bj = 0; bj < 2; ++bj) { gw[m][bj] = *(const u32x2*)(G8 + acc_slot(u.pm * 16 + u.pn, wid, ai, m, bj, lane) * 8); tw[m][bj] = *(const u32x4*)(T1p + acc_slot(u.pm * 8 + u.pn, wid, ai, m, bj, lane) * 8); }
#pragma unroll
            for (int m = 0; m < 4; ++m)
#pragma unroll
                for (int bj = 0; bj < 2; ++bj) { const size_t r = (size_t)(row0 + ai * HALF + m * 16); f32x4 g0, g1, t0, t1; gate_unpack8(gw[m][bj].x, gw[m][bj].y, g0, g1); unpack8(tw[m][bj], t0, t1);
                    *(u32x4*)(M + r * D + col0 + bj * HALF) = pack8(acc[ai][bj][m][0] * g0 + t0, acc[ai][bj][m][1] * g1 + t1); }
            asm volatile("" ::: "memory"); }
    } };
struct EpMergedR { static constexpr bool PERM = true; bf16_t* M; const unsigned char* G8;
    __device__ __forceinline__ void mid(f32x4 (&acc)[2][2][4][2], const Unit& u, int wr, int wc, int fr, int fq) const {
        typedef unsigned u32x2 __attribute__((ext_vector_type(2))); const int lane = fq * 16 + fr, wid = wr * 4 + wc;
        int gt = u.pm * 16 + u.pn; asm volatile("" : "+s"(gt));
#pragma unroll
        for (int ai = 0; ai < 2; ++ai) {
            u32x2 ga[4][2], gp[4][2];
#pragma unroll
            for (int m = 0; m < 4; ++m)
#pragma unroll
                for (int bj = 0; bj < 2; ++bj) { ga[m][bj] = *(const u32x2*)(G8 + acc_slot(gt, wid, ai, m, bj, lane) * 8); gp[m][bj] = __builtin_nontemporal_load((const u32x2*)(G8 + acc_slot(gt + 8, wid, ai, m, bj, lane) * 8)); }
#pragma unroll
            for (int m = 0; m < 4; ++m)
#pragma unroll
                for (int bj = 0; bj < 2; ++bj) {
#pragma unroll
                    for (int n = 0; n < 2; ++n) { const unsigned wa = n ? ga[m][bj].y : ga[m][bj].x, wp = n ? gp[m][bj].y : gp[m][bj].x;
#pragma unroll
                        for (int i = 0; i < 4; ++i) { const float qa = fmaxf((float)((wa >> (8 * i)) & 255u), 0.5f), qp = (float)((wp >> (8 * i)) & 255u); acc[ai][bj][m][n][i] *= qp * __builtin_amdgcn_rcpf(qa); } } }
            asm volatile("" ::: "memory"); }
    }
    __device__ __forceinline__ void operator()(const f32x4 (&acc)[2][2][4][2], const Unit& u, int wr, int wc, int fr, int fq) const {
        const int row0 = u.pm * BM + wr * 64 + fr, col0 = u.pn * BM + wc * 32 + 8 * fq;
        typedef unsigned u32x2 __attribute__((ext_vector_type(2))); const int lane = fq * 16 + fr, wid = wr * 4 + wc;
        u32x2 ga[2][4][2];
#pragma unroll
        for (int ai = 0; ai < 2; ++ai)
#pragma unroll
            for (int m = 0; m < 4; ++m)
#pragma unroll
                for (int bj = 0; bj < 2; ++bj) ga[ai][m][bj] = __builtin_nontemporal_load((const u32x2*)(G8 + acc_slot(u.pm * 16 + u.pn, wid, ai, m, bj, lane) * 8));
#pragma unroll
        for (int ai = 0; ai < 2; ++ai)
#pragma unroll
            for (int m = 0; m < 4; ++m)
#pragma unroll
                for (int bj = 0; bj < 2; ++bj) { const size_t r = (size_t)(row0 + ai * HALF + m * 16); f32x4 g[2];
#pragma unroll
                    for (int n = 0; n < 2; ++n) { const unsigned wa = n ? ga[ai][m][bj].y : ga[ai][m][bj].x;
#pragma unroll
                        for (int i = 0; i < 4; ++i) g[n][i] = fmaxf((float)((wa >> (8 * i)) & 255u), 0.5f) * (1.0f / 255.0f); }
                    *(u32x4*)(M + r * D + col0 + bj * HALF) = pack8(acc[ai][bj][m][0] * g[0], acc[ai][bj][m][1] * g[1]); }
    } };
struct EpX1 { static constexpr bool PERM = true; const float* x; bf16_t* X1; const float* ada; float* SSQ;
    __device__ __forceinline__ void operator()(const f32x4 (&acc)[2][2][4][2], const Unit& u, int wr, int wc, int fr, int fq) const {
        const int row0 = u.pm * BM + wr * 64 + fr, col0 = u.pn * BM + wc * 32 + 8 * fq; const float* g1 = ada + (size_t)(u.pm >> 5) * NADA + 2 * D;
        f32x4 gv[2][2];
#pragma unroll
        for (int bj = 0; bj < 2; ++bj)
#pragma unroll
            for (int n = 0; n < 2; ++n) gv[bj][n] = *(const f32x4*)(g1 + col0 + bj * HALF + 4 * n);
#pragma unroll
        for (int am = 0; am < 4; ++am) { const int ai = am >> 1, m0 = (am & 1) * 2;
            f32x4 xv[2][2][2];
#pragma unroll
            for (int mm = 0; mm < 2; ++mm)
#pragma unroll
                for (int bj = 0; bj < 2; ++bj)
#pragma unroll
                    for (int n = 0; n < 2; ++n) xv[mm][bj][n] = __builtin_nontemporal_load((const f32x4*)(x + (size_t)(row0 + ai * HALF + (m0 + mm) * 16) * D + col0 + bj * HALF + 4 * n));
#pragma unroll
            for (int mm = 0; mm < 2; ++mm) { const int m = m0 + mm; const size_t r = (size_t)(row0 + ai * HALF + m * 16); float s = 0.f;
#pragma unroll
                for (int bj = 0; bj < 2; ++bj) { const f32x4 v0 = xv[mm][bj][0] + gv[bj][0] * acc[ai][bj][m][0], v1 = xv[mm][bj][1] + gv[bj][1] * acc[ai][bj][m][1];
                    *(u32x4*)(X1 + r * D + col0 + bj * HALF) = pack8(v0, v1);
                    s += ((v0[0] * v0[0] + v0[1] * v0[1]) + (v0[2] * v0[2] + v0[3] * v0[3])) + ((v1[0] * v1[0] + v1[1] * v1[1]) + (v1[2] * v1[2] + v1[3] * v1[3])); }
                s += __shfl_xor(s, 16); s += __shfl_xor(s, 32);
                if (fq == 0) SSQ[r * 32 + u.pn * 4 + wc] = s; }
            asm volatile("" ::: "memory"); }
    } };
struct EpAct { static constexpr bool PERM = true; bf16_t* ACT; const float* lw; const PG8_LAS int* lm;
    __device__ __forceinline__ void operator()(const f32x4 (&acc)[2][2][4][2], const Unit& u, int wr, int wc, int fr, int fq) const {
        const int li0 = wr * 64 + fr, row0 = u.pm * BM + li0, col0 = u.pn * HALF + wc * 32 + 8 * fq;
        const int lt = u.pm - lm[208 + u.be], rb = u.be * 16384 + lt * BM, rc = lm[192 + u.be] - lt * BM;
        float wv[2][4];
#pragma unroll
        for (int ai = 0; ai < 2; ++ai)
#pragma unroll
            for (int m = 0; m < 4; ++m) { const int li = li0 + ai * HALF + m * 16; wv[ai][m] = li < rc ? lw[rb + li] : 0.f; }
#pragma unroll
        for (int ai = 0; ai < 2; ++ai)
#pragma unroll
            for (int m = 0; m < 4; ++m) { const size_t r = (size_t)(row0 + ai * HALF + m * 16); const float w = wv[ai][m]; f32x4 o[2];
#pragma unroll
                for (int n = 0; n < 2; ++n)
#pragma unroll
                    for (int i = 0; i < 4; ++i) { const float g = acc[ai][0][m][n][i], uu = acc[ai][1][m][n][i]; o[n][i] = g * sigmoid_fast(g) * uu * w; }
                *(u32x4*)(ACT + r * FF + col0) = pack8(o[0], o[1]); }
    } };
struct EpY { static constexpr bool PERM = true; bf16_t* Y;
    __device__ __forceinline__ void operator()(const f32x4 (&acc)[2][2][4][2], const Unit& u, int wr, int wc, int fr, int fq) const {
        const int row0 = u.pm * BM + wr * 64 + fr, col0 = u.pn * BM + wc * 32 + 8 * fq;
#pragma unroll
        for (int ai = 0; ai < 2; ++ai)
#pragma unroll
            for (int m = 0; m < 4; ++m) { bf16_t* rowp = Y + (size_t)(row0 + ai * HALF + m * 16) * D + col0;
#pragma unroll
                for (int bj = 0; bj < 2; ++bj) *(u32x4*)(rowp + bj * HALF) = pack8(acc[ai][bj][m][0], acc[ai][bj][m][1]); }
    } };

template <class Epi, class Sched, bool GATHER, bool MID = false>
__device__ __forceinline__ void gemm_phase(PG8_LAS unsigned char* lds, const Gemm g, const Sched& S, const Epi& E, int stagger = 0) {
    if (stagger > 0) { const unsigned long long t0 = __builtin_amdgcn_s_memrealtime(); const unsigned long long dl = (unsigned long long)stagger * (unsigned)blockIdx.x / gridDim.x;
        while (__builtin_amdgcn_s_memrealtime() - t0 < dl) __builtin_amdgcn_s_sleep(8); }
    const int tid = threadIdx.x, wid = __builtin_amdgcn_readfirstlane(tid >> 6), lane = tid & 63, wr = wid >> 2, wc = wid & 3, fr = lane & 15, fq = lane >> 4;
    int K = g.K; asm volatile("" : "+s"(K));
    const int nt = K / BK;
    int sR[2], sC[2]; unsigned voB[2], voA[2][2], voN[2][2];
#pragma unroll
    for (int i = 0; i < 2; ++i) { int R, C; stage_rc(tid * 16 + i * 8192, R, C); sR[i] = R; sC[i] = C; const int Rb = Epi::PERM ? ((R & ~31) + perm32(R & 31)) : R;
        voB[i] = (unsigned)(Rb * g.ldb + C) * 2u;
#pragma unroll
        for (int h = 0; h < 2; ++h) { voA[h][i] = (unsigned)((h * HALF + R) * g.lda + C) * 2u; voN[h][i] = voA[h][i]; } }
    const size_t kstep = (size_t)(BK * 2);
    const size_t hstepB = (size_t)HALF * g.ldb * 2, tstepA = (size_t)BM * g.lda * 2, tstepB = (size_t)BM * g.ldb * 2;
    const unsigned ldsw = (unsigned)wid * 1024u;
    const int aoff = lds_byte(wr * 64 + fr, fq * 8), boff = lds_byte(wc * 32 + fr, fq * 8);
#define PG8_SA(b, h) (((b) * 2 + (h)) * HTB)
#define PG8_SB(b, h) ((4 + (b) * 2 + (h)) * HTB)
#define PG8_STAGE(bufoff, gbase, voff) do { _Pragma("unroll") for (int _i = 0; _i < 2; ++_i) \
        __builtin_amdgcn_global_load_lds((const unsigned*)((const char*)(gbase) + (voff)[_i]), (PG8_LAS unsigned*)(lds + (bufoff) + ldsw + _i * 8192), 16, 0, 0); } while (0)
#define PG8_LDA(dst, b, h) do { _Pragma("unroll") for (int m = 0; m < 4; ++m) _Pragma("unroll") for (int k = 0; k < 2; ++k) dst[m][k] = *(const PG8_LAS bf16x8*)(lds + PG8_SA(b, h) + aoff + m * 2048 + k * 1024); } while (0)
#define PG8_LDB(dst, b, h) do { _Pragma("unroll") for (int n = 0; n < 2; ++n) _Pragma("unroll") for (int k = 0; k < 2; ++k) dst[n][k] = *(const PG8_LAS bf16x8*)(lds + PG8_SB(b, h) + boff + n * 2048 + k * 1024); } while (0)
#define PG8_MMA(ai, bj, At, Bt) do { __builtin_amdgcn_s_setprio(1); _Pragma("unroll") for (int m = 0; m < 4; ++m) _Pragma("unroll") for (int n = 0; n < 2; ++n) _Pragma("unroll") for (int k = 0; k < 2; ++k) \
        acc[ai][bj][m][n] = __builtin_amdgcn_mfma_f32_16x16x32_bf16(Bt[n][k], At[m][k], acc[ai][bj][m][n], 0, 0, 0); __builtin_amdgcn_s_setprio(0); } while (0)
#define PG8_WAIT_V(n) asm volatile("s_waitcnt vmcnt(" #n ")" ::: "memory")
#define PG8_WAIT_L(n) asm volatile("s_waitcnt lgkmcnt(" #n ")" ::: "memory")
#define PG8_BAR __builtin_amdgcn_s_barrier()
#define PG8_SCHED __builtin_amdgcn_sched_barrier(0)
#define PG8_GATHER_OFFS(dst, u_) do { const int _e = (u_).be, _lt = (u_).pm - g.lm[208 + _e], _rb = _e * 16384 + _lt * BM, _rc = g.lm[192 + _e] - _lt * BM;     \
        int _ri[2][2];     \
        _Pragma("unroll") for (int _h = 0; _h < 2; ++_h) _Pragma("unroll") for (int _i = 0; _i < 2; ++_i) { const int _ix = _h * HALF + sR[_i]; _ri[_h][_i] = g.rowidx[_rb + (_ix < _rc ? _ix : 0)]; } \
        _Pragma("unroll") for (int _h = 0; _h < 2; ++_h) _Pragma("unroll") for (int _i = 0; _i < 2; ++_i) { const int _ix = _h * HALF + sR[_i]; \
            dst[_h][_i] = (unsigned)((_ix < _rc ? _ri[_h][_i] : 0) * g.lda + sC[_i]) * 2u; } \
        __builtin_amdgcn_s_waitcnt(0x0F70); _Pragma("unroll") for (int _h = 0; _h < 2; ++_h) _Pragma("unroll") for (int _i = 0; _i < 2; ++_i) asm volatile("" : "+v"(dst[_h][_i])); } while (0)
    Unit cur, nxt; int ui = 0;
    if (!S.next(0, cur)) return;
    f32x4 acc[2][2][4][2];
#pragma unroll
    for (int a = 0; a < 2; ++a)
#pragma unroll
        for (int b = 0; b < 2; ++b)
#pragma unroll
            for (int m = 0; m < 4; ++m)
#pragma unroll
                for (int n = 0; n < 2; ++n) acc[a][b][m][n] = (f32x4){0.f, 0.f, 0.f, 0.f};
    bf16x8 At[4][2], B0[2][2], B1[2][2];
    const char* cA = (const char*)g.A + (GATHER ? (size_t)0 : (size_t)cur.pm * tstepA);
    const char* cB = (const char*)g.Bt + ((size_t)cur.be * g.bstride) * 2 + (size_t)cur.pn * tstepB;
    if constexpr (GATHER) PG8_GATHER_OFFS(voA, cur);
    PG8_STAGE(PG8_SB(0, 0), cB, voB); PG8_STAGE(PG8_SB(0, 1), cB + hstepB, voB); PG8_STAGE(PG8_SA(0, 0), cA, voA[0]); PG8_STAGE(PG8_SA(0, 1), cA, voA[1]);
    if (wr == 1) PG8_BAR;
    PG8_WAIT_V(2); PG8_BAR;
    PG8_STAGE(PG8_SB(1, 0), cB + kstep, voB); PG8_STAGE(PG8_SA(1, 0), cA + kstep, voA[0]); PG8_STAGE(PG8_SB(1, 1), cB + hstepB + kstep, voB);
    PG8_WAIT_V(6); PG8_BAR;
    for (;;) {
        const bool has_next = S.next(ui + 1, nxt);
        const char* nA = has_next ? (const char*)g.A + (GATHER ? (size_t)0 : (size_t)nxt.pm * tstepA) : cA;
        const char* nB = has_next ? (const char*)g.Bt + ((size_t)nxt.be * g.bstride) * 2 + (size_t)nxt.pn * tstepB : cB;
        if constexpr (GATHER) { if (has_next) PG8_GATHER_OFFS(voN, nxt); else {
#pragma unroll
            for (int h = 0; h < 2; ++h)
#pragma unroll
                for (int i = 0; i < 2; ++i) voN[h][i] = voA[h][i]; } }
        for (int t = 0; t < nt; t += 2) {
            const bool last = (t == nt - 2);
            if constexpr (MID) { if (t == (nt >> 1)) E.mid(acc, cur, wr, wc, fr, fq); }
            const char* a1 = cA + (size_t)(t + 1) * kstep;
            const char* a2 = last ? nA : cA + (size_t)(t + 2) * kstep; const char* b2 = last ? nB : cB + (size_t)(t + 2) * kstep;
            const char* a3 = a2 + kstep; const char* b3 = b2 + kstep;
            unsigned vo2[2][2];
#pragma unroll
            for (int h = 0; h < 2; ++h)
#pragma unroll
                for (int i = 0; i < 2; ++i) vo2[h][i] = (GATHER && last) ? voN[h][i] : voA[h][i];
            PG8_LDB(B0, 0, 0); PG8_LDB(B1, 0, 1); PG8_SCHED; PG8_LDA(At, 0, 0); PG8_STAGE(PG8_SA(1, 1), a1, voA[1]);
            PG8_WAIT_V(8); PG8_WAIT_L(0); PG8_BAR; PG8_MMA(0, 0, At, B0); PG8_MMA(0, 1, At, B1); PG8_BAR; PG8_SCHED;
            PG8_LDA(At, 0, 1); PG8_STAGE(PG8_SB(0, 0), b2, voB); PG8_STAGE(PG8_SB(0, 1), b2 + hstepB, voB); PG8_STAGE(PG8_SA(0, 0), a2, vo2[0]);
            PG8_WAIT_V(8); PG8_WAIT_L(0); PG8_BAR; PG8_MMA(1, 0, At, B0); PG8_MMA(1, 1, At, B1); PG8_BAR; PG8_SCHED;
            PG8_LDB(B0, 1, 0); PG8_LDB(B1, 1, 1); PG8_SCHED; PG8_LDA(At, 1, 0); PG8_STAGE(PG8_SA(0, 1), a2, vo2[1]);
            PG8_WAIT_V(8); PG8_WAIT_L(0); PG8_BAR; PG8_MMA(0, 0, At, B0); PG8_MMA(0, 1, At, B1); PG8_BAR; PG8_SCHED;
            PG8_LDA(At, 1, 1); PG8_STAGE(PG8_SB(1, 0), b3, voB); PG8_STAGE(PG8_SB(1, 1), b3 + hstepB, voB); PG8_STAGE(PG8_SA(1, 0), a3, vo2[0]);
            PG8_WAIT_V(8); PG8_WAIT_L(0); PG8_BAR; PG8_MMA(1, 0, At, B0); PG8_MMA(1, 1, At, B1); PG8_BAR; PG8_SCHED;
        }
        if (wr == 0) PG8_BAR;
        E(acc, cur, wr, wc, fr, fq);
        if (!has_next) break;
#pragma unroll
        for (int a = 0; a < 2; ++a)
#pragma unroll
            for (int b = 0; b < 2; ++b)
#pragma unroll
                for (int m = 0; m < 4; ++m)
#pragma unroll
                    for (int n = 0; n < 2; ++n) acc[a][b][m][n] = (f32x4){0.f, 0.f, 0.f, 0.f};
        cur = nxt; cA = nA; cB = nB; ++ui;
        if constexpr (GATHER) {
#pragma unroll
            for (int h = 0; h < 2; ++h)
#pragma unroll
                for (int i = 0; i < 2; ++i) voA[h][i] = voN[h][i]; }
        if (wr == 1) PG8_BAR;
    }
    PG8_WAIT_V(0);
    PG8_BAR;
#undef PG8_SA
#undef PG8_SB
#undef PG8_STAGE
#undef PG8_LDA
#undef PG8_LDB
#undef PG8_MMA
#undef PG8_WAIT_V
#undef PG8_WAIT_L
#undef PG8_BAR
#undef PG8_SCHED
#undef PG8_GATHER_OFFS
}
}

#define GAS __attribute__((address_space(1)))
#define LAS __attribute__((address_space(3)))
typedef unsigned v4u __attribute__((ext_vector_type(4)));
typedef unsigned v2u __attribute__((ext_vector_type(2)));
typedef float f32x4 __attribute__((ext_vector_type(4)));
typedef float f32x16 __attribute__((ext_vector_type(16)));
typedef short bf16x8 __attribute__((ext_vector_type(8)));
typedef short s16x4 __attribute__((ext_vector_type(4)));
typedef GAS unsigned gu32;
#define RLX_AGENT __ATOMIC_RELAXED, __HIP_MEMORY_SCOPE_AGENT
#define LDS_WAIT() asm volatile("s_waitcnt lgkmcnt(0)" ::: "memory")
#define VM_WAIT() asm volatile("s_waitcnt vmcnt(0)" ::: "memory")
constexpr int NWAVES = 8;
constexpr int STG_P1 = 0, STG_P3A = 0, STG_P3B = 0, STG_P4 = 0, STG_P7 = 0;
constexpr int RING_OFF = 0, RING_BYTES = 131072;
constexpr int LDSCTL_OFF = 139264;
constexpr int MISC_OFF = LDSCTL_OFF + 64;
constexpr int LMETA_OFF = LDSCTL_OFF + 256;
constexpr int LDS_BYTES = 147456;
constexpr int CW_MOE = 8256;
constexpr int CW_TMO = 0, CW_BAR = 4096, CW_CNT = 8192;

#define XB_TMO      128
#define XB_XCNT(j)  (256  + 64 * (j))
#define XB_XSUB(j)  (1280 + 64 * (j))
#define XB_XGEN(j)  (2304 + 64 * (j))
#define XB_TOP      3328
#define XB_TOPGEN   3392
#define XCD_BAR_WORDS 3456
#define XB_SPIN_CAP (1u << 18)
__device__ __forceinline__ unsigned xb_ld(unsigned* p)              { return __hip_atomic_load(p, __ATOMIC_RELAXED, __HIP_MEMORY_SCOPE_AGENT); }
__device__ __forceinline__ unsigned xb_add(unsigned* p, unsigned v) { return __hip_atomic_fetch_add(p, v, __ATOMIC_RELAXED, __HIP_MEMORY_SCOPE_AGENT); }
__device__ __forceinline__ unsigned xb_xcc_id() { return (unsigned)__builtin_amdgcn_s_getreg((3 << 11) | 20) & 0xFu; }
#define XB_SPIN(cond, bar) do { unsigned _sp = 0; while (cond) { __builtin_amdgcn_s_sleep(1); \
    if ((++_sp & 255u) == 0u) { if (xb_ld(&(bar)[XB_TMO])) break; if (_sp > XB_SPIN_CAP) { atomicAdd(&(bar)[XB_TMO], 1u); break; } } } } while (0)
struct XcdBarrier { unsigned* bar; unsigned x; volatile LAS unsigned* st; };
__device__ __forceinline__ XcdBarrier xcd_barrier_post(unsigned* bar, volatile LAS unsigned* st) {
    XcdBarrier b; b.bar = bar; b.x = xb_xcc_id(); b.st = st;
    if (threadIdx.x == 0) (void)xb_add(&bar[XB_XCNT(b.x)], 1u);
    return b;
}
__device__ __forceinline__ void xcd_barrier_complete(unsigned* bar, unsigned x, unsigned& nloc, unsigned& nx) {
    const unsigned G = gridDim.x * gridDim.y * gridDim.z;
    unsigned sum, cnt, mine, sp = 0u;
    for (;;) {
        sum = 0u; cnt = 0u; mine = 0u;
#pragma unroll
        for (unsigned j = 0; j < 16; ++j) { const unsigned c = xb_ld(&bar[XB_XCNT(j)]); sum += c; cnt += (c > 0u) ? 1u : 0u; mine = (j == x) ? c : mine; }
        if (sum == G) break;
        __builtin_amdgcn_s_sleep(1);
        if ((++sp & 255u) == 0u) { if (xb_ld(&bar[XB_TMO])) break; if (sp > XB_SPIN_CAP) { atomicAdd(&bar[XB_TMO], 1u); break; } }
    }
    nloc = mine > 0u ? mine : 1u; nx = cnt > 0u ? cnt : 1u;
}
__device__ __forceinline__ void xcd_barrier(const XcdBarrier& b) {
    asm volatile("s_waitcnt vmcnt(0)" ::: "memory");
    __syncthreads();
    if (threadIdx.x == 0) {
        unsigned* bar = b.bar;
        __builtin_amdgcn_s_waitcnt(0);
        unsigned nloc = b.st[0], nx = b.st[1];
        if (nloc == 0u) { xcd_barrier_complete(bar, b.x, nloc, nx); b.st[0] = nloc; b.st[1] = nx; }
        const unsigned old = xb_add(&bar[XB_XSUB(b.x)], 1u);
        const unsigned gen = old / nloc;
        if (old + 1u == (gen + 1u) * nloc) {
            __builtin_amdgcn_fence(__ATOMIC_RELEASE, "agent");
            asm volatile("s_waitcnt vmcnt(0)" ::: "memory");
            const unsigned og = xb_add(&bar[XB_TOP], 1u);
            const unsigned tg = og / nx;
            if (og + 1u == (tg + 1u) * nx) xb_add(&bar[XB_TOPGEN], 1u);
            else XB_SPIN(xb_ld(&bar[XB_TOPGEN]) == tg, bar);
            __builtin_amdgcn_fence(__ATOMIC_ACQUIRE, "agent");
            xb_add(&bar[XB_XGEN(b.x)], 1u);
            asm volatile("s_waitcnt vmcnt(0)" ::: "memory");
        } else {
            XB_SPIN(xb_ld(&bar[XB_XGEN(b.x)]) == gen, bar);
            __builtin_amdgcn_fence(__ATOMIC_ACQUIRE, "agent");
            asm volatile("s_waitcnt vmcnt(0)" ::: "memory");
        }
    }
    __syncthreads();
}

struct Args { const float* in[21]; float* out; unsigned char* ws; int ph_lo, ph_hi; };
typedef const __attribute__((address_space(4))) Args* KArgs;
struct Frame {
    LAS unsigned char* lds; volatile LAS unsigned* MISC; LAS int* LM; gu32* ctl;
    int vcu, G;
    KArgs ka;
    __device__ __forceinline__ int tid() const { int t = threadIdx.x; asm volatile("" : "+v"(t)); return t; }
    __device__ __forceinline__ int lane() const { return tid() & 63; }
    __device__ __forceinline__ int wave() const { return __builtin_amdgcn_readfirstlane(tid() >> 6); }
    float* out; unsigned char* ws;
    __device__ __forceinline__ const float* x() const { return ka->in[0]; }
    __device__ __forceinline__ const float* c() const { return ka->in[1]; }
    __device__ __forceinline__ const float* w_ada() const { return ka->in[2]; }
    __device__ __forceinline__ const float* b_ada() const { return ka->in[3]; }
    __device__ __forceinline__ const float* g1() const { return ka->in[4]; }
    __device__ __forceinline__ const float* w_in() const { return ka->in[5]; }
    __device__ __forceinline__ const float* sinks() const { return ka->in[6]; }
    __device__ __forceinline__ const float* w_pool() const { return ka->in[7]; }
    __device__ __forceinline__ const float* pool_scale() const { return ka->in[8]; }
    __device__ __forceinline__ const float* w_ab() const { return ka->in[9]; }
    __device__ __forceinline__ const float* w_pb() const { return ka->in[10]; }
    __device__ __forceinline__ const float* w_out() const { return ka->in[11]; }
    __device__ __forceinline__ const float* g2() const { return ka->in[12]; }
    __device__ __forceinline__ const float* w_rg() const { return ka->in[13]; }
    __device__ __forceinline__ const float* b_rg() const { return ka->in[14]; }
    __device__ __forceinline__ const float* w_re() const { return ka->in[15]; }
    __device__ __forceinline__ const float* b_re() const { return ka->in[16]; }
    __device__ __forceinline__ const float* w_eg() const { return ka->in[17]; }
    __device__ __forceinline__ const float* w_eu() const { return ka->in[18]; }
    __device__ __forceinline__ const float* w_ed() const { return ka->in[19]; }
    __device__ __forceinline__ const float* fg() const { return ka->in[20]; }
};

__device__ __forceinline__ unsigned pk2(float lo, float hi) { return pg8::cvt_pk_bf16(lo, hi); }
struct P0Item { const float* W; bf16* WT; int N, dpitch, drow0, k0, n0, dk; };
__device__ __forceinline__ void p0_item_load(const P0Item& I, f32x4 (&a)[8], f32x4 (&b)[8], int lane) {
    const int nq = lane & 15, kr = lane >> 4;
#pragma unroll
    for (int it = 0; it < 8; ++it) { const float* p = I.W + (size_t)(I.k0 + 8 * it + 2 * kr) * I.N + I.n0 + 4 * nq; a[it] = __builtin_nontemporal_load((const GAS f32x4*)p); b[it] = __builtin_nontemporal_load((const GAS f32x4*)(p + I.N)); }
}
__device__ __forceinline__ void p0_item_store(const P0Item& I, const f32x4 (&a)[8], const f32x4 (&b)[8], LAS unsigned* scr, int lane) {
    const int nq = lane & 15, kr = lane >> 4;
#pragma unroll
    for (int it = 0; it < 8; ++it) { LAS unsigned* d = scr + (4 * it + kr) * 65 + 4 * nq;
        d[0] = pk2(a[it].x, b[it].x); d[1] = pk2(a[it].y, b[it].y); d[2] = pk2(a[it].z, b[it].z); d[3] = pk2(a[it].w, b[it].w); }
    LDS_WAIT(); asm volatile("" ::: "memory");
    const int c = lane & 7, nl = lane >> 3;
#pragma unroll
    for (int j = 0; j < 8; ++j) { const int n = nl + 8 * j; const LAS unsigned* sp = scr + (4 * c) * 65 + n;
        v4u o; o.x = sp[0]; o.y = sp[65]; o.z = sp[130]; o.w = sp[195];
        *(GAS v4u*)(I.WT + (size_t)(I.drow0 + n) * I.dpitch + I.k0 + I.dk + 8 * c) = o; }
    LDS_WAIT(); asm volatile("" ::: "memory");
}
namespace cv {
constexpr int I_IN = (D / 64) * (NPROJ / 64), I_BR = (1024 / 64) * (D / 64), I_OUT = (D / 64) * (D / 64), I_POOL = 0;
constexpr int I_GE = (D / 64) * (FF / 64), I_DN = (FF / 64) * (D / 64);
constexpr int G0 = I_IN + 2 * I_BR + I_OUT + I_POOL, U0 = G0 + NEXP * I_GE, DN0 = U0 + NEXP * I_GE, NITEMS = DN0 + NEXP * I_DN;
constexpr int E_LATE = 8;
constexpr int NP0 = G0 + (NEXP - E_LATE) * I_GE + (NEXP - E_LATE) * I_GE;
constexpr int NP1 = 2 * E_LATE * I_GE, NP6 = NEXP * I_DN;
__device__ __forceinline__ int map_p0(int j) { const int h = G0 + (NEXP - E_LATE) * I_GE; return j < h ? j : U0 + (j - h); }
__device__ __forceinline__ int map_p1(int j) { return j < E_LATE * I_GE ? G0 + (NEXP - E_LATE) * I_GE + j : U0 + (NEXP - E_LATE) * I_GE + (j - E_LATE * I_GE); }
__device__ __forceinline__ int map_p6(int j) { return DN0 + j; }
}
__device__ __forceinline__ P0Item p0_decode(Frame& F, int it) { using namespace cv; int r = it; P0Item I;
    bf16* WIN = (bf16*)(F.ws + WS_WIN); bf16* WPB = (bf16*)(F.ws + WS_WPB); bf16* WAB = (bf16*)(F.ws + WS_WTMP); bf16* WOUT = (bf16*)(F.ws + WS_WOUT);
    bf16* WPOOL = (bf16*)(F.ws + WS_WPOOL); bf16* WGU = (bf16*)(F.ws + WS_WGU); bf16* WDN = (bf16*)(F.ws + WS_WDN);
    if (r < I_IN) { const int nb = NPROJ / 64; I = {F.w_in(), WIN, NPROJ, D, 64 * (r % nb), 64 * (r / nb), 64 * (r % nb), 0}; return I; } r -= I_IN;
    if (r < I_BR) { const int nb = D / 64; I = {F.w_pb(), WAB, D, 1024, 64 * (r % nb), 64 * (r / nb), 64 * (r % nb), 0}; return I; } r -= I_BR;
    if (r < I_BR) { const int nb = D / 64; I = {F.w_ab(), WPB, D, 2048, 64 * (r % nb), 64 * (r / nb), 64 * (r % nb), 1024}; return I; } r -= I_BR;
    if (r < I_OUT) { const int nb = D / 64; I = {F.w_out(), WOUT, D, D, 64 * (r % nb), 64 * (r / nb), 64 * (r % nb), 0}; return I; } r -= I_OUT;
    if (r < I_POOL) { const int g = r / 16, q = r % 16; I = {F.w_pool() + (size_t)g * 65536, WPOOL + (size_t)g * 65536, 256, 256, 64 * (q % 4), 64 * (q / 4), 64 * (q % 4), 0}; return I; } r -= I_POOL;
    if (r < NEXP * I_GE) { const int e = r / I_GE, q = r % I_GE, nb = FF / 64, n0 = 64 * (q % nb); I = {F.w_eg() + (size_t)e * D * FF, WGU + (size_t)e * 1024 * D, FF, D, (n0 >> 7) * 256 + (n0 & 127), 64 * (q / nb), n0, 0}; return I; } r -= NEXP * I_GE;
    if (r < NEXP * I_GE) { const int e = r / I_GE, q = r % I_GE, nb = FF / 64, n0 = 64 * (q % nb); I = {F.w_eu() + (size_t)e * D * FF, WGU + (size_t)e * 1024 * D, FF, D, (n0 >> 7) * 256 + 128 + (n0 & 127), 64 * (q / nb), n0, 0}; return I; } r -= NEXP * I_GE;
    { const int e = r / I_DN, q = r % I_DN, nb = D / 64, n0 = 64 * (q % nb); I = {F.w_ed() + (size_t)e * FF * D, WDN + (size_t)e * D * FF, D, FF, n0, 64 * (q / nb), n0, 0}; return I; } }
template <class ItemOf> __device__ __forceinline__ void p0_convert(Frame& F, ItemOf item_of) {
    LAS unsigned* scr = (LAS unsigned*)(F.lds + RING_OFF + F.wave() * 16384); const int lane = F.lane();
    int k = 0, it0 = item_of(0);
    if (it0 >= 0) { f32x4 a0[8], b0[8], a1[8], b1[8]; P0Item I0 = p0_decode(F, it0), I1 = I0; p0_item_load(I0, a0, b0, lane);
        for (;;) { int it1 = item_of(++k); if (it1 >= 0) { I1 = p0_decode(F, it1); p0_item_load(I1, a1, b1, lane); }
            p0_item_store(I0, a0, b0, scr, lane); if (it1 < 0) break;
            it0 = item_of(++k); if (it0 >= 0) { I0 = p0_decode(F, it0); p0_item_load(I0, a0, b0, lane); }
            p0_item_store(I1, a1, b1, scr, lane); if (it0 < 0) break; } }
}
template <class Map> __device__ __forceinline__ void p0_convert_tail(Frame& F, int w, int nw, int n, Map map) {
    p0_convert(F, [&](int k) -> int { const int j = w + k * nw; return j < n ? map(j) : -1; });
}
__device__ __forceinline__ void p0_prologue(Frame& F) {
    const int gw = F.vcu * NWAVES + F.wave(), NGW = F.G * NWAVES, lane = F.lane();
    float* ADAP = (float*)(F.ws + WS_ADAP);
    constexpr int P0_TW = 3, P0_R1 = 1;
    const bool tw = F.wave() < P0_TW;
    if (tw) for (int task = F.vcu * P0_TW + F.wave(); task < ADA_SL * 48; task += F.G * P0_TW) { const int ks = task / 48, j = (task % 48) * 256 + 4 * lane; constexpr int KS = D / ADA_SL;
        f32x4 a0 = {0.f, 0.f, 0.f, 0.f}, a1 = {0.f, 0.f, 0.f, 0.f};
#pragma unroll 32
        for (int k = ks * KS; k < ks * KS + KS; ++k) { const f32x4 w = __builtin_nontemporal_load((const GAS f32x4*)(F.w_ada() + (size_t)k * NADA + j)); a0 += w * F.c()[k]; a1 += w * F.c()[D + k]; }
        *(GAS f32x4*)(ADAP + ((size_t)ks * 2 + 0) * NADA + j) = a0; *(GAS f32x4*)(ADAP + ((size_t)ks * 2 + 1) * NADA + j) = a1; }
    { bf16* WRT = (bf16*)(F.ws + WS_WRT);
      for (int idx = gw * 64 + lane; idx < 32 * D; idx += NGW * 64) { const int n = idx >> 11, d = idx & (D - 1);
          const float w = n < 4 ? F.w_rg()[(size_t)d * 4 + n] : (n < 20 ? F.w_re()[(size_t)d * 16 + (n - 4)] : 0.f);
          const unsigned hi = f2bf(w); const unsigned lo = f2bf(w - bf2f(hi));
          const size_t fi = ((size_t)(d >> 4) * 2) * 512 + (size_t)(((d >> 3) & 1) * 32 + n) * 8 + (d & 7);
          WRT[fi] = (bf16)hi; WRT[fi + 512] = (bf16)lo; } }
    { bf16* WPS = (bf16*)(F.ws + WS_WPOOL);
      for (int idx = (gw * 64 + lane) * 4; idx < 4 * 65536; idx += NGW * 64 * 4) { const int g = idx >> 16, d = idx & 255;
          const f32x4 w = *(const GAS f32x4*)(F.w_pool() + idx), sc = *(const GAS f32x4*)(F.pool_scale() + 256 * g + d);
          v2u o; o.x = pk2(w.x * sc.x, w.y * sc.y); o.y = pk2(w.z * sc.z, w.w * sc.w); *(GAS v2u*)(WPS + idx) = o; } }
    { const int NTW = F.G * P0_TW, NCW = F.G * (NWAVES - P0_TW), HEAD = NTW * P0_R1 < cv::NP0 ? NTW * P0_R1 : 0;
      const int twi = F.vcu * P0_TW + F.wave(), cwi = F.vcu * (NWAVES - P0_TW) + (F.wave() - P0_TW);
      p0_convert(F, [&](int k) -> int { int j;
          if (tw) j = (HEAD && k < P0_R1) ? k * NTW + twi : cv::NP0; else j = HEAD + k * NCW + cwi;
          return j < cv::NP0 ? cv::map_p0(j) : -1; }); }
}
__device__ __forceinline__ void p0b_h1(Frame& F) {
    const float* ADAP = (const float*)(F.ws + WS_ADAP); float* ADA = (float*)(F.ws + WS_ADA); bf16* H1 = (bf16*)(F.ws + WS_B);
    LAS float* gsL = (LAS float*)(F.lds + RING_OFF);
    LAS float* shL = gsL + 2 * D;
    const bool split = (F.G & 1) == 0; const int hg = F.G >> 1, b0 = split ? (F.vcu >= hg ? 1 : 0) : 0, nent = split ? D : 2 * D;
    for (int i = F.tid(); i < nent; i += NWAVES * 64) { const int b = b0 + i / D, d = i % D; float ps[ADA_SL], pc[ADA_SL];
#pragma unroll
        for (int ks = 0; ks < ADA_SL; ++ks) { ps[ks] = ADAP[((size_t)ks * 2 + b) * NADA + d]; pc[ks] = ADAP[((size_t)ks * 2 + b) * NADA + D + d]; }
        float sh = F.b_ada()[d], sc = F.b_ada()[D + d];
#pragma unroll
        for (int ks = 0; ks < ADA_SL; ++ks) { sh += ps[ks]; sc += pc[ks]; }
        gsL[b * D + d] = F.g1()[d] * (1.f + sc); shL[b * D + d] = sh; }
    { const int i = F.vcu * (NWAVES * 64) + F.tid(); if (i < 2 * NADA) { const int b = i / NADA, j = i % NADA; float pp[ADA_SL];
#pragma unroll
        for (int ks = 0; ks < ADA_SL; ++ks) pp[ks] = ADAP[((size_t)ks * 2 + b) * NADA + j];
        float s = F.b_ada()[j];
#pragma unroll
        for (int ks = 0; ks < ADA_SL; ++ks) s += pp[ks];
        ADA[i] = s; } }
    LDS_WAIT(); __syncthreads();
    const int lane = F.lane();
    const int gw = split ? (F.vcu - b0 * hg) * NWAVES + F.wave() : F.vcu * NWAVES + F.wave(), NGW = split ? hg * NWAVES : F.G * NWAVES;
    const int rbase = split ? b0 * SEQ : 0, rend = split ? rbase + SEQ : T;
    auto ld = [&](int row, f32x4 (&v)[8]) { int r = row; asm volatile("" : "+s"(r)); const GAS f32x4* xr = (const GAS f32x4*)(F.x() + (size_t)r * D) + lane;
#pragma unroll
        for (int j = 0; j < 8; ++j) v[j] = __builtin_nontemporal_load(xr + 64 * j); };
    auto fin = [&](int row, const f32x4 (&v)[8]) { const int b = row / SEQ; float ss = 0.f;
#pragma unroll
        for (int j = 0; j < 8; ++j) ss += (v[j].x * v[j].x + v[j].y * v[j].y) + (v[j].z * v[j].z + v[j].w * v[j].w);
        const float rstd = rsqrtf(wave_sum(ss) * (1.0f / D) + EPS);
#pragma unroll
        for (int j = 0; j < 8; ++j) { const int d = 4 * lane + 256 * j; const f32x4 gs = *(const LAS f32x4*)(gsL + b * D + d), sh = *(const LAS f32x4*)(shL + b * D + d);
            const f32x4 o = v[j] * rstd * gs + sh; v2u w; w.x = pk2(o.x, o.y); w.y = pk2(o.z, o.w);
            *(GAS v2u*)(H1 + (size_t)row * D + d) = w; } };
    { f32x4 va[8], vb[8]; int row = rbase + gw;
      if (row < rend) { ld(row, va);
#pragma unroll 1
          for (;;) { const int r1 = row + NGW; if (r1 < rend) ld(r1, vb);
              fin(row, va); if (r1 >= rend) break;
              const int r2 = r1 + NGW; if (r2 < rend) ld(r2, va);
              fin(r1, vb); if (r2 >= rend) break; row = r2; } } }
    __syncthreads();
}

constexpr int AT_BUF = 49152, AT_K = 0, AT_V = 24576, AT_WS = 2 * AT_BUF, AT_OST = AT_WS + 2048, AT_BYTES = AT_OST + 32768;
static_assert(AT_BYTES <= LDSCTL_OFF, "attention LDS map");
__device__ __forceinline__ int crow(int r, int hi) { return (r & 3) + 8 * (r >> 2) + 4 * hi; }
__device__ __forceinline__ unsigned cvtpk_s(float lo, float hi) { typedef float f32x2_t __attribute__((ext_vector_type(2))); typedef __bf16 bf16x2_t __attribute__((ext_vector_type(2)));
    f32x2_t v = {lo, hi}; bf16x2_t b = __builtin_convertvector(v, bf16x2_t); return __builtin_bit_cast(unsigned, b); }
typedef short v4i16_t __attribute__((ext_vector_type(4)));
__device__ __forceinline__ s16x4 vtr(LAS const unsigned char* p) { return __builtin_bit_cast(s16x4, __builtin_amdgcn_ds_read_tr16_b64_v4i16((LAS v4i16_t*)p)); }
struct AttnU { int b, kvh, q0; };
__device__ __forceinline__ AttnU attn_decode(int unit) { AttnU u; u.q0 = (unit & 127) * 64; u.kvh = (unit >> 7) & 3; u.b = unit >> 9; return u; }
__device__ __forceinline__ void attn_dma(Frame& F, const AttnU u, int buf, int wid, int lane) {
    const bf16* P = (const bf16*)(F.ws + WS_PROJ); LAS unsigned char* L = F.lds + RING_OFF + buf * AT_BUF;
#pragma unroll
    for (int t = 0; t < 3; ++t) {
        int kk = u.q0 - 128 + 64 * t + lane; if (kk < 0) kk = 0;
        int kv = u.q0 - 128 + 64 * t + 16 * (wid & 3) + (lane >> 2); if (kv < 0) kv = 0;
        const bf16* ks = P + ((size_t)u.b * SEQ + kk) * NPROJ + C_K + u.kvh * 64 + wid * 8;
        const bf16* vs = P + ((size_t)u.b * SEQ + kv) * NPROJ + C_V + u.kvh * 64 + (wid >> 2) * 32 + (lane & 3) * 8;
        __builtin_amdgcn_global_load_lds((const unsigned*)ks, (LAS unsigned*)(L + AT_K + t * 8192 + wid * 1024), 16, 0, 0);
        __builtin_amdgcn_global_load_lds((const unsigned*)vs, (LAS unsigned*)(L + AT_V + t * 8192 + wid * 1024), 16, 0, 0); }
}
__device__ __forceinline__ void attn_q(Frame& F, const AttnU u, bf16x8 (&qr)[4], int wid, int lane) {
    const bf16* P = (const bf16*)(F.ws + WS_PROJ); const int hq = u.kvh * 4 + (wid & 3), rh = wid >> 2, r32 = lane & 31, hi = lane >> 5;
    const size_t qrow = (size_t)u.b * SEQ + u.q0 + 32 * rh + r32;
#pragma unroll
    for (int d0 = 0; d0 < 4; ++d0) qr[d0] = __builtin_nontemporal_load((const GAS bf16x8*)(P + qrow * NPROJ + C_Q + hq * 64 + d0 * 16 + hi * 8));
}
__device__ __forceinline__ void attn_compute(Frame& F, const AttnU u, int buf, const bf16x8 (&qr)[4], int wid, int lane, float sink2) {
    bf16* AP = (bf16*)(F.ws + WS_B);
    const int r32 = lane & 31, hi = lane >> 5, q0 = u.q0, hq = u.kvh * 4 + (wid & 3), rh = wid >> 2;
    LAS unsigned char* L = F.lds + RING_OFF + buf * AT_BUF; LAS unsigned char* L0 = F.lds + RING_OFF;
    f32x16 p[5];
#pragma unroll
    for (int s = 0; s < 5; ++s) { const int j = rh + s; f32x16 a;
        if (q0 - 128 + 32 * j >= 0) { a = f32x16{};
            const int ko = AT_K + (j >> 1) * 8192 + (j & 1) * 512;
#pragma unroll
            for (int d0 = 0; d0 < 4; ++d0) { const bf16x8 kf = *(const LAS bf16x8*)(L + ko + (2 * d0 + hi) * 1024 + r32 * 16);
                a = __builtin_amdgcn_mfma_f32_32x32x16_bf16(kf, qr[d0], a, 0, 0, 0); } }
        else {
#pragma unroll
            for (int r = 0; r < 16; ++r) a[r] = -1e30f; }
        p[s] = a; }
    const float xf = (float)(r32 - 4 * hi);
#pragma unroll
    for (int r = 0; r < 16; ++r) { const float dlt = xf - (float)((r & 3) + 8 * (r >> 2));
        p[0][r] = __builtin_fmaf(fmaxf(dlt + 1.0f, 0.0f), -1e30f, p[0][r]);
        p[4][r] = __builtin_fmaf(fmaxf(-dlt, 0.0f), -1e30f, p[4][r]); }
    float mx = sink2;
#pragma unroll
    for (int s = 0; s < 5; ++s)
#pragma unroll
        for (int r = 0; r < 16; ++r) mx = fmaxf(mx, p[s][r]);
    mx = fmaxf(mx, __shfl_xor(mx, 32));
    float lsum = 0.f;
#pragma unroll
    for (int s = 0; s < 5; ++s)
#pragma unroll
        for (int r = 0; r < 16; ++r) { const float e = __builtin_amdgcn_exp2f(p[s][r] - mx); p[s][r] = e; lsum += e; }
    lsum += __shfl_xor(lsum, 32);
    lsum += __builtin_amdgcn_exp2f(sink2 - mx);
    f32x16 o[2]; o[0] = f32x16{}; o[1] = f32x16{};
    const int vb = AT_V + ((lane >> 4) & 1) * 32 + (lane & 3) * 8 + (4 * hi + ((lane & 15) >> 2)) * 64;
#pragma unroll
    for (int s = 0; s < 5; ++s) { const int j = rh + s; const int vo = vb + (j >> 1) * 8192 + (j & 1) * 2048;
        v4u pw[2];
#pragma unroll
        for (int kk = 0; kk < 2; ++kk) { const int rb = kk * 8;
            pw[kk].x = cvtpk_s(p[s][rb + 0], p[s][rb + 1]); pw[kk].y = cvtpk_s(p[s][rb + 2], p[s][rb + 3]);
            pw[kk].z = cvtpk_s(p[s][rb + 4], p[s][rb + 5]); pw[kk].w = cvtpk_s(p[s][rb + 6], p[s][rb + 7]); }
#pragma unroll
        for (int d0 = 0; d0 < 2; ++d0)
#pragma unroll
            for (int kk = 0; kk < 2; ++kk) { const s16x4 lo = vtr(L + vo + d0 * 4096 + kk * 1024), hh = vtr(L + vo + d0 * 4096 + kk * 1024 + 512);
                const bf16x8 vf = {lo[0], lo[1], lo[2], lo[3], hh[0], hh[1], hh[2], hh[3]};
                o[d0] = __builtin_amdgcn_mfma_f32_32x32x16_bf16(__builtin_bit_cast(bf16x8, pw[kk]), vf, o[d0], 0, 0, 0); }
        __builtin_amdgcn_sched_barrier(0); }
    LAS float* wsf = (LAS float*)(L0 + AT_WS) + wid * 64;
    if (hi == 0) wsf[r32] = lsum;
    LDS_WAIT();
    LAS bf16* stg = (LAS bf16*)(L0 + AT_OST) + wid * 2048;
#pragma unroll
    for (int r = 0; r < 16; ++r) { const int orow = crow(r, hi); const float rl = __builtin_amdgcn_rcpf(wsf[orow]);
#pragma unroll
        for (int d0 = 0; d0 < 2; ++d0) stg[orow * 64 + d0 * 32 + r32] = (bf16)f2bf(o[d0][r] * rl); }
    LDS_WAIT();
    bf16* Ow = AP + ((size_t)u.b * SEQ + q0 + 32 * rh) * D + 1024 + hq * 64;
#pragma unroll
    for (int i = 0; i < 4; ++i) { const int row = i * 8 + (lane >> 3), ch = lane & 7; const v4u v = *(const LAS v4u*)(stg + row * 64 + ch * 8); *(GAS v4u*)(Ow + (size_t)row * D + ch * 8) = v; }
}
__device__ __forceinline__ void attn_phase(Frame& F) {
    constexpr int NU = BATCH * 4 * (SEQ / 64);
    const int wid = F.wave(), lane = F.lane();
    int unit = F.vcu; if (unit >= NU) return;
    bf16x8 qc[4], qn[4];
    float sk[4];
#pragma unroll
    for (int k = 0; k < 4; ++k) sk[k] = F.sinks()[k * 4 + (wid & 3)] * LOG2E;
    attn_dma(F, attn_decode(unit), 0, wid, lane); attn_q(F, attn_decode(unit), qc, wid, lane);
    VM_WAIT(); __syncthreads();
    int buf = 0;
#pragma unroll 1
    for (;; unit += F.G, buf ^= 1) {
        const int nu = unit + F.G; const bool more = nu < NU;
        if (more) { attn_dma(F, attn_decode(nu), buf ^ 1, wid, lane); attn_q(F, attn_decode(nu), qn, wid, lane); }
        { const AttnU cu = attn_decode(unit); const float sk2 = cu.kvh == 0 ? sk[0] : cu.kvh == 1 ? sk[1] : cu.kvh == 2 ? sk[2] : sk[3];
          attn_compute(F, cu, buf, qc, wid, lane, sk2); }
        asm volatile("s_waitcnt vmcnt(4)" ::: "memory"); LDS_WAIT(); __builtin_amdgcn_s_barrier(); asm volatile("" ::: "memory");
        if (!more) break;
#pragma unroll
        for (int d0 = 0; d0 < 4; ++d0) qc[d0] = qn[d0];
    }
}
template <int W> __device__ __forceinline__ void pooled_rows(const bf16* up, bf16* po, int r0, int t0) {
    constexpr int H = W - 1;
    v2u v[32 + H];
#pragma unroll
    for (int k = 0; k < 32 + H; ++k) { v[k].x = 0u; v[k].y = 0u; if (t0 + k - H >= 0) v[k] = __builtin_nontemporal_load((const GAS v2u*)(up + (size_t)(r0 + k - H) * NPROJ)); }
    float s0 = 0.f, s1 = 0.f, s2 = 0.f, s3 = 0.f;
#pragma unroll
    for (int k = 0; k < H; ++k) { s0 += bflo(v[k].x); s1 += bfhi(v[k].x); s2 += bflo(v[k].y); s3 += bfhi(v[k].y); }
#pragma unroll
    for (int i = 0; i < 32; ++i) { const float x0 = bflo(v[i + H].x), x1 = bfhi(v[i + H].x), x2 = bflo(v[i + H].y), x3 = bfhi(v[i + H].y);
        s0 += x0; s1 += x1; s2 += x2; s3 += x3;
        const int t = t0 + i; const float rc = (t + 1) < W ? 1.0f / (float)(t + 1) : 1.0f / (float)W;
        v2u o; o.x = pk2(s0 * rc - x0, s1 * rc - x1); o.y = pk2(s2 * rc - x2, s3 * rc - x3);
        *(GAS v2u*)(po + (size_t)(r0 + i) * D) = o;
        s0 -= bflo(v[i].x); s1 -= bfhi(v[i].x); s2 -= bflo(v[i].y); s3 -= bfhi(v[i].y); }
}
__device__ __forceinline__ void pooled_unit(Frame& F, int pm, int g) {
    const bf16* P = (const bf16*)(F.ws + WS_PROJ); bf16* PO = (bf16*)(F.ws + WS_B);
    const int tid = F.tid(), c4 = tid & 63, seg = tid >> 6;
    const int r0 = pm * 256 + seg * 32, t0 = r0 % SEQ;
    const bf16* up = P + C_U + 256 * g + 4 * c4; bf16* po = PO + 256 * g + 4 * c4;
    if (g == 0) pooled_rows<2>(up, po, r0, t0); else if (g == 1) pooled_rows<4>(up, po, r0, t0); else if (g == 2) pooled_rows<8>(up, po, r0, t0); else pooled_rows<16>(up, po, r0, t0);
}

__device__ __forceinline__ int p5_row(int blk, int j) { return (blk >> 7) * SEQ + 128 * j + (blk & 127); }
__device__ __forceinline__ void p5b_fill(Frame& F) {
    unsigned char* rt = F.ws + WS_RT;
    const int* TOKE = (const int*)(rt + RT_TOKE); const float* TOKW = (const float*)(rt + RT_TOKW); const int* LRANK = (const int*)(rt + RT_LRANK); int* TOKSLOT = (int*)(rt + RT_TOKSLOT);
    const int* BLKCNT = (const int*)(rt + RT_BLKCNT); int* SLOTTOK = (int*)(rt + RT_SLOTTOK); float* SLOTW = (float*)(rt + RT_SLOTW); int* META = (int*)(rt + RT_META);
    LAS int* cntL = (LAS int*)(F.lds + RING_OFF);
    LAS int* totL = cntL + 4096;
    for (int i = F.tid(); i < 4096; i += NWAVES * 64) cntL[i] = BLKCNT[i];
    LDS_WAIT(); __syncthreads();
    for (int blk = F.vcu; blk < 256; blk += F.G) {
        { const int e = F.tid() >> 5, s = F.tid() & 31; int pt = 0, pb = 0;
            for (int bb = 8 * s; bb < 8 * s + 8; ++bb) { const int c = cntL[bb * 16 + e]; pt += c; pb += (bb < blk) ? c : 0; }
#pragma unroll
            for (int o = 1; o < 32; o <<= 1) { pt += __shfl_xor(pt, o); pb += __shfl_xor(pb, o); }
            if (s == 0) { totL[e] = pt; totL[16 + e] = pb; } }
        LDS_WAIT(); __syncthreads();
        if (F.tid() == 0) { int o = 0, nt = 0; for (int e = 0; e < 16; ++e) { totL[32 + e] = o; const int tl = (totL[e] + 255) >> 8;
                if (F.vcu == 0 && blk == 0) { META[e] = o; for (int i = 0; i < tl; ++i) META[32 + nt + i] = e; } nt += tl; o += tl * 256; }
            totL[48] = o; if (F.vcu == 0 && blk == 0) { META[16] = o; META[17] = o; META[18] = nt; } }
        LDS_WAIT(); __syncthreads();
        if (F.tid() < 128) { const int t = F.tid(), i = p5_row(blk, t >> 1) * 2 + (t & 1), e = TOKE[i]; const int slot = totL[32 + e] + totL[16 + e] + LRANK[i];
            SLOTTOK[slot] = i >> 1; SLOTW[slot] = TOKW[i]; TOKSLOT[i] = slot; }
        if (blk < 16) { const int e = blk; for (int s = totL[32 + e] + totL[e] + F.tid(); s < totL[32 + e + 1]; s += NWAVES * 64) { SLOTTOK[s] = 0; SLOTW[s] = 0.f; } }
        __syncthreads();
    }
}

__device__ __forceinline__ float swap32_add(float a, float b) { const auto r = __builtin_amdgcn_permlane32_swap(__float_as_uint(a), __float_as_uint(b), false, false); return __uint_as_float(r[0]) + __uint_as_float(r[1]); }
__device__ __forceinline__ float swap16_add(float a, float b) { const auto r = __builtin_amdgcn_permlane16_swap(__float_as_uint(a), __float_as_uint(b), false, false); return __uint_as_float(r[0]) + __uint_as_float(r[1]); }
template <int CTRL> __device__ __forceinline__ float dpp_add(float v) { return v + __uint_as_float((unsigned)__builtin_amdgcn_update_dpp(0, (int)__float_as_uint(v), CTRL, 0xf, 0xf, false)); }
__device__ __forceinline__ float row16_sum(float v) { v = dpp_add<0x128>(v); v = dpp_add<0x124>(v); v = dpp_add<0x122>(v); v = dpp_add<0x121>(v); return v; }
#define P5_BAR() do { LDS_WAIT(); __builtin_amdgcn_s_barrier(); asm volatile("" ::: "memory"); } while (0)
constexpr int P5_AP = 528, P5_HI = 4096, P5_LO = P5_HI + 64 * P5_AP, P5_PART = 73728;
__device__ __forceinline__ void p5a_block(Frame& F, int blk, LAS int* eL) {
    typedef float f4 __attribute__((ext_vector_type(4)));
    const bf16* X1 = (const bf16*)(F.ws + WS_B); const float* SSQ = (const float*)(F.ws + WS_SSQ); const float* ada = (const float*)(F.ws + WS_ADA); bf16* H2 = (bf16*)(F.ws + WS_C);
    const bf16* WRT = (const bf16*)(F.ws + WS_WRT);
    unsigned char* rt = F.ws + WS_RT;
    LAS unsigned char* L = F.lds + RING_OFF;
    LAS float* partL = (LAS float*)(L + P5_PART);
    const int lane = F.lane(), wid = F.wave(), r32 = lane & 31, hl = lane >> 5;
    const int b = blk >> 7, rowb = p5_row(blk, 0);
    const float* sh = ada + (size_t)b * NADA + 3 * D; const float* sc = ada + (size_t)b * NADA + 4 * D;
    LAS float* gsL = (LAS float*)(L + 110592); LAS float* hL = (LAS float*)(L + 118784);
    { const int d0 = 4 * F.tid(); const f4 g = *(const GAS f4*)(F.g2() + d0), s = *(const GAS f4*)(sc + d0), h = *(const GAS f4*)(sh + d0);
      *(LAS f4*)(gsL + d0) = g * (1.f + s); *(LAS f4*)(hL + d0) = h; }
    const int rot = blk & 7;
    if (wid < 4) {
        float rs[16];
#pragma unroll
        for (int i = 0; i < 16; ++i) rs[i] = SSQ[(size_t)(rowb + 128 * (wid * 16 + i)) * 32 + (lane & 31)];
        v2u xa[16], xb[16], xc[16], xd[16];
#pragma unroll
        for (int i = 0; i < 16; ++i) { const bf16* xp = X1 + (size_t)(rowb + 128 * (wid * 16 + i)) * D + 4 * lane; xa[i] = __builtin_nontemporal_load((const GAS v2u*)(xp + 256 * (rot & 7))); xb[i] = __builtin_nontemporal_load((const GAS v2u*)(xp + 256 * ((rot + 1) & 7))); xc[i] = __builtin_nontemporal_load((const GAS v2u*)(xp + 256 * ((rot + 2) & 7))); xd[i] = __builtin_nontemporal_load((const GAS v2u*)(xp + 256 * ((rot + 3) & 7))); }
#pragma unroll
        for (int i = 0; i < 16; ++i) rs[i] = rsqrtf(wave_sum(lane < 32 ? rs[i] : 0.f) * (1.0f / D) + EPS);
        P5_BAR();
        auto xstep = [&](int j, v2u (&xn)[16]) { int d = 4 * lane + 256 * ((j + rot) & 7), dn = 4 * lane + 256 * ((j + 4 + rot) & 7); asm volatile("" : "+v"(d), "+v"(dn));
            const f4 gs = *(const LAS f4*)(gsL + d), h = *(const LAS f4*)(hL + d);
#pragma unroll
            for (int i = 0; i < 16; ++i) { const int rl = wid * 16 + i; const f4 xf = {bflo(xn[i].x), bfhi(xn[i].x), bflo(xn[i].y), bfhi(xn[i].y)}; const f4 hv = xf * rs[i] * gs + h;
                v2u whi; whi.x = pk2(hv.x, hv.y); whi.y = pk2(hv.z, hv.w);
                v2u wlo; wlo.x = pk2(hv.x - bflo(whi.x), hv.y - bfhi(whi.x)); wlo.y = pk2(hv.z - bflo(whi.y), hv.w - bfhi(whi.y));
                *(LAS v2u*)(L + P5_HI + rl * P5_AP + 8 * lane) = whi; *(LAS v2u*)(L + P5_LO + rl * P5_AP + 8 * lane) = wlo;
                *(GAS v2u*)(H2 + (size_t)(rowb + 128 * rl) * D + d) = whi; }
            if (j < 4) {
#pragma unroll
                for (int i = 0; i < 16; ++i) xn[i] = __builtin_nontemporal_load((const GAS v2u*)(X1 + (size_t)(rowb + 128 * (wid * 16 + i)) * D + dn)); }
            P5_BAR();
            P5_BAR(); };
#pragma unroll 1
        for (int jj = 0; jj < 8; jj += 4) { xstep(jj, xa); xstep(jj + 1, xb); xstep(jj + 2, xc); xstep(jj + 3, xd); }
    } else {
        const int kq = wid - 4;
        f32x16 acc0 = {}, acc1 = {};
        auto wload = [&](int j, bf16x8 (&bh)[4], bf16x8 (&bl)[4]) { int jq = (j + rot) & 7; asm volatile("" : "+s"(jq));
#pragma unroll
            for (int s4 = 0; s4 < 4; ++s4) { const bf16* wp = WRT + ((size_t)((jq * 4 + kq) * 4 + s4) * 2) * 512 + lane * 8; bh[s4] = *(const GAS bf16x8*)wp; bl[s4] = *(const GAS bf16x8*)(wp + 512); } };
        bf16x8 wah[4], wal[4], wbh[4], wbl[4];
        wload(0, wah, wal);
        P5_BAR();
        auto mstep = [&](int j, const bf16x8 (&bh)[4], const bf16x8 (&bl)[4], bf16x8 (&nh)[4], bf16x8 (&nl)[4]) {
            if (j < 7) wload(j + 1, nh, nl);
            P5_BAR();
#pragma unroll
            for (int s4 = 0; s4 < 4; ++s4) { const int ao = r32 * P5_AP + (64 * kq + 16 * s4 + 8 * hl) * 2;
                const bf16x8 ah0 = *(const LAS bf16x8*)(L + P5_HI + ao), al0 = *(const LAS bf16x8*)(L + P5_LO + ao);
                const bf16x8 ah1 = *(const LAS bf16x8*)(L + P5_HI + 32 * P5_AP + ao), al1 = *(const LAS bf16x8*)(L + P5_LO + 32 * P5_AP + ao);
                acc0 = __builtin_amdgcn_mfma_f32_32x32x16_bf16(ah0, bh[s4], acc0, 0, 0, 0); acc1 = __builtin_amdgcn_mfma_f32_32x32x16_bf16(ah1, bh[s4], acc1, 0, 0, 0);
                acc0 = __builtin_amdgcn_mfma_f32_32x32x16_bf16(ah0, bl[s4], acc0, 0, 0, 0); acc1 = __builtin_amdgcn_mfma_f32_32x32x16_bf16(ah1, bl[s4], acc1, 0, 0, 0);
                acc0 = __builtin_amdgcn_mfma_f32_32x32x16_bf16(al0, bh[s4], acc0, 0, 0, 0); acc1 = __builtin_amdgcn_mfma_f32_32x32x16_bf16(al1, bh[s4], acc1, 0, 0, 0); }
            P5_BAR(); };
#pragma unroll 1
        for (int jj = 0; jj < 8; jj += 4) { mstep(jj, wah, wal, wbh, wbl); mstep(jj + 1, wbh, wbl, wah, wal); mstep(jj + 2, wah, wal, wbh, wbl); mstep(jj + 3, wbh, wbl, wah, wal); }
#pragma unroll
        for (int r = 0; r < 16; ++r) { const int ro = ((r & 3) + 8 * (r >> 2) + 4 * hl) * 33 + r32; partL[(2 * kq) * 1056 + ro] = acc0[r]; partL[(2 * kq + 1) * 1056 + ro] = acc1[r]; }
    }
    P5_BAR();
    if (wid == 4) {
        float lg[20]; const int prb = lane >> 5, prow = lane & 31;
#pragma unroll
        for (int o = 0; o < 20; ++o) { float v = 0.f;
#pragma unroll
            for (int q = 0; q < 4; ++q) v += partL[(2 * q + prb) * 1056 + prow * 33 + o];
            lg[o] = v; }
        float gl[4]; int gi = 0;
#pragma unroll
        for (int o = 0; o < 4; ++o) gl[o] = lg[o] + F.b_rg()[o];
#pragma unroll
        for (int o = 1; o < 4; ++o) if (gl[o] > gl[gi]) gi = o;
        float gsum = 0.f;
#pragma unroll
        for (int o = 0; o < 4; ++o) gsum += __expf(gl[o] - gl[gi]);
        const float gp = 1.0f / gsum;
        float el[4];
#pragma unroll
        for (int o = 0; o < 4; ++o) { float v = 0.f;
#pragma unroll
            for (int g = 0; g < 4; ++g) v = (g == gi) ? lg[4 + 4 * g + o] + F.b_re()[4 * g + o] : v;
            el[o] = v; }
        int i1 = 0;
#pragma unroll
        for (int o = 1; o < 4; ++o) if (el[o] > el[i1]) i1 = o;
        int i2 = (i1 == 0) ? 1 : 0;
#pragma unroll
        for (int o = 0; o < 4; ++o) if (o != i1 && el[o] > el[i2]) i2 = o;
        const float rr = __expf(el[i2] - el[i1]);
        const float w1 = gp / (1.0f + rr), w2 = gp * rr / (1.0f + rr);
        const int row = rowb + 128 * lane, e1 = gi * 4 + i1, e2 = gi * 4 + i2;
        const unsigned long long lt = (1ull << lane) - 1ull; int r1 = 0, r2 = 0, mycnt = 0;
        for (int e = 0; e < NEXP; ++e) { const unsigned long long m1 = __ballot(e1 == e), m2 = __ballot(e2 == e);
            if (e1 == e) r1 = __popcll(m1 & lt); if (e2 == e) r2 = __popcll(m1) + __popcll(m2 & lt);
            if (lane == e) mycnt = __popcll(m1) + __popcll(m2); }
        int base = 0; if (lane < NEXP) base = (int)__hip_atomic_fetch_add((unsigned*)(F.ctl + CW_CNT) + lane, (unsigned)mycnt, __ATOMIC_RELAXED, __HIP_MEMORY_SCOPE_AGENT);
        const int p1 = e1 * T + __shfl(base, e1) + r1, p2 = e2 * T + __shfl(base, e2) + r2;
        int* LTOK = (int*)(F.ws + WS_LTOK); float* LW = (float*)(F.ws + WS_LW);
        LTOK[p1] = row; LW[p1] = w1; LTOK[p2] = row; LW[p2] = w2;
        ((int*)(rt + RT_TOKSLOT))[row * 2] = p1; ((int*)(rt + RT_TOKSLOT))[row * 2 + 1] = p2;
    }
}

__global__ void __launch_bounds__(NWAVES * 64, 2) mk_fwd(Args args) {
    extern __shared__ __attribute__((aligned(16))) unsigned char lds[];
    Frame F;
    F.lds = (LAS unsigned char*)lds; F.MISC = (volatile LAS unsigned*)(F.lds + MISC_OFF); F.LM = (LAS int*)(F.lds + LMETA_OFF);
    F.G = gridDim.x; { const int bx = blockIdx.x; F.vcu = (F.G % 8 == 0) ? (bx % 8) * (F.G / 8) + bx / 8 : bx; }
    F.ws = args.ws; F.out = args.out; F.ctl = (gu32*)(args.ws + WS_CTL);
    F.ka = (KArgs)__builtin_amdgcn_kernarg_segment_ptr();
    { int zt = F.tid(); asm volatile("" : "+v"(zt));
      for (int u = zt; u < (LDS_BYTES - LDSCTL_OFF) / 4; u += NWAVES * 64) ((LAS unsigned*)(F.lds + LDSCTL_OFF))[u] = 0u; }
    __syncthreads();
    const int lo = args.ph_lo, hi = args.ph_hi;
    XcdBarrier bar; bar.bar = (unsigned*)(F.ctl + CW_BAR); bar.x = 0; bar.st = nullptr;
    if (hi - lo > 1) bar = xcd_barrier_post((unsigned*)(F.ctl + CW_BAR), F.MISC);
#ifndef ENMASK
#define ENMASK 0x7FF
#endif
#define IN(k) (((ENMASK >> (k)) & 1) && lo <= (k) && (k) < hi)
#define SEAM(k) do { if (IN(k) && IN((k) + 1)) xcd_barrier(bar); } while (0)
#ifndef REPMASK
#define REPMASK 0
#endif
#define REP(k) _Pragma("unroll 1") for (int rep_ = 0; rep_ < 1 + ((REPMASK >> (k)) & 1); ++rep_)
    unsigned char* ws = args.ws; float* ADA = (float*)(ws + WS_ADA);
    bf16* PROJ = (bf16*)(ws + WS_PROJ); bf16* BUFB = (bf16*)(ws + WS_B); bf16* BUFC = (bf16*)(ws + WS_C);
    unsigned char* rt = ws + WS_RT;

    if (IN(0)) REP(0) { p0_prologue(F); } SEAM(0);
    if (IN(1)) REP(1) { p0b_h1(F); } SEAM(1);
    if (IN(2)) REP(2) {
        pg8::Gemm g{BUFB, (const bf16*)(ws + WS_WIN), D, D, D, 0, nullptr, nullptr}; pg8::StaticOrder S; S.init(T, NPROJ, F.G, (int)blockIdx.x);
        pg8::gemm_phase<pg8::EpProj, pg8::StaticOrder, false>(F.lds + RING_OFF, g, S, pg8::EpProj{PROJ, (unsigned char*)F.out + 64 * MiB}, STG_P1);
        { const int nwg = (T / 256) * (NPROJ / 256), rem = nwg % F.G, c = (int)blockIdx.x;
          const int nidle = rem ? F.G - rem : F.G, first = rem ? rem : 0;
          if (c >= first) {
              for (int j = c - first; j < 32; j += nidle) { const int gq = j >> 3;
                  pg8::Gemm gf{(const bf16*)(ws + WS_WTMP) + 256 * gq, (const bf16*)(ws + WS_WPOOL), 1024, 256, 256, 65536, nullptr, nullptr};
                  pg8::OneUnit SF{{j & 7, 0, gq}};
                  pg8::gemm_phase<pg8::EpFold, pg8::OneUnit, false>(F.lds + RING_OFF, gf, SF, pg8::EpFold{(bf16*)(ws + WS_WPB)}); }
              { const int nfold = nidle > 64 ? 32 : 0, ci = c - first;
                if (ci >= nfold) p0_convert_tail(F, (ci - nfold) * NWAVES + F.wave(), (nidle - nfold) * NWAVES, cv::NP1, [](int j) { return cv::map_p1(j); }); } }
          __syncthreads(); }
    } SEAM(2);
    if (IN(3)) REP(3) {
        attn_phase(F);
        for (int u = F.vcu; u < 256; u += F.G) pooled_unit(F, u >> 2, u & 3);
    } SEAM(3);
    if (IN(4)) REP(4) {
        pg8::Gemm g{BUFB, (const bf16*)(ws + WS_WPB), D, D, D, 0, nullptr, nullptr}; pg8::StaticOrder S; S.init(T, D, F.G, (int)blockIdx.x);
        pg8::gemm_phase<pg8::EpMergedR, pg8::StaticOrder, false, true>(F.lds + RING_OFF, g, S, pg8::EpMergedR{BUFC, (const unsigned char*)F.out + 64 * MiB});
    } SEAM(4);
    if (IN(5)) REP(5) {
        pg8::Gemm g{BUFC, (const bf16*)(ws + WS_WOUT), D, D, D, 0, nullptr, nullptr}; pg8::StaticOrder S; S.init(T, D, F.G, (int)blockIdx.x);
        pg8::gemm_phase<pg8::EpX1, pg8::StaticOrder, false>(F.lds + RING_OFF, g, S, pg8::EpX1{F.x(), BUFB, ADA, (float*)(ws + WS_SSQ)}, STG_P4);
    } SEAM(5);
    if (IN(6)) REP(6) {
        LAS int* eL = (LAS int*)(F.lds + RING_OFF);
        for (int blk = F.vcu; blk < 256; blk += F.G) { p5a_block(F, blk, eL); LDS_WAIT(); __syncthreads(); }
    } SEAM(6);
    if (IN(8) || IN(9) || IN(10)) {
        if (F.wave() == 0) { const int l = F.lane(); int c = 0;
            if (l < NEXP) c = (int)__hip_atomic_load((unsigned*)(F.ctl + CW_CNT) + l, __ATOMIC_RELAXED, __HIP_MEMORY_SCOPE_AGENT);
            const int tl = (c + 255) >> 8; int incl = tl;
#pragma unroll
            for (int d = 1; d < NEXP; d <<= 1) { const int v = __shfl_up(incl, d); if (l >= d) incl += v; }
            const int nt0 = incl - tl, total = __shfl(incl, NEXP - 1);
            if (l < NEXP) { F.LM[l] = nt0 * 256; F.LM[192 + l] = c; F.LM[208 + l] = nt0; for (int i = 0; i < tl; ++i) F.LM[32 + nt0 + i] = l; }
            if (l == 0) { F.LM[16] = total * 256; F.LM[18] = total; } }
        LDS_WAIT(); __syncthreads();
    }
    if (IN(8)) REP(8) {
        pg8::Gemm g{BUFC, (const bf16*)(ws + WS_WGU), D, D, D, (size_t)1024 * D, (const int*)(ws + WS_LTOK), F.LM};
        pg8::DynOrder S{F.LM[18] * 4, 4, F.G, F.vcu, F.LM + 32};
        pg8::gemm_phase<pg8::EpAct, pg8::DynOrder, true>(F.lds + RING_OFF, g, S, pg8::EpAct{(bf16*)(ws + WS_ACT), (const float*)(ws + WS_LW), F.LM});
        { const int nun = F.LM[18] * 4, rem = nun % F.G, c = F.vcu;
          const int nidle = rem ? F.G - rem : F.G, first = rem ? rem : 0;
          if (c >= first) p0_convert_tail(F, (c - first) * NWAVES + F.wave(), nidle * NWAVES, cv::NP6, [](int j) { return cv::map_p6(j); });
          __syncthreads();
          const int rt0 = (first + 3) >> 2, rmax = (nun < F.G ? nun : F.G) >> 2, navail = rmax > rt0 ? rmax - rt0 : 0, nE = ((nidle >> 3) < navail ? (nidle >> 3) : navail) * 8;
          if (c >= first && nE > 0 && IN(9)) {
              VM_WAIT(); __syncthreads();
              if (F.tid() == 0) { __builtin_amdgcn_fence(__ATOMIC_RELEASE, "agent"); VM_WAIT();
                  __hip_atomic_fetch_add((unsigned*)(F.ctl + CW_MOE), 1u, __ATOMIC_RELAXED, __HIP_MEMORY_SCOPE_AGENT);
                  unsigned sp = 0; while (__hip_atomic_load((unsigned*)(F.ctl + CW_MOE), __ATOMIC_RELAXED, __HIP_MEMORY_SCOPE_AGENT) < (unsigned)nidle && ++sp < (1u << 20)) __builtin_amdgcn_s_sleep(2);
                  __builtin_amdgcn_fence(__ATOMIC_ACQUIRE, "agent"); VM_WAIT(); }
              __syncthreads();
              const int k = c - first;
              if (k < nE) { pg8::Gemm gd{(const bf16*)(ws + WS_ACT), (const bf16*)(ws + WS_WDN), FF, FF, FF, (size_t)D * FF, nullptr, nullptr};
                  const int pmE = rt0 + (k >> 3); pg8::OneUnit SE{{pmE, k & 7, F.LM[32 + pmE]}};
                  pg8::gemm_phase<pg8::EpY, pg8::OneUnit, false>(F.lds + RING_OFF, gd, SE, pg8::EpY{(bf16*)(ws + WS_Y)}); } } }
    } SEAM(8);
    if (IN(9)) REP(9) {
        pg8::Gemm g{(const bf16*)(ws + WS_ACT), (const bf16*)(ws + WS_WDN), FF, FF, FF, (size_t)D * FF, nullptr, nullptr};
        int nE = 0, rt0 = 0;
        if (IN(8)) { const int nun = F.LM[18] * 4, rem = nun % F.G, nidle = rem ? F.G - rem : F.G, first = rem ? rem : 0; rt0 = (first + 3) >> 2;
            const int rmax = (nun < F.G ? nun : F.G) >> 2, navail = rmax > rt0 ? rmax - rt0 : 0; nE = ((nidle >> 3) < navail ? (nidle >> 3) : navail) * 8; }
        pg8::DynOrder S{F.LM[18] * 8 - nE, 8, F.G, F.vcu, F.LM + 32, rt0 * 8, nE};
        pg8::gemm_phase<pg8::EpY, pg8::DynOrder, false>(F.lds + RING_OFF, g, S, pg8::EpY{(bf16*)(ws + WS_Y)}, STG_P7);
    } SEAM(9);
    if (IN(10)) {
        const int gw = F.vcu * NWAVES + F.wave(), NGW = F.G * NWAVES;
        for (int row = gw; row < T; row += NGW) final_row_pos(BUFB, F.out, (const bf16*)(ws + WS_Y), (const int*)(rt + RT_TOKSLOT), F.LM, ADA, F.fg(), row, F.lane());
    }
#undef IN
#undef SEAM
}

#ifndef FASTMASK
#define FASTMASK 0x7FF
#endif
#ifndef ONE_LAUNCH
#define ONE_LAUNCH 1
#endif
constexpr int NPHASE = 11;
extern "C" void kernel_launch(void* const* d_in, const int* in_sizes, int n_in, void* d_out, int out_size, void* d_ws, size_t ws_size, hipStream_t stream) {
    if (n_in != 21 || out_size != T * D || ws_size < WS_END) { fprintf(stderr, "kernel_launch: unexpected shapes (n_in %d out %d ws %zu)\n", n_in, out_size, ws_size); return; }
    static int grid = 0;
    if (grid == 0) {
        int dev = 0, cus = 0, per_cu = 0;
        if (hipGetDevice(&dev) != hipSuccess || hipDeviceGetAttribute(&cus, hipDeviceAttributeMultiprocessorCount, dev) != hipSuccess) { fprintf(stderr, "kernel_launch: device query failed\n"); grid = -1; return; }
        if (hipFuncSetAttribute((const void*)mk_fwd, hipFuncAttributeMaxDynamicSharedMemorySize, LDS_BYTES) != hipSuccess) { fprintf(stderr, "kernel_launch: hipFuncSetAttribute failed\n"); grid = -1; return; }
        if (hipOccupancyMaxActiveBlocksPerMultiprocessor(&per_cu, (const void*)mk_fwd, NWAVES * 64, LDS_BYTES) != hipSuccess || per_cu < 1) { fprintf(stderr, "kernel_launch: occupancy query says %d\n", per_cu); }
        (void)hipGetLastError();
        grid = cus;
    }
    if (grid < 0) return;
    const float* x = (const float*)d_in[0]; const float* c = (const float*)d_in[1]; const float* w_ada = (const float*)d_in[2]; const float* b_ada = (const float*)d_in[3];
    const float* norm1_g = (const float*)d_in[4]; const float* w_in = (const float*)d_in[5]; const float* sinks = (const float*)d_in[6]; const float* w_pool = (const float*)d_in[7];
    const float* pool_scale = (const float*)d_in[8]; const float* w_ab = (const float*)d_in[9]; const float* w_pb = (const float*)d_in[10]; const float* w_out = (const float*)d_in[11];
    const float* norm2_g = (const float*)d_in[12]; const float* w_rg = (const float*)d_in[13]; const float* b_rg = (const float*)d_in[14]; const float* w_re = (const float*)d_in[15];
    const float* b_re = (const float*)d_in[16]; const float* w_eg = (const float*)d_in[17]; const float* w_eu = (const float*)d_in[18]; const float* w_ed = (const float*)d_in[19];
    const float* final_g = (const float*)d_in[20];
    unsigned char* ws = (unsigned char*)d_ws; float* out = (float*)d_out;
    float* ADA = (float*)(ws + WS_ADA); float* ADAP = (float*)(ws + WS_ADAP); float* SSQ = (float*)(ws + WS_SSQ);
    bf16* PROJ = (bf16*)(ws + WS_PROJ); bf16* ACT = (bf16*)(ws + WS_ACT); bf16* Y = (bf16*)(ws + WS_Y);
    bf16* BUFB = (bf16*)(ws + WS_B); bf16* BUFC = (bf16*)(ws + WS_C);
    unsigned char* rt = ws + WS_RT;
    int* TOKE = (int*)(rt + RT_TOKE); float* TOKW = (float*)(rt + RT_TOKW); int* LRANK = (int*)(rt + RT_LRANK); int* TOKSLOT = (int*)(rt + RT_TOKSLOT);
    int* BLKCNT = (int*)(rt + RT_BLKCNT); int* BLKBASE = (int*)(rt + RT_BLKBASE); int* SLOTTOK = (int*)(rt + RT_SLOTTOK); float* SLOTW = (float*)(rt + RT_SLOTW); int* META = (int*)(rt + RT_META);

    (void)hipMemsetAsync(ws + WS_CTL, 0, 1 * MiB, stream);
    Args a{}; for (int i = 0; i < 21; ++i) a.in[i] = (const float*)d_in[i]; a.out = out; a.ws = ws;
    if (ONE_LAUNCH && FASTMASK == 0x7FF) { a.ph_lo = 0; a.ph_hi = NPHASE; hipLaunchKernelGGL(mk_fwd, dim3(grid), dim3(NWAVES * 64), LDS_BYTES, stream, a);
#ifdef EXTRA_PHASE
        a.ph_lo = EXTRA_PHASE; a.ph_hi = EXTRA_PHASE + 1; hipLaunchKernelGGL(mk_fwd, dim3(grid), dim3(NWAVES * 64), LDS_BYTES, stream, a);
#endif
        return; }
    for (int ph = 0; ph < NPHASE; ++ph) {
        const bool fast = (FASTMASK >> ph) & 1;
        if (fast || (ph == 0 && (FASTMASK & 0x33C))) { a.ph_lo = ph; a.ph_hi = ph + 1; hipLaunchKernelGGL(mk_fwd, dim3(grid), dim3(NWAVES * 64), LDS_BYTES, stream, a); if (fast) continue; }
        switch (ph) {
        case 0: nv::ada_part<<<dim3(NADA / 256, ADA_SL), 256, 0, stream>>>(c, w_ada, ADAP); break;
        case 1: nv::ada_sum<<<2 * NADA / 256, 256, 0, stream>>>(ADAP, b_ada, ADA); nv::h1<<<T / 4, 256, 0, stream>>>(x, norm1_g, ADA, BUFB); break;
        case 2: nv::gemm<false><<<dim3(NPROJ / 64, T / 64), 256, 0, stream>>>(nv::ABf16{BUFB, D, 0}, nv::WPlain{w_in, NPROJ}, nv::WPlain{w_in, NPROJ}, nv::EpProj{PROJ}, D); break;
        case 3: nv::attn<<<dim3(SEQ / 16, 16, BATCH), 256, 0, stream>>>(PROJ, sinks, BUFB);
                nv::pooled<<<(unsigned)((size_t)T * 1024 / 256), 256, 0, stream>>>(PROJ, BUFC);
                for (int g = 0; g < 4; ++g) nv::gemm<false><<<dim3(256 / 64, T / 64), 256, 0, stream>>>(nv::ABf16{BUFC, 1024, g * 256}, nv::WPlain{w_pool + (size_t)g * 256 * 256, 256}, nv::WPlain{w_pool, 256}, nv::EpPool{BUFB, pool_scale, g}, 256);
                break;
        case 4: nv::gemm<false><<<dim3(D / 64, T / 64), 256, 0, stream>>>(nv::ABf16{BUFB, D, 0}, nv::WPlain{w_pb, D}, nv::WPlain{w_pb, D}, nv::EpT1{BUFC, PROJ}, 1024);
                nv::gemm<false><<<dim3(D / 64, T / 64), 256, 0, stream>>>(nv::ABf16{BUFB, D, 1024}, nv::WPlain{w_ab, D}, nv::WPlain{w_ab, D}, nv::EpMerged{BUFC, PROJ}, 1024); break;
        case 5: nv::gemm<false><<<dim3(D / 64, T / 64), 256, 0, stream>>>(nv::ABf16{BUFC, D, 0}, nv::WPlain{w_out, D}, nv::WPlain{w_out, D}, nv::EpX1{out, x, ADA}, D);
                nv::ssq<<<T / 4, 256, 0, stream>>>(out, SSQ); break;
        case 6: nv::route<<<T / 4, 256, 0, stream>>>(out, SSQ, norm2_g, ADA, w_rg, b_rg, w_re, b_re, BUFB, TOKE, TOKW); nv::hist<<<256, 64, 0, stream>>>(TOKE, BLKCNT, LRANK); break;
        case 7: nv::scan<<<1, 256, 0, stream>>>(BLKCNT, BLKBASE, META, SLOTTOK, SLOTW); nv::fill<<<2 * T / 256, 256, 0, stream>>>(TOKE, TOKW, LRANK, BLKBASE, META, SLOTTOK, SLOTW, TOKSLOT); break;
        case 8: nv::gemm<true><<<dim3(FF / 64, MAXSLOT / 64), 256, 0, stream>>>(nv::AGather{BUFB, D, SLOTTOK, META}, nv::WExpert{w_eg, FF, (size_t)D * FF, META}, nv::WExpert{w_eu, FF, (size_t)D * FF, META}, nv::EpAct{ACT, SLOTW}, D); break;
        case 9: nv::gemm<false><<<dim3(D / 64, MAXSLOT / 64), 256, 0, stream>>>(nv::ASlot{ACT, FF, META}, nv::WExpert{w_ed, D, (size_t)FF * D, META}, nv::WExpert{w_ed, D, (size_t)FF * D, META}, nv::EpY{Y}, FF); break;
        case 10: nv::final_<<<T / 4, 256, 0, stream>>>(out, Y, TOKSLOT, ADA, final_g); break;
        }
    }
}
```

```cpp
#include <hip/hip_runtime.h>
#include <stdint.h>
#include <cstdio>

constexpr int D = 2048, BATCH = 2, SEQ = 8192, T = BATCH * SEQ;
constexpr int NPROJ = 6656;
constexpr int C_Q = 0, C_K = 1024, C_V = 1280, C_U = 1536, C_GA = 2560, C_GP = 4608;
constexpr int NADA = 6 * D;
constexpr int NEXP = 16, FF = 512;
constexpr int MAXSLOT = 2 * T + NEXP * 256;
constexpr int ADA_SL = 16;
constexpr float EPS = 1e-6f;
constexpr float LOG2E = 1.4426950408889634f;
constexpr float C2 = 0.125f * LOG2E;

typedef unsigned short bf16;

constexpr size_t MiB = 1u << 20;
constexpr size_t WS_CTL = 0;
constexpr size_t WS_ADA = 1 * MiB;
constexpr size_t WS_WRT = WS_ADA + 512 * 1024;
constexpr size_t WS_LTOK = 2 * MiB;
constexpr size_t WS_LW = 3 * MiB;
constexpr size_t WS_ADAP = 2 * MiB;
constexpr size_t WS_WIN = 4 * MiB;
constexpr size_t WS_WG8 = 14 * MiB;
constexpr size_t WS_H1F8 = 424 * MiB;
constexpr size_t WS_LS = 20 * MiB;
constexpr size_t WS_HS = 481 * MiB;
constexpr size_t WS_AP8 = 448 * MiB;
constexpr size_t WS_AS = 481 * MiB + 65536;
constexpr float SW_BR = 739.0f;
constexpr float SW_DN = 522.5f;
constexpr float SW_IN = 1045.0f;
constexpr float MERGED_SCALE = 16.0f;
constexpr float GATE_WSCALE = 64.0f;
constexpr size_t WS_WTMP = 416 * MiB;
constexpr size_t WS_WPB = 30 * MiB;
constexpr size_t WS_WAB = 34 * MiB;
constexpr size_t WS_WOUT = 38 * MiB;
constexpr size_t WS_WPOOL = 46 * MiB;
constexpr size_t WS_WGU = 47 * MiB;
constexpr size_t WS_WDN = 111 * MiB;
constexpr size_t WS_PROJ = 144 * MiB;
constexpr size_t WS_ACT = 144 * MiB;
constexpr size_t WS_Y = 180 * MiB;
constexpr size_t WS_B = 352 * MiB;
constexpr size_t WS_C = 416 * MiB;
constexpr size_t WS_RT = 480 * MiB;
constexpr size_t WS_SSQ = 482 * MiB;
constexpr size_t WS_END = 484 * MiB;
constexpr size_t RT_TOKE = 0;
constexpr size_t RT_TOKW = RT_TOKE + (size_t)T * 2 * 4;
constexpr size_t RT_LRANK = RT_TOKW + (size_t)T * 2 * 4;
constexpr size_t RT_TOKSLOT = RT_LRANK + (size_t)T * 2 * 4;
constexpr size_t RT_BLKCNT = RT_TOKSLOT + (size_t)T * 2 * 4;
constexpr size_t RT_BLKBASE = RT_BLKCNT + 256 * 16 * 4;
constexpr size_t RT_SLOTTOK = RT_BLKBASE + 256 * 16 * 4;
constexpr size_t RT_SLOTW = RT_SLOTTOK + (size_t)MAXSLOT * 4;
constexpr size_t RT_META = RT_SLOTW + (size_t)MAXSLOT * 4;
static_assert(RT_META + 1024 * 4 <= 2 * MiB, "routing arrays");

__device__ __forceinline__ unsigned f2bf(float f) { unsigned u = __builtin_bit_cast(unsigned, f); return (u + 0x7fffu + ((u >> 16) & 1u)) >> 16; }
__device__ __forceinline__ float bf2f(unsigned h) { return __builtin_bit_cast(float, h << 16); }
__device__ __forceinline__ float bflo(unsigned w) { return __builtin_bit_cast(float, w << 16); }
__device__ __forceinline__ float bfhi(unsigned w) { return __builtin_bit_cast(float, w & 0xffff0000u); }
__device__ __forceinline__ float wave_sum(float v) {
#pragma unroll
    for (int o = 1; o < 64; o <<= 1) v += __shfl_xor(v, o);
    return v;
}
__device__ __forceinline__ float sigmoidf_(float v) { return 1.0f / (1.0f + __expf(-v)); }
__device__ __forceinline__ float sigmoid_fast(float v) { return __builtin_amdgcn_rcpf(1.0f + __builtin_amdgcn_exp2f(-LOG2E * v)); }

namespace nv {
__global__ __launch_bounds__(256) void ada_part(const float* __restrict__ c, const float* __restrict__ W, float* __restrict__ adap) {
    const int j = blockIdx.x * 256 + threadIdx.x, ks = blockIdx.y; constexpr int KS = D / ADA_SL;
    float a0 = 0.f, a1 = 0.f;
    for (int k = ks * KS; k < ks * KS + KS; ++k) { const float w = W[(size_t)k * NADA + j]; a0 += c[k] * w; a1 += c[D + k] * w; }
    adap[((size_t)ks * 2 + 0) * NADA + j] = a0; adap[((size_t)ks * 2 + 1) * NADA + j] = a1;
}
__global__ __launch_bounds__(256) void ada_sum(const float* __restrict__ adap, const float* __restrict__ bias, float* __restrict__ ada) {
    const int i = blockIdx.x * 256 + threadIdx.x;
    const int b = i / NADA, j = i % NADA; float s = bias[j];
    for (int ks = 0; ks < ADA_SL; ++ks) s += adap[((size_t)ks * 2 + b) * NADA + j];
    ada[i] = s;
}
__global__ __launch_bounds__(256) void h1(const float* __restrict__ x, const float* __restrict__ g1, const float* __restrict__ ada, bf16* __restrict__ H1) {
    const int lane = threadIdx.x & 63, row = blockIdx.x * 4 + (threadIdx.x >> 6), b = row / SEQ;
    const float4* xr = (const float4*)(x + (size_t)row * D) + lane;
    float4 v[8]; float ss = 0.f;
#pragma unroll
    for (int j = 0; j < 8; ++j) { v[j] = xr[64 * j]; ss += v[j].x * v[j].x + v[j].y * v[j].y + v[j].z * v[j].z + v[j].w * v[j].w; }
    const float rstd = rsqrtf(wave_sum(ss) * (1.0f / D) + EPS);
    const float* sh = ada + (size_t)b * NADA + 0 * D; const float* sc = ada + (size_t)b * NADA + 1 * D;
#pragma unroll
    for (int j = 0; j < 8; ++j) { const int d = 4 * lane + 256 * j;
        const float4 g = *(const float4*)(g1 + d), s = *(const float4*)(sc + d), h = *(const float4*)(sh + d);
        const float o0 = v[j].x * rstd * g.x * (1.f + s.x) + h.x, o1 = v[j].y * rstd * g.y * (1.f + s.y) + h.y;
        const float o2 = v[j].z * rstd * g.z * (1.f + s.z) + h.z, o3 = v[j].w * rstd * g.w * (1.f + s.w) + h.w;
        uint2 w; w.x = f2bf(o0) | (f2bf(o1) << 16); w.y = f2bf(o2) | (f2bf(o3) << 16);
        *(uint2*)(H1 + (size_t)row * D + d) = w; }
}
struct ABf16 { const bf16* A; long long lda; long long koff;
    __device__ bool init(int bm) { return true; }
    __device__ const bf16* rowptr(int m) const { return A + (size_t)m * lda + koff; } };
struct AGather { const bf16* A; long long lda; const int* slot_tok; const int* meta;
    __device__ bool init(int bm) { return bm < meta[17]; }
    __device__ const bf16* rowptr(int m) const { return A + (size_t)slot_tok[m] * lda; } };
struct ASlot { const bf16* A; long long lda; const int* meta;
    __device__ bool init(int bm) { return bm < meta[17]; }
    __device__ const bf16* rowptr(int m) const { return A + (size_t)m * lda; } };
struct WPlain { const float* W; long long ldw;
    __device__ const float* base(int bm) const { return W; } };
struct WExpert { const float* W; long long ldw; size_t estride; const int* meta;
    __device__ const float* base(int bm) const { return W + (size_t)meta[32 + (bm >> 8)] * estride; } };

template <bool DUAL, class AL, class WL, class EP>
__global__ __launch_bounds__(256) void gemm(AL al, WL wl, WL wl2, EP ep, long long K_) {
    const int K = (int)K_;
    __shared__ float As[16][68]; __shared__ float Ws[16][64]; __shared__ float Ws2[DUAL ? 16 : 1][64];
    const int tid = threadIdx.x, tx = tid & 15, ty = tid >> 4, bm = blockIdx.y * 64, bn = blockIdx.x * 64;
    if (!al.init(bm)) return;
    const float* Wb = wl.base(bm); const float* Wb2 = DUAL ? wl2.base(bm) : nullptr;
    const bf16* arow = al.rowptr(bm + (tid >> 2)); const int ak = (tid & 3) * 4;
    float acc[4][4], acc2[4][4];
#pragma unroll
    for (int i = 0; i < 4; ++i)
#pragma unroll
        for (int j = 0; j < 4; ++j) { acc[i][j] = 0.f; acc2[i][j] = 0.f; }
    for (int k0 = 0; k0 < K; k0 += 16) {
        const uint2 a = *(const uint2*)(arow + k0 + ak);
        As[ak + 0][tid >> 2] = bf2f(a.x & 0xffffu); As[ak + 1][tid >> 2] = bf2f(a.x >> 16); As[ak + 2][tid >> 2] = bf2f(a.y & 0xffffu); As[ak + 3][tid >> 2] = bf2f(a.y >> 16);
        *(float4*)&Ws[ty][tx * 4] = *(const float4*)(Wb + (size_t)(k0 + ty) * wl.ldw + bn + tx * 4);
        if (DUAL) *(float4*)&Ws2[ty][tx * 4] = *(const float4*)(Wb2 + (size_t)(k0 + ty) * wl.ldw + bn + tx * 4);
        __syncthreads();
#pragma unroll
        for (int kk = 0; kk < 16; ++kk) {
            const float4 av = *(const float4*)&As[kk][ty * 4]; const float4 wv = *(const float4*)&Ws[kk][tx * 4];
            const float a4[4] = {av.x, av.y, av.z, av.w}, w4[4] = {wv.x, wv.y, wv.z, wv.w};
#pragma unroll
            for (int i = 0; i < 4; ++i)
#pragma unroll
                for (int j = 0; j < 4; ++j) acc[i][j] += a4[i] * w4[j];
            if (DUAL) { const float4 wv2 = *(const float4*)&Ws2[kk][tx * 4]; const float u4[4] = {wv2.x, wv2.y, wv2.z, wv2.w};
#pragma unroll
                for (int i = 0; i < 4; ++i)
#pragma unroll
                    for (int j = 0; j < 4; ++j) acc2[i][j] += a4[i] * u4[j]; }
        }
        __syncthreads();
    }
#pragma unroll
    for (int i = 0; i < 4; ++i)
#pragma unroll
        for (int j = 0; j < 4; ++j) ep(bm + ty * 4 + i, bn + tx * 4 + j, acc[i][j], acc2[i][j]);
}
struct EpProj { bf16* P;
    __device__ void operator()(int m, int n, float v, float) const {
        if (n < C_K) v *= C2; else if (n >= C_GA) v = sigmoidf_(v);
        P[(size_t)m * NPROJ + n] = (bf16)f2bf(v); } };
struct EpPool { bf16* AP; const float* pool_scale; long long g;
    __device__ void operator()(int m, int n, float v, float) const { AP[(size_t)m * D + g * 256 + n] = (bf16)f2bf(v * pool_scale[g * 256 + n]); } };
struct EpT1 { bf16* T1; const bf16* P;
    __device__ void operator()(int m, int n, float v, float) const { T1[(size_t)m * D + n] = (bf16)f2bf(v * bf2f(P[(size_t)m * NPROJ + C_GP + n])); } };
struct EpMerged { bf16* T1; const bf16* P;
    __device__ void operator()(int m, int n, float v, float) const { const size_t o = (size_t)m * D + n; T1[o] = (bf16)f2bf(v * bf2f(P[(size_t)m * NPROJ + C_GA + n]) + bf2f(T1[o])); } };
struct EpX1 { float* X1; const float* x; const float* ada;
    __device__ void operator()(int m, int n, float v, float) const { const size_t o = (size_t)m * D + n; X1[o] = x[o] + ada[(size_t)(m / SEQ) * NADA + 2 * D + n] * v; } };
struct EpAct { bf16* ACT; const float* slot_w;
    __device__ void operator()(int m, int n, float g, float u) const { ACT[(size_t)m * FF + n] = (bf16)f2bf(g * sigmoidf_(g) * u * slot_w[m]); } };
struct EpY { bf16* Y;
    __device__ void operator()(int m, int n, float v, float) const { Y[(size_t)m * D + n] = (bf16)f2bf(v); } };

__global__ __launch_bounds__(256) void attn(const bf16* __restrict__ P, const float* __restrict__ sinks, bf16* __restrict__ AP) {
    __shared__ float Ps[16][129];
    const int tid = threadIdx.x, r = tid >> 4, part = tid & 15, h = blockIdx.y, b = blockIdx.z, kvh = h >> 2;
    const int t = blockIdx.x * 16 + r; const size_t rowq = (size_t)b * SEQ + t;
    uint4 q4[8];
#pragma unroll
    for (int c = 0; c < 8; ++c) q4[c] = *(const uint4*)(P + rowq * NPROJ + C_Q + h * 64 + c * 8);
    float s[8]; float mx = sinks[h] * LOG2E;
#pragma unroll
    for (int jj = 0; jj < 8; ++jj) { const int w = part + 16 * jj, kp = t - w; float dot = -1e30f;
        if (kp >= 0) { const bf16* kr = P + ((size_t)b * SEQ + kp) * NPROJ + C_K + kvh * 64; dot = 0.f;
#pragma unroll
            for (int c = 0; c < 8; ++c) { const uint4 k4 = *(const uint4*)(kr + c * 8);
                dot += bflo(q4[c].x) * bflo(k4.x) + bfhi(q4[c].x) * bfhi(k4.x) + bflo(q4[c].y) * bflo(k4.y) + bfhi(q4[c].y) * bfhi(k4.y)
                     + bflo(q4[c].z) * bflo(k4.z) + bfhi(q4[c].z) * bfhi(k4.z) + bflo(q4[c].w) * bflo(k4.w) + bfhi(q4[c].w) * bfhi(k4.w); } }
        s[jj] = dot; mx = fmaxf(mx, dot); }
    mx = fmaxf(mx, __shfl_xor(mx, 1)); mx = fmaxf(mx, __shfl_xor(mx, 2)); mx = fmaxf(mx, __shfl_xor(mx, 4)); mx = fmaxf(mx, __shfl_xor(mx, 8));
    float sum = 0.f;
#pragma unroll
    for (int jj = 0; jj < 8; ++jj) { const float p = exp2f(s[jj] - mx); sum += p; Ps[r][part + 16 * jj] = p; }
    sum += __shfl_xor(sum, 1); sum += __shfl_xor(sum, 2); sum += __shfl_xor(sum, 4); sum += __shfl_xor(sum, 8);
    sum += exp2f(sinks[h] * LOG2E - mx);
    __syncthreads();
    float o[4] = {0.f, 0.f, 0.f, 0.f};
    const int wmax = t < 127 ? t : 127;
    for (int w = 0; w <= wmax; ++w) { const float p = Ps[r][w]; const uint2 v2 = *(const uint2*)(P + ((size_t)b * SEQ + (t - w)) * NPROJ + C_V + kvh * 64 + part * 4);
        o[0] += p * bflo(v2.x); o[1] += p * bfhi(v2.x); o[2] += p * bflo(v2.y); o[3] += p * bfhi(v2.y); }
    const float inv = 1.0f / sum; uint2 w2; w2.x = f2bf(o[0] * inv) | (f2bf(o[1] * inv) << 16); w2.y = f2bf(o[2] * inv) | (f2bf(o[3] * inv) << 16);
    *(uint2*)(AP + rowq * D + 1024 + h * 64 + part * 4) = w2;
}
__global__ __launch_bounds__(256) void pooled(const bf16* __restrict__ P, bf16* __restrict__ PO) {
    const size_t idx = (size_t)blockIdx.x * 256 + threadIdx.x; const int row = (int)(idx >> 10), ch = (int)(idx & 1023), t = row % SEQ, g = ch >> 8, w = 2 << g;
    const int cnt = (t + 1) < w ? (t + 1) : w; float s = 0.f;
    for (int i = 0; i < cnt; ++i) s += bf2f(P[(size_t)(row - i) * NPROJ + C_U + ch]);
    PO[(size_t)row * 1024 + ch] = (bf16)f2bf(s / (float)cnt - bf2f(P[(size_t)row * NPROJ + C_U + ch]));
}
__global__ __launch_bounds__(256) void ssq(const float* __restrict__ X1, float* __restrict__ SSQ) {
    const int lane = threadIdx.x & 63, row = blockIdx.x * 4 + (threadIdx.x >> 6);
    const float* xr = X1 + (size_t)row * D;
    for (int p = 0; p < 32; ++p) { const float v = xr[64 * p + lane]; const float s = wave_sum(v * v); if (lane == 0) SSQ[(size_t)row * 32 + p] = s; }
}
}

__device__ __forceinline__ int route_row(const float* __restrict__ X1, const float* __restrict__ SSQ, const float* __restrict__ g2, const float* __restrict__ ada,
                                         const float* __restrict__ wrg, const float* __restrict__ brg, const float* __restrict__ wre, const float* __restrict__ bre,
                                         bf16* __restrict__ H2, int row, int lane, float& w1, float& w2) {
    const int b = row / SEQ;
    const float part = lane < 32 ? SSQ[(size_t)row * 32 + lane] : 0.f;
    const float rstd = rsqrtf(wave_sum(part) * (1.0f / D) + EPS);
    const float* sh = ada + (size_t)b * NADA + 3 * D; const float* sc = ada + (size_t)b * NADA + 4 * D;
    float acc[20];
#pragma unroll
    for (int o = 0; o < 20; ++o) acc[o] = 0.f;
#pragma unroll
    for (int j = 0; j < 8; ++j) { const int d = 4 * lane + 256 * j;
        const float4 xv = *(const float4*)(X1 + (size_t)row * D + d), g = *(const float4*)(g2 + d), s = *(const float4*)(sc + d), h = *(const float4*)(sh + d);
        const float hv[4] = {xv.x * rstd * g.x * (1.f + s.x) + h.x, xv.y * rstd * g.y * (1.f + s.y) + h.y, xv.z * rstd * g.z * (1.f + s.z) + h.z, xv.w * rstd * g.w * (1.f + s.w) + h.w};
        uint2 w; w.x = f2bf(hv[0]) | (f2bf(hv[1]) << 16); w.y = f2bf(hv[2]) | (f2bf(hv[3]) << 16);
        *(uint2*)(H2 + (size_t)row * D + d) = w;
#pragma unroll
        for (int e = 0; e < 4; ++e) { const float4 wg = *(const float4*)(wrg + (size_t)(d + e) * 4);
            acc[0] += hv[e] * wg.x; acc[1] += hv[e] * wg.y; acc[2] += hv[e] * wg.z; acc[3] += hv[e] * wg.w;
#pragma unroll
            for (int q = 0; q < 4; ++q) { const float4 we = *(const float4*)(wre + (size_t)(d + e) * 16 + q * 4);
                acc[4 + 4 * q] += hv[e] * we.x; acc[5 + 4 * q] += hv[e] * we.y; acc[6 + 4 * q] += hv[e] * we.z; acc[7 + 4 * q] += hv[e] * we.w; } } }
#pragma unroll
    for (int o = 0; o < 20; ++o) acc[o] = wave_sum(acc[o]);
    float gl[4]; int gi = 0;
#pragma unroll
    for (int o = 0; o < 4; ++o) gl[o] = acc[o] + brg[o];
#pragma unroll
    for (int o = 1; o < 4; ++o) if (gl[o] > gl[gi]) gi = o;
    float gsum = 0.f;
#pragma unroll
    for (int o = 0; o < 4; ++o) gsum += __expf(gl[o] - gl[gi]);
    const float gp = 1.0f / gsum;
    float el[4];
#pragma unroll
    for (int o = 0; o < 4; ++o) { float v = 0.f;
#pragma unroll
        for (int g = 0; g < 4; ++g) v = (g == gi) ? acc[4 + 4 * g + o] + bre[4 * g + o] : v;
        el[o] = v; }
    int i1 = 0;
#pragma unroll
    for (int o = 1; o < 4; ++o) if (el[o] > el[i1]) i1 = o;
    int i2 = (i1 == 0) ? 1 : 0;
#pragma unroll
    for (int o = 0; o < 4; ++o) if (o != i1 && el[o] > el[i2]) i2 = o;
    const float r = __expf(el[i2] - el[i1]);
    w1 = gp / (1.0f + r); w2 = gp * r / (1.0f + r);
    return (gi * 4 + i1) | ((gi * 4 + i2) << 8);
}
__device__ __forceinline__ int route_rows4(const float* __restrict__ X1, const float* __restrict__ SSQ, const float* __restrict__ g2, const float* __restrict__ ada,
                                           const float* __restrict__ wrg, const float* __restrict__ brg, const float* __restrict__ wre, const float* __restrict__ bre,
                                           bf16* __restrict__ H2, int row0, int lane, float& w1, float& w2) {
    typedef float f4 __attribute__((ext_vector_type(4)));
    const int b = row0 / SEQ;
    float rstd[4];
#pragma unroll
    for (int r = 0; r < 4; ++r) { const float part = lane < 32 ? SSQ[(size_t)(row0 + r) * 32 + lane] : 0.f; rstd[r] = rsqrtf(wave_sum(part) * (1.0f / D) + EPS); }
    const float* sh = ada + (size_t)b * NADA + 3 * D; const float* sc = ada + (size_t)b * NADA + 4 * D;
    float acc[4][20];
#pragma unroll
    for (int r = 0; r < 4; ++r)
#pragma unroll
        for (int o = 0; o < 20; ++o) acc[r][o] = 0.f;
#pragma unroll 1
    for (int j = 0; j < 8; ++j) { const int d = 4 * lane + 256 * j;
        const f4 g = *(const f4*)(g2 + d), s = *(const f4*)(sc + d), h = *(const f4*)(sh + d); const f4 gs = g * (1.f + s);
        f4 hv[4];
#pragma unroll
        for (int r = 0; r < 4; ++r) { const f4 xv = *(const f4*)(X1 + (size_t)(row0 + r) * D + d); hv[r] = xv * rstd[r] * gs + h;
            uint2 w; w.x = f2bf(hv[r].x) | (f2bf(hv[r].y) << 16); w.y = f2bf(hv[r].z) | (f2bf(hv[r].w) << 16); *(uint2*)(H2 + (size_t)(row0 + r) * D + d) = w; }
#pragma unroll
        for (int e = 0; e < 4; ++e) { const f4 wg = *(const f4*)(wrg + (size_t)(d + e) * 4);
            f4 we[4];
#pragma unroll
            for (int q = 0; q < 4; ++q) we[q] = *(const f4*)(wre + (size_t)(d + e) * 16 + q * 4);
#pragma unroll
            for (int r = 0; r < 4; ++r) { const float hx = hv[r][e];
                acc[r][0] += hx * wg.x; acc[r][1] += hx * wg.y; acc[r][2] += hx * wg.z; acc[r][3] += hx * wg.w;
#pragma unroll
                for (int q = 0; q < 4; ++q) { acc[r][4 + 4 * q] += hx * we[q].x; acc[r][5 + 4 * q] += hx * we[q].y; acc[r][6 + 4 * q] += hx * we[q].z; acc[r][7 + 4 * q] += hx * we[q].w; } } } }
    float t2[2][20], t1[20];
    { const bool up = (lane & 32) != 0;
#pragma unroll
        for (int r = 0; r < 2; ++r)
#pragma unroll
            for (int o = 0; o < 20; ++o) { const float keep = up ? acc[r + 2][o] : acc[r][o], send = up ? acc[r][o] : acc[r + 2][o]; t2[r][o] = keep + __shfl_xor(send, 32); } }
    { const bool up = (lane & 16) != 0;
#pragma unroll
        for (int o = 0; o < 20; ++o) { const float keep = up ? t2[1][o] : t2[0][o], send = up ? t2[0][o] : t2[1][o]; t1[o] = keep + __shfl_xor(send, 16); } }
#pragma unroll
    for (int o = 0; o < 20; ++o) { float v = t1[o]; v += __shfl_xor(v, 8); v += __shfl_xor(v, 4); v += __shfl_xor(v, 2); v += __shfl_xor(v, 1); t1[o] = v; }
    float gl[4]; int gi = 0;
#pragma unroll
    for (int o = 0; o < 4; ++o) gl[o] = t1[o] + brg[o];
#pragma unroll
    for (int o = 1; o < 4; ++o) if (gl[o] > gl[gi]) gi = o;
    float gsum = 0.f;
#pragma unroll
    for (int o = 0; o < 4; ++o) gsum += __expf(gl[o] - gl[gi]);
    const float gp = 1.0f / gsum;
    float el[4];
#pragma unroll
    for (int o = 0; o < 4; ++o) { float v = 0.f;
#pragma unroll
        for (int g = 0; g < 4; ++g) v = (g == gi) ? t1[4 + 4 * g + o] + bre[4 * g + o] : v;
        el[o] = v; }
    int i1 = 0;
#pragma unroll
    for (int o = 1; o < 4; ++o) if (el[o] > el[i1]) i1 = o;
    int i2 = (i1 == 0) ? 1 : 0;
#pragma unroll
    for (int o = 0; o < 4; ++o) if (o != i1 && el[o] > el[i2]) i2 = o;
    const float rr = __expf(el[i2] - el[i1]);
    w1 = gp / (1.0f + rr); w2 = gp * rr / (1.0f + rr);
    return (gi * 4 + i1) | ((gi * 4 + i2) << 8);
}
__device__ __forceinline__ void hist_wave(int e1, int e2, int lane, int blk, int* __restrict__ blkcnt, int& r1, int& r2) {
    const unsigned long long lt = (1ull << lane) - 1ull; r1 = 0; r2 = 0;
    for (int e = 0; e < NEXP; ++e) { const unsigned long long m1 = __ballot(e1 == e), m2 = __ballot(e2 == e);
        if (e1 == e) r1 = __popcll(m1 & lt); if (e2 == e) r2 = __popcll(m1) + __popcll(m2 & lt);
        if (lane == 0) blkcnt[blk * 16 + e] = __popcll(m1) + __popcll(m2); }
}
__device__ __forceinline__ void final_row(float* X1, const bf16* __restrict__ Y, const int* __restrict__ tokslot, const float* __restrict__ ada, const float* __restrict__ fg, int row, int lane, float* OUT = nullptr) {
    if (!OUT) OUT = X1;
    const int b = row / SEQ;
    const int s1 = tokslot[row * 2], s2 = tokslot[row * 2 + 1]; const float* g2 = ada + (size_t)b * NADA + 5 * D;
    float4 v[8]; float ss = 0.f;
#pragma unroll
    for (int j = 0; j < 8; ++j) { const int d = 4 * lane + 256 * j; const float4 xv = *(const float4*)(X1 + (size_t)row * D + d), g = *(const float4*)(g2 + d);
        const uint2 a = *(const uint2*)(Y + (size_t)s1 * D + d), c = *(const uint2*)(Y + (size_t)s2 * D + d);
        v[j].x = xv.x + g.x * (bflo(a.x) + bflo(c.x)); v[j].y = xv.y + g.y * (bfhi(a.x) + bfhi(c.x));
        v[j].z = xv.z + g.z * (bflo(a.y) + bflo(c.y)); v[j].w = xv.w + g.w * (bfhi(a.y) + bfhi(c.y));
        ss += v[j].x * v[j].x + v[j].y * v[j].y + v[j].z * v[j].z + v[j].w * v[j].w; }
    const float rstd = rsqrtf(wave_sum(ss) * (1.0f / D) + EPS);
#pragma unroll
    for (int j = 0; j < 8; ++j) { const int d = 4 * lane + 256 * j; const float4 g = *(const float4*)(fg + d);
        *(float4*)(OUT + (size_t)row * D + d) = make_float4(v[j].x * rstd * g.x, v[j].y * rstd * g.y, v[j].z * rstd * g.z, v[j].w * rstd * g.w); }
}
typedef unsigned fr_v2u __attribute__((ext_vector_type(2))); typedef float fr_f4 __attribute__((ext_vector_type(4)));
__device__ __forceinline__ void final_row_pos(const bf16* __restrict__ X1, float* __restrict__ OUT, const bf16* __restrict__ Y, const int* __restrict__ tokpos, const __attribute__((address_space(3))) int* offL, const float* __restrict__ ada, const float* __restrict__ fg, int row, int lane) {
    const int b = row / SEQ;
    const int p1 = tokpos[row * 2], p2 = tokpos[row * 2 + 1]; const int s1 = offL[p1 >> 14] + (p1 & 16383), s2 = offL[p2 >> 14] + (p2 & 16383); const float* g2 = ada + (size_t)b * NADA + 5 * D;
    float4 v[8]; float ss = 0.f;
#pragma unroll
    for (int j = 0; j < 8; ++j) { const int d = 4 * lane + 256 * j; const fr_v2u xb = __builtin_nontemporal_load((const fr_v2u*)(X1 + (size_t)row * D + d)); const float4 g = *(const float4*)(g2 + d);
        const fr_v2u a = __builtin_nontemporal_load((const fr_v2u*)(Y + (size_t)s1 * D + d)), c = __builtin_nontemporal_load((const fr_v2u*)(Y + (size_t)s2 * D + d));
        v[j].x = bflo(xb.x) + g.x * (bflo(a.x) + bflo(c.x)); v[j].y = bfhi(xb.x) + g.y * (bfhi(a.x) + bfhi(c.x));
        v[j].z = bflo(xb.y) + g.z * (bflo(a.y) + bflo(c.y)); v[j].w = bfhi(xb.y) + g.w * (bfhi(a.y) + bfhi(c.y));
        ss += v[j].x * v[j].x + v[j].y * v[j].y + v[j].z * v[j].z + v[j].w * v[j].w; }
    const float rstd = rsqrtf(wave_sum(ss) * (1.0f / D) + EPS);
#pragma unroll
    for (int j = 0; j < 8; ++j) { const int d = 4 * lane + 256 * j; const float4 g = *(const float4*)(fg + d);
        const fr_f4 ov = {v[j].x * rstd * g.x, v[j].y * rstd * g.y, v[j].z * rstd * g.z, v[j].w * rstd * g.w}; __builtin_nontemporal_store(ov, (fr_f4*)(OUT + (size_t)row * D + d)); }
}
namespace nv {
__global__ __launch_bounds__(256) void route(const float* X1, const float* SSQ, const float* g2, const float* ada, const float* wrg, const float* brg, const float* wre, const float* bre,
                                             bf16* H2, int* __restrict__ toke, float* __restrict__ tokw) {
    const int lane = threadIdx.x & 63, row = blockIdx.x * 4 + (threadIdx.x >> 6); float w1, w2;
    const int ee = route_row(X1, SSQ, g2, ada, wrg, brg, wre, bre, H2, row, lane, w1, w2);
    if (lane == 0) { toke[row * 2] = ee & 255; toke[row * 2 + 1] = ee >> 8; tokw[row * 2] = w1; tokw[row * 2 + 1] = w2; }
}
__global__ __launch_bounds__(64) void hist(const int* __restrict__ toke, int* __restrict__ blkcnt, int* __restrict__ lrank) {
    const int lane = threadIdx.x, tkn = blockIdx.x * 64 + lane; int r1, r2;
    hist_wave(toke[tkn * 2], toke[tkn * 2 + 1], lane, blockIdx.x, blkcnt, r1, r2);
    lrank[tkn * 2] = r1; lrank[tkn * 2 + 1] = r2;
}
__global__ __launch_bounds__(256) void scan(const int* __restrict__ blkcnt, int* __restrict__ blkbase, int* __restrict__ meta, int* __restrict__ slot_tok, float* __restrict__ slot_w) {
    __shared__ int cnt[16], off[17];
    const int tid = threadIdx.x;
    if (tid < 16) { int base = 0; for (int b = 0; b < 256; ++b) { blkbase[b * 16 + tid] = base; base += blkcnt[b * 16 + tid]; } cnt[tid] = base; }
    __syncthreads();
    if (tid == 0) { int o = 0, nt = 0; for (int e = 0; e < 16; ++e) { off[e] = o; meta[e] = o; const int tl = (cnt[e] + 255) >> 8; for (int i = 0; i < tl; ++i) meta[32 + nt++] = e; o += tl * 256; } off[16] = o; meta[16] = o; meta[17] = o; meta[18] = nt; }
    __syncthreads();
    for (int e = 0; e < 16; ++e) for (int s = off[e] + cnt[e] + tid; s < off[e + 1]; s += 256) { slot_tok[s] = 0; slot_w[s] = 0.f; }
}
__global__ __launch_bounds__(256) void fill(const int* __restrict__ toke, const float* __restrict__ tokw, const int* __restrict__ lrank, const int* __restrict__ blkbase, const int* __restrict__ meta,
                                            int* __restrict__ slot_tok, float* __restrict__ slot_w, int* __restrict__ tokslot) {
    const int i = blockIdx.x * 256 + threadIdx.x;
    const int tkn = i >> 1, e = toke[i], slot = meta[e] + blkbase[(tkn >> 6) * 16 + e] + lrank[i];
    slot_tok[slot] = tkn; slot_w[slot] = tokw[i]; tokslot[i] = slot;
}
__global__ __launch_bounds__(256) void final_(float* X1, const bf16* Y, const int* tokslot, const float* ada, const float* fg) {
    final_row(X1, Y, tokslot, ada, fg, blockIdx.x * 4 + (threadIdx.x >> 6), threadIdx.x & 63);
}
}

namespace pg8 {
#define PG8_LAS __attribute__((address_space(3)))
typedef unsigned short bf16_t;
typedef short bf16x8 __attribute__((ext_vector_type(8)));
typedef float f32x4 __attribute__((ext_vector_type(4)));
typedef unsigned u32x4 __attribute__((ext_vector_type(4)));
constexpr int BM = 256, BK = 64, HALF = 128, HTB = HALF * BK * 2, STAGE_BYTES = 8 * HTB, NXCD = 8, WGM = 8;
__host__ __device__ __forceinline__ int lds_byte(int r, int c) { const int st = (r >> 4) * 2 + (c >> 5), rr = r & 15, cc = c & 31, ob = rr * 64 + cc * 2; return st * 1024 + (ob ^ (((ob >> 9) & 1) << 5)); }
__host__ __device__ __forceinline__ void stage_rc(int b, int& R, int& C) { const int st = b / 1024, sb = b % 1024, swz = sb ^ (((sb >> 9) & 1) << 5); R = (st >> 1) * 16 + swz / 64; C = (st & 1) * 32 + (swz % 64) / 2; }
__host__ __device__ __forceinline__ int perm32(int rho) { const int n = rho >> 4, i = rho & 15; return 8 * (i >> 2) + 4 * n + (i & 3); }

struct Unit { int pm, pn, be; };
struct Gemm { const bf16_t* A; const bf16_t* Bt; int lda, ldb, K; size_t bstride; const int* rowidx; const PG8_LAS int* lm; };

struct StaticOrder {
    int nM, nN, nwg, G, c;
    __device__ void init(int M, int N, int G_, int c_) { nM = M / BM; nN = N / BM; nwg = nM * nN; G = G_; c = c_; }
    __device__ bool next(int i, Unit& u) const {
        const long L = (long)i * G + c; if (L >= nwg) return false;
        int wgid = (int)L; { const int q = nwg / NXCD, r = nwg % NXCD, xcd = wgid % NXCD, off = wgid / NXCD; wgid = (xcd < r ? xcd * (q + 1) : r * (q + 1) + (xcd - r) * q) + off; }
        const int nig = WGM * nN, gid = wgid / nig, fm = gid * WGM, gsz = (nM - fm) < WGM ? (nM - fm) : WGM;
        u.pm = fm + ((wgid % nig) % gsz); u.pn = (wgid % nig) / gsz; u.be = 0; return true;
    }
};
struct RowTileOrder { int nunits, G, c;
    __device__ bool next(int i, Unit& u) const { const int L = i * G + c; if (L >= nunits) return false; u.pm = L >> 3; u.pn = L & 7; u.be = 0; return true; } };
struct OneUnit { Unit u0; __device__ bool next(int i, Unit& u) const { if (i) return false; u = u0; return true; } };
struct DynOrder { int nunits, nN, G, c; const PG8_LAS int* tile_e;
    __device__ bool next(int i, Unit& u) const { const int L = i * G + c; if (L >= nunits) return false; u.pm = L / nN; u.pn = L % nN; u.be = tile_e[u.pm]; return true; } };

typedef int v4i_t __attribute__((ext_vector_type(4))); typedef int v8i_t __attribute__((ext_vector_type(8)));
__device__ __forceinline__ unsigned cvt_pk_bf16(float lo, float hi) { unsigned r; asm volatile("v_cvt_pk_bf16_f32 %0, %1, %2" : "=v"(r) : "v"(lo), "v"(hi)); return r; }
__device__ __forceinline__ u32x4 pack8(f32x4 v0, f32x4 v1) { u32x4 w; w.x = cvt_pk_bf16(v0[0], v0[1]); w.y = cvt_pk_bf16(v0[2], v0[3]); w.z = cvt_pk_bf16(v1[0], v1[1]); w.w = cvt_pk_bf16(v1[2], v1[3]); return w; }

__device__ __forceinline__ unsigned gate_pack4(f32x4 v) {
    unsigned r = 0;
#pragma unroll
    for (int i = 0; i < 4; ++i) { const unsigned q = (unsigned)__builtin_fmaf(sigmoid_fast(v[i]), 255.0f, 0.5f); r |= q << (8 * i); }
    return r;
}
__device__ __forceinline__ void gate_unpack8(unsigned lo, unsigned hi, f32x4& a, f32x4& b) {
    const float k = 1.0f / 255.0f;
    a[0] = (float)(lo & 255u) * k; a[1] = (float)((lo >> 8) & 255u) * k; a[2] = (float)((lo >> 16) & 255u) * k; a[3] = (float)(lo >> 24) * k;
    b[0] = (float)(hi & 255u) * k; b[1] = (float)((hi >> 8) & 255u) * k; b[2] = (float)((hi >> 16) & 255u) * k; b[3] = (float)(hi >> 24) * k;
}
__device__ __forceinline__ size_t acc_slot(int tile, int wid, int ai, int m, int bj, int lane) { return ((size_t)(tile * 8 + wid) * 16 + ((ai * 4 + m) * 2 + bj)) * 64 + lane; }
struct EpProj { static constexpr bool PERM = true; bf16_t* O; unsigned char* G8;
    __device__ __forceinline__ void operator()(const f32x4 (&acc)[2][2][4][2], const Unit& u, int wr, int wc, int fr, int fq) const {
        const int row0 = u.pm * BM + wr * 64 + fr, col0 = u.pn * BM + wc * 32 + 8 * fq; const int mode = u.pn < 4 ? 0 : (u.pn < 10 ? 1 : 2);
        typedef unsigned u32x2 __attribute__((ext_vector_type(2))); const int lane = fq * 16 + fr, wid = wr * 4 + wc;
        if (mode == 2) {
            const int gt = u.pm * 16 + (u.pn - 10);
#pragma unroll
            for (int ai = 0; ai < 2; ++ai)
#pragma unroll
                for (int m = 0; m < 4; ++m)
#pragma unroll
                    for (int bj = 0; bj < 2; ++bj) { u32x2 w; w.x = gate_pack4(acc[ai][bj][m][0]); w.y = gate_pack4(acc[ai][bj][m][1]);
                        __builtin_nontemporal_store(w, (u32x2*)(G8 + acc_slot(gt, wid, ai, m, bj, lane) * 8)); }
        } else {
            const float sc = mode == 0 ? C2 : 1.0f;
#pragma unroll
            for (int ai = 0; ai < 2; ++ai)
#pragma unroll
                for (int m = 0; m < 4; ++m) { bf16_t* rowb = O + (size_t)(row0 + ai * HALF + m * 16) * NPROJ;
#pragma unroll
                    for (int bj = 0; bj < 2; ++bj) *(u32x4*)(rowb + col0 + bj * HALF) = pack8(acc[ai][bj][m][0] * sc, acc[ai][bj][m][1] * sc); }
        }
    } };
struct EpProjI { static constexpr bool PERM = true; bf16_t* O; unsigned char* G8; const float* hs;
    __device__ __forceinline__ void operator()(const f32x4 (&acc)[2][2][4][2], const Unit& u, int wr, int wc, int fr, int fq) const {
        const int row0 = u.pm * BM + wr * 64 + fr, col0 = u.pn * BM + wc * 32 + 8 * fq; const int mode = u.pn < 4 ? 0 : (u.pn < 10 ? 1 : 2);
        typedef unsigned u32x2 __attribute__((ext_vector_type(2))); const int lane = fq * 16 + fr, wid = wr * 4 + wc;
        float rsc[2][4];
#pragma unroll
        for (int ai = 0; ai < 2; ++ai)
#pragma unroll
            for (int m = 0; m < 4; ++m) rsc[ai][m] = hs[row0 + ai * HALF + m * 16] * ((mode == 0 ? C2 : 1.0f) / SW_IN);
        auto cvt = [](f32x4 a, float f) { const v4i_t i = __builtin_bit_cast(v4i_t, a); f32x4 r = {(float)i[0] * f, (float)i[1] * f, (float)i[2] * f, (float)i[3] * f}; return r; };
        if (mode == 2) { int gt = u.pm * 16 + (u.pn - 10); asm volatile("" : "+s"(gt));
#pragma unroll
            for (int ai = 0; ai < 2; ++ai)
#pragma unroll
                for (int m = 0; m < 4; ++m)
#pragma unroll
                    for (int bj = 0; bj < 2; ++bj) { u32x2 w; w.x = gate_pack4(cvt(acc[ai][bj][m][0], rsc[ai][m])); w.y = gate_pack4(cvt(acc[ai][bj][m][1], rsc[ai][m]));
                        __builtin_nontemporal_store(w, (u32x2*)(G8 + acc_slot(gt, wid, ai, m, bj, lane) * 8)); }
        } else {
#pragma unroll
            for (int ai = 0; ai < 2; ++ai)
#pragma unroll
                for (int m = 0; m < 4; ++m) { bf16_t* rowb = O + (size_t)(row0 + ai * HALF + m * 16) * NPROJ;
#pragma unroll
                    for (int bj = 0; bj < 2; ++bj) *(u32x4*)(rowb + col0 + bj * HALF) = pack8(cvt(acc[ai][bj][m][0], rsc[ai][m]), cvt(acc[ai][bj][m][1], rsc[ai][m])); }
        }
    } };
struct EpGate { static constexpr bool PERM = true; unsigned char* G8;
    __device__ __forceinline__ void operator()(const f32x4 (&acc)[2][2][4][2], const Unit& u, int wr, int wc, int fr, int fq) const {
        typedef unsigned u32x2 __attribute__((ext_vector_type(2))); const int lane = fq * 16 + fr, wid = wr * 4 + wc; int gt = u.pm * 16 + u.pn; asm volatile("" : "+s"(gt));
#pragma unroll
        for (int ai = 0; ai < 2; ++ai)
#pragma unroll
            for (int m = 0; m < 4; ++m)
#pragma unroll
                for (int bj = 0; bj < 2; ++bj) { u32x2 w; w.x = gate_pack4(acc[ai][bj][m][0] * (1.0f / GATE_WSCALE)); w.y = gate_pack4(acc[ai][bj][m][1] * (1.0f / GATE_WSCALE));
                    __builtin_nontemporal_store(w, (u32x2*)(G8 + acc_slot(gt, wid, ai, m, bj, lane) * 8)); }
    } };
struct EpFold { static constexpr bool PERM = true; unsigned char* O;
    __device__ __forceinline__ void operator()(const f32x4 (&acc)[2][2][4][2], const Unit& u, int wr, int wc, int fr, int fq) const {
        typedef unsigned u32x2 __attribute__((ext_vector_type(2)));
        const int row0 = u.pm * BM + wr * 64 + fr, col0 = u.be * 256 + wc * 32 + 8 * fq;
        auto q4 = [](f32x4 v) { unsigned w = 0;
#pragma unroll
            for (int i = 0; i < 4; ++i) { const float t = fminf(fmaxf(v[i] * SW_BR, -127.f), 127.f); w |= ((unsigned)(int)rintf(t) & 255u) << (8 * i); } return w; };
#pragma unroll
        for (int ai = 0; ai < 2; ++ai)
#pragma unroll
            for (int m = 0; m < 4; ++m) { unsigned char* rowp = O + (size_t)(row0 + ai * HALF + m * 16) * 2048 + col0;
#pragma unroll
                for (int bj = 0; bj < 2; ++bj) { u32x2 w8; w8.x = q4(acc[ai][bj][m][0]); w8.y = q4(acc[ai][bj][m][1]); *(u32x2*)(rowp + bj * HALF) = w8; } }
    } };
__device__ __forceinline__ void unpack8(u32x4 w, f32x4& a, f32x4& b) { a[0] = bflo(w.x); a[1] = bfhi(w.x); a[2] = bflo(w.y); a[3] = bfhi(w.y); b[0] = bflo(w.z); b[1] = bfhi(w.z); b[2] = bflo(w.w); b[3] = bfhi(w.w); }
struct EpT1 { static constexpr bool PERM = true; bf16_t* T1p; const unsigned char* G8;
    __device__ __forceinline__ void operator()(const f32x4 (&acc)[2][2][4][2], const Unit& u, int wr, int wc, int fr, int fq) const {
        typedef unsigned u32x2 __attribute__((ext_vector_type(2))); const int lane = fq * 16 + fr, wid = wr * 4 + wc;
        u32x2 gw[2][4][2];
#pragma unroll
        for (int ai = 0; ai < 2; ++ai)
#pragma unroll
            for (int m = 0; m < 4; ++m)
#pragma unroll
                for (int bj = 0; bj < 2; ++bj) gw[ai][m][bj] = *(const u32x2*)(G8 + acc_slot(u.pm * 16 + 8 + u.pn, wid, ai, m, bj, lane) * 8);
#pragma unroll
        for (int ai = 0; ai < 2; ++ai)
#pragma unroll
            for (int m = 0; m < 4; ++m)
#pragma unroll
                for (int bj = 0; bj < 2; ++bj) { f32x4 g0, g1; gate_unpack8(gw[ai][m][bj].x, gw[ai][m][bj].y, g0, g1);
                    *(u32x4*)(T1p + acc_slot(u.pm * 8 + u.pn, wid, ai, m, bj, lane) * 8) = pack8(acc[ai][bj][m][0] * g0, acc[ai][bj][m][1] * g1); }
    } };
struct EpMerged { static constexpr bool PERM = true; bf16_t* M; const bf16_t* T1p; const unsigned char* G8;
    __device__ __forceinline__ void operator()(const f32x4 (&acc)[2][2][4][2], const Unit& u, int wr, int wc, int fr, int fq) const {
        const int row0 = u.pm * BM + wr * 64 + fr, col0 = u.pn * BM + wc * 32 + 8 * fq;
        typedef unsigned u32x2 __attribute__((ext_vector_type(2))); const int lane = fq * 16 + fr, wid = wr * 4 + wc;
#pragma unroll
        for (int ai = 0; ai < 2; ++ai) {
            u32x2 gw[4][2]; u32x4 tw[4][2];
#pragma unroll
            for (int m = 0; m < 4; ++m)
#pragma unroll
                for (int bj = 0; bj < 2; ++bj) { gw[m][bj] = *(const u32x2*)(G8 + acc_slot(u.pm * 16 + u.pn, wid, ai, m, bj, lane) * 8); tw[m][bj] = *(const u32x4*)(T1p + acc_slot(u.pm * 8 + u.pn, wid, ai, m, bj, lane) * 8); }
#pragma unroll
            for (int m = 0; m < 4; ++m)
#pragma unroll
                for (int bj = 0; bj < 2; ++bj) { const size_t r = (size_t)(row0 + ai * HALF + m * 16); f32x4 g0, g1, t0, t1; gate_unpack8(gw[m][bj].x, gw[m][bj].y, g0, g1); unpack8(tw[m][bj], t0, t1);
                    *(u32x4*)(M + r * D + col0 + bj * HALF) = pack8(acc[ai][bj][m][0] * g0 + t0, acc[ai][bj][m][1] * g1 + t1); }
            asm volatile("" ::: "memory"); }
    } };
struct EpMergedR { static constexpr bool PERM = true; bf16_t* M; const unsigned char* G8; unsigned* rmax; unsigned* rcnt; const float* as;
    __device__ __forceinline__ void mid(f32x4 (&acc)[2][2][4][2], const Unit& u, int wr, int wc, int fr, int fq) const {
        typedef unsigned u32x2 __attribute__((ext_vector_type(2))); const int lane = fq * 16 + fr, wid = wr * 4 + wc;
        int gt = u.pm * 16 + u.pn; asm volatile("" : "+s"(gt));
        u32x2 ga[2][4][2], gp[2][4][2];
#pragma unroll
        for (int ai = 0; ai < 2; ++ai)
#pragma unroll
            for (int m = 0; m < 4; ++m)
#pragma unroll
                for (int bj = 0; bj < 2; ++bj) { ga[ai][m][bj] = *(const u32x2*)(G8 + acc_slot(gt, wid, ai, m, bj, lane) * 8); gp[ai][m][bj] = __builtin_nontemporal_load((const u32x2*)(G8 + acc_slot(gt + 8, wid, ai, m, bj, lane) * 8)); }
#pragma unroll
        for (int ai = 0; ai < 2; ++ai)
#pragma unroll
            for (int m = 0; m < 4; ++m)
#pragma unroll
                for (int bj = 0; bj < 2; ++bj) {
#pragma unroll
                    for (int n = 0; n < 2; ++n) { const unsigned wa = n ? ga[ai][m][bj].y : ga[ai][m][bj].x, wp = n ? gp[ai][m][bj].y : gp[ai][m][bj].x;
                        v4i_t ci = __builtin_bit_cast(v4i_t, acc[ai][bj][m][n]);
#pragma unroll
                        for (int i = 0; i < 4; ++i) { const float qa = fmaxf((float)((wa >> (8 * i)) & 255u), 0.5f), qp = (float)((wp >> (8 * i)) & 255u); ci[i] = (int)rintf((float)ci[i] * (qp * __builtin_amdgcn_rcpf(qa))); }
                        acc[ai][bj][m][n] = __builtin_bit_cast(f32x4, ci); } }
        asm volatile("" ::: "memory");
    }
    __device__ __forceinline__ void operator()(const f32x4 (&acc)[2][2][4][2], const Unit& u, int wr, int wc, int fr, int fq) const {
        const int row0 = u.pm * BM + wr * 64 + fr, col0 = u.pn * BM + wc * 32 + 8 * fq;
        typedef unsigned u32x2 __attribute__((ext_vector_type(2))); const int lane = fq * 16 + fr, wid = wr * 4 + wc;
        u32x2 ga[2][4][2];
#pragma unroll
        for (int ai = 0; ai < 2; ++ai)
#pragma unroll
            for (int m = 0; m < 4; ++m)
#pragma unroll
                for (int bj = 0; bj < 2; ++bj) ga[ai][m][bj] = __builtin_nontemporal_load((const u32x2*)(G8 + acc_slot(u.pm * 16 + u.pn, wid, ai, m, bj, lane) * 8));
        auto gq = [](unsigned wa, int i) { return fmaxf((float)((wa >> (8 * i)) & 255u), 0.5f) * (1.0f / 255.0f); };
        float rowf[2][4];
#pragma unroll
        for (int ai = 0; ai < 2; ++ai)
#pragma unroll
            for (int m = 0; m < 4; ++m) rowf[ai][m] = as[row0 + ai * HALF + m * 16] * (1.0f / SW_BR);
#pragma unroll
        for (int ai = 0; ai < 2; ++ai)
#pragma unroll
            for (int m = 0; m < 4; ++m) { float mx = 0.f; const float rf = rowf[ai][m];
#pragma unroll
                for (int bj = 0; bj < 2; ++bj)
#pragma unroll
                    for (int n = 0; n < 2; ++n) { const unsigned wa = n ? ga[ai][m][bj].y : ga[ai][m][bj].x; const v4i_t ci = __builtin_bit_cast(v4i_t, acc[ai][bj][m][n]);
#pragma unroll
                        for (int i = 0; i < 4; ++i) mx = fmaxf(mx, fabsf((float)ci[i] * rf * gq(wa, i))); }
                mx = fmaxf(mx, __shfl_xor(mx, 16)); mx = fmaxf(mx, __shfl_xor(mx, 32));
                if (fq == 0) atomicMax(rmax + (row0 + ai * HALF + m * 16), __float_as_uint(mx)); }
        asm volatile("s_waitcnt vmcnt(0)" ::: "memory"); __builtin_amdgcn_s_barrier(); asm volatile("" ::: "memory");
        if (lane == 0 && wid == 0) { __hip_atomic_fetch_add(rcnt + u.pm, 1u, __ATOMIC_RELAXED, __HIP_MEMORY_SCOPE_AGENT);
            unsigned sp = 0; while (__hip_atomic_load(rcnt + u.pm, __ATOMIC_RELAXED, __HIP_MEMORY_SCOPE_AGENT) < 8u && ++sp < (1u << 18)) __builtin_amdgcn_s_sleep(1); }
        asm volatile("s_waitcnt vmcnt(0)" ::: "memory"); __builtin_amdgcn_s_barrier(); asm volatile("" ::: "memory");
        float rmv[2][4];
#pragma unroll
        for (int ai = 0; ai < 2; ++ai)
#pragma unroll
            for (int m = 0; m < 4; ++m) rmv[ai][m] = __uint_as_float(__hip_atomic_load(rmax + (row0 + ai * HALF + m * 16), __ATOMIC_RELAXED, __HIP_MEMORY_SCOPE_AGENT));
#pragma unroll
        for (int ai = 0; ai < 2; ++ai)
#pragma unroll
            for (int m = 0; m < 4; ++m) { const size_t r = (size_t)(row0 + ai * HALF + m * 16);
                const float rm = rmv[ai][m], inv = 127.0f / fmaxf(rm, 1e-20f);
#pragma unroll
                for (int bj = 0; bj < 2; ++bj) { u32x2 w8;
#pragma unroll
                    for (int n = 0; n < 2; ++n) { const unsigned wa = n ? ga[ai][m][bj].y : ga[ai][m][bj].x; unsigned w = 0; const v4i_t ci = __builtin_bit_cast(v4i_t, acc[ai][bj][m][n]);
#pragma unroll
                        for (int i = 0; i < 4; ++i) w |= ((unsigned)(int)rintf((float)ci[i] * rowf[ai][m] * gq(wa, i) * inv) & 255u) << (8 * i);
                        if (n) w8.y = w; else w8.x = w; }
                    *(u32x2*)((unsigned char*)M + r * D + col0 + bj * HALF) = w8; } }
    } };
struct EpX1 { static constexpr bool PERM = true; const float* x; bf16_t* X1; const float* ada; float* SSQ; const unsigned* rmax;
    __device__ __forceinline__ void operator()(const f32x4 (&acc)[2][2][4][2], const Unit& u, int wr, int wc, int fr, int fq) const {
        const int row0 = u.pm * BM + wr * 64 + fr, col0 = u.pn * BM + wc * 32 + 8 * fq; const float* g1 = ada + (size_t)(u.pm >> 5) * NADA + 2 * D;
        f32x4 gv[2][2];
#pragma unroll
        for (int bj = 0; bj < 2; ++bj)
#pragma unroll
            for (int n = 0; n < 2; ++n) gv[bj][n] = *(const f32x4*)(g1 + col0 + bj * HALF + 4 * n) * (1.0f / (127.0f * SW_IN));
        auto cvt = [](f32x4 a) { const v4i_t i = __builtin_bit_cast(v4i_t, a); f32x4 r = {(float)i[0], (float)i[1], (float)i[2], (float)i[3]}; return r; };
#pragma unroll
        for (int am = 0; am < 4; ++am) { const int ai = am >> 1, m0 = (am & 1) * 2;
            f32x4 xv[2][2][2]; float rsc[2];
#pragma unroll
            for (int mm = 0; mm < 2; ++mm) { rsc[mm] = __uint_as_float(__hip_atomic_load(rmax + (row0 + ai * HALF + (m0 + mm) * 16), __ATOMIC_RELAXED, __HIP_MEMORY_SCOPE_AGENT));
#pragma unroll
                for (int bj = 0; bj < 2; ++bj)
#pragma unroll
                    for (int n = 0; n < 2; ++n) xv[mm][bj][n] = __builtin_nontemporal_load((const f32x4*)(x + (size_t)(row0 + ai * HALF + (m0 + mm) * 16) * D + col0 + bj * HALF + 4 * n)); }
#pragma unroll
            for (int mm = 0; mm < 2; ++mm) { const int m = m0 + mm; const size_t r = (size_t)(row0 + ai * HALF + m * 16); float s = 0.f;
#pragma unroll
                for (int bj = 0; bj < 2; ++bj) { const f32x4 v0 = xv[mm][bj][0] + gv[bj][0] * (cvt(acc[ai][bj][m][0]) * rsc[mm]), v1 = xv[mm][bj][1] + gv[bj][1] * (cvt(acc[ai][bj][m][1]) * rsc[mm]);
                    *(u32x4*)(X1 + r * D + col0 + bj * HALF) = pack8(v0, v1);
                    s += ((v0[0] * v0[0] + v0[1] * v0[1]) + (v0[2] * v0[2] + v0[3] * v0[3])) + ((v1[0] * v1[0] + v1[1] * v1[1]) + (v1[2] * v1[2] + v1[3] * v1[3])); }
                s += __shfl_xor(s, 16); s += __shfl_xor(s, 32);
                if (fq == 0) SSQ[r * 32 + u.pn * 4 + wc] = s; }
            asm volatile("" ::: "memory"); }
    } };
struct EpAct { static constexpr bool PERM = true; unsigned char* ACT; const float* lw; const PG8_LAS int* lm; const float* ls; unsigned* amax; unsigned* acnt;
    __device__ __forceinline__ void operator()(const f32x4 (&acc_)[2][2][4][2], const Unit& u, int wr, int wc, int fr, int fq) const {
        f32x4 (&acc)[2][2][4][2] = const_cast<f32x4 (&)[2][2][4][2]>(acc_);
        typedef unsigned u32x2 __attribute__((ext_vector_type(2))); const int lane = fq * 16 + fr, wid = wr * 4 + wc;
        const int li0 = wr * 64 + fr, row0 = u.pm * BM + li0, col0 = u.pn * HALF + wc * 32 + 8 * fq;
        const int lt = u.pm - lm[208 + u.be], rb = u.be * 16384 + lt * BM, rc = lm[192 + u.be] - lt * BM;
        float wv[2][4], sv[2][4];
#pragma unroll
        for (int ai = 0; ai < 2; ++ai)
#pragma unroll
            for (int m = 0; m < 4; ++m) { const int li = li0 + ai * HALF + m * 16; const int lc = li < rc ? li : 0; wv[ai][m] = li < rc ? lw[rb + lc] : 0.f; sv[ai][m] = ls[rb + lc] * (1.0f / SW_IN); }
#pragma unroll
        for (int ai = 0; ai < 2; ++ai)
#pragma unroll
            for (int m = 0; m < 4; ++m) { const float w = wv[ai][m], sa = sv[ai][m]; float mx = 0.f;
#pragma unroll
                for (int n = 0; n < 2; ++n) { const v4i_t gi = __builtin_bit_cast(v4i_t, acc[ai][0][m][n]), ui = __builtin_bit_cast(v4i_t, acc[ai][1][m][n]); f32x4 o;
#pragma unroll
                    for (int i = 0; i < 4; ++i) { const float g = (float)gi[i] * sa, uu = (float)ui[i] * sa; o[i] = g * sigmoid_fast(g) * uu * w; mx = fmaxf(mx, fabsf(o[i])); }
                    acc[ai][0][m][n] = o; }
                mx = fmaxf(mx, __shfl_xor(mx, 16)); mx = fmaxf(mx, __shfl_xor(mx, 32));
                if (fq == 0) atomicMax(amax + (row0 + ai * HALF + m * 16), __float_as_uint(mx)); }
        asm volatile("s_waitcnt vmcnt(0)" ::: "memory"); __builtin_amdgcn_s_barrier(); asm volatile("" ::: "memory");
        if (lane == 0 && wid == 0) { __hip_atomic_fetch_add(acnt + u.pm, 1u, __ATOMIC_RELAXED, __HIP_MEMORY_SCOPE_AGENT);
            unsigned sp = 0; while (__hip_atomic_load(acnt + u.pm, __ATOMIC_RELAXED, __HIP_MEMORY_SCOPE_AGENT) < 4u && ++sp < (1u << 18)) __builtin_amdgcn_s_sleep(1); }
        asm volatile("s_waitcnt vmcnt(0)" ::: "memory"); __builtin_amdgcn_s_barrier(); asm volatile("" ::: "memory");
        float rmv[2][4];
#pragma unroll
        for (int ai = 0; ai < 2; ++ai)
#pragma unroll
            for (int m = 0; m < 4; ++m) rmv[ai][m] = __uint_as_float(__hip_atomic_load(amax + (row0 + ai * HALF + m * 16), __ATOMIC_RELAXED, __HIP_MEMORY_SCOPE_AGENT));
#pragma unroll
        for (int ai = 0; ai < 2; ++ai)
#pragma unroll
            for (int m = 0; m < 4; ++m) { const size_t r = (size_t)(row0 + ai * HALF + m * 16);
                const float rm = rmv[ai][m], inv = 127.0f / fmaxf(rm, 1e-20f); u32x2 w8;
#pragma unroll
                for (int n = 0; n < 2; ++n) { unsigned w = 0;
#pragma unroll
                    for (int i = 0; i < 4; ++i) w |= ((unsigned)(int)rintf(acc[ai][0][m][n][i] * inv) & 255u) << (8 * i);
                    if (n) w8.y = w; else w8.x = w; }
                *(u32x2*)(ACT + r * FF + col0) = w8; }
    } };
struct EpY { static constexpr bool PERM = true; bf16_t* Y; const unsigned* amax;
    __device__ __forceinline__ void operator()(const f32x4 (&acc)[2][2][4][2], const Unit& u, int wr, int wc, int fr, int fq) const {
        const int row0 = u.pm * BM + wr * 64 + fr, col0 = u.pn * BM + wc * 32 + 8 * fq;
        auto cvt = [](f32x4 a, float f) { const v4i_t i = __builtin_bit_cast(v4i_t, a); f32x4 r = {(float)i[0] * f, (float)i[1] * f, (float)i[2] * f, (float)i[3] * f}; return r; };
        float rsc[2][4];
#pragma unroll
        for (int ai = 0; ai < 2; ++ai)
#pragma unroll
            for (int m = 0; m < 4; ++m) rsc[ai][m] = __uint_as_float(__hip_atomic_load(amax + (row0 + ai * HALF + m * 16), __ATOMIC_RELAXED, __HIP_MEMORY_SCOPE_AGENT)) * (1.0f / (127.0f * SW_DN));
#pragma unroll
        for (int ai = 0; ai < 2; ++ai)
#pragma unroll
            for (int m = 0; m < 4; ++m) { bf16_t* rowp = Y + (size_t)(row0 + ai * HALF + m * 16) * D + col0;
#pragma unroll
                for (int bj = 0; bj < 2; ++bj) *(u32x4*)(rowp + bj * HALF) = pack8(cvt(acc[ai][bj][m][0], rsc[ai][m]), cvt(acc[ai][bj][m][1], rsc[ai][m])); }
    } };

__device__ __forceinline__ v8i_t cat8(bf16x8 x0, bf16x8 x1) { return __builtin_shufflevector(__builtin_bit_cast(v4i_t, x0), __builtin_bit_cast(v4i_t, x1), 0, 1, 2, 3, 4, 5, 6, 7); }
template <class Epi, class Sched, bool GATHER, bool MID = false, bool F8 = false, bool I8 = false>
__device__ __forceinline__ void gemm_phase(PG8_LAS unsigned char* lds, const Gemm g, const Sched& S, const Epi& E, int stagger = 0) {
    if (stagger > 0) { const unsigned long long t0 = __builtin_amdgcn_s_memrealtime(); const unsigned long long dl = (unsigned long long)stagger * (unsigned)blockIdx.x / gridDim.x;
        while (__builtin_amdgcn_s_memrealtime() - t0 < dl) __builtin_amdgcn_s_sleep(8); }
    const int tid = threadIdx.x, wid = __builtin_amdgcn_readfirstlane(tid >> 6), lane = tid & 63, wr = wid >> 2, wc = wid & 3, fr = lane & 15, fq = lane >> 4;
    int K = g.K; asm volatile("" : "+s"(K));
    const int nt = K / BK;
    int sR[2], sC[2]; unsigned voB[2], voA[2][2], voN[2][2];
#pragma unroll
    for (int i = 0; i < 2; ++i) { int R, C; stage_rc(tid * 16 + i * 8192, R, C); sR[i] = R; sC[i] = C; const int Rb = Epi::PERM ? ((R & ~31) + perm32(R & 31)) : R;
        voB[i] = (unsigned)(Rb * g.ldb + C) * 2u;
#pragma unroll
        for (int h = 0; h < 2; ++h) { voA[h][i] = (unsigned)((h * HALF + R) * g.lda + C) * 2u; voN[h][i] = voA[h][i]; } }
    const size_t kstep = (size_t)(BK * 2);
    const size_t hstepB = (size_t)HALF * g.ldb * 2, tstepA = (size_t)BM * g.lda * 2, tstepB = (size_t)BM * g.ldb * 2;
    const unsigned ldsw = (unsigned)wid * 1024u;
    const int aoff = lds_byte(wr * 64 + fr, fq * 8), boff = lds_byte(wc * 32 + fr, fq * 8);
#define PG8_SA(b, h) (((b) * 2 + (h)) * HTB)
#define PG8_SB(b, h) ((4 + (b) * 2 + (h)) * HTB)
#define PG8_STAGE(bufoff, gbase, voff) do { _Pragma("unroll") for (int _i = 0; _i < 2; ++_i) \
        __builtin_amdgcn_global_load_lds((const unsigned*)((const char*)(gbase) + (voff)[_i]), (PG8_LAS unsigned*)(lds + (bufoff) + ldsw + _i * 8192), 16, 0, 0); } while (0)
#define PG8_LDA(dst, b, h) do { if constexpr (F8) { _Pragma("unroll") for (int m = 0; m < 4; ++m) { dst##8[m].lo = *(const PG8_LAS v4i_t*)(lds + PG8_SA(b, h) + aoff + m * 2048); dst##8[m].hi = *(const PG8_LAS v4i_t*)(lds + PG8_SA(b, h) + aoff + m * 2048 + 1024); } } \
        else { _Pragma("unroll") for (int m = 0; m < 4; ++m) _Pragma("unroll") for (int k = 0; k < 2; ++k) dst[m][k] = *(const PG8_LAS bf16x8*)(lds + PG8_SA(b, h) + aoff + m * 2048 + k * 1024); } } while (0)
#define PG8_LDB(dst, b, h) do { if constexpr (F8) { _Pragma("unroll") for (int n = 0; n < 2; ++n) { dst##8[n].lo = *(const PG8_LAS v4i_t*)(lds + PG8_SB(b, h) + boff + n * 2048); dst##8[n].hi = *(const PG8_LAS v4i_t*)(lds + PG8_SB(b, h) + boff + n * 2048 + 1024); } } \
        else { _Pragma("unroll") for (int n = 0; n < 2; ++n) _Pragma("unroll") for (int k = 0; k < 2; ++k) dst[n][k] = *(const PG8_LAS bf16x8*)(lds + PG8_SB(b, h) + boff + n * 2048 + k * 1024); } } while (0)
#define PG8_MMA(ai, bj, At, Bt) do { __builtin_amdgcn_s_setprio(1); \
        if constexpr (F8) { _Pragma("unroll") for (int m = 0; m < 4; ++m) _Pragma("unroll") for (int n = 0; n < 2; ++n) \
            asm volatile("v_mfma_f32_16x16x128_f8f6f4 %0, %1, %2, %0" : "+v"(acc[ai][bj][m][n]) : "v"(Bt##8[n]), "v"(At##8[m])); }   \
        else if constexpr (I8) { _Pragma("unroll") for (int m = 0; m < 4; ++m) _Pragma("unroll") for (int n = 0; n < 2; ++n) _Pragma("unroll") for (int k = 0; k < 2; ++k) \
            acc[ai][bj][m][n] = __builtin_bit_cast(f32x4, __builtin_amdgcn_mfma_i32_16x16x64_i8(__builtin_bit_cast(v4i_t, Bt[n][k]), __builtin_bit_cast(v4i_t, At[m][k]), __builtin_bit_cast(v4i_t, acc[ai][bj][m][n]), 0, 0, 0)); } \
        else { _Pragma("unroll") for (int m = 0; m < 4; ++m) _Pragma("unroll") for (int n = 0; n < 2; ++n) _Pragma("unroll") for (int k = 0; k < 2; ++k) \
            acc[ai][bj][m][n] = __builtin_amdgcn_mfma_f32_16x16x32_bf16(Bt[n][k], At[m][k], acc[ai][bj][m][n], 0, 0, 0); } \
        __builtin_amdgcn_s_setprio(0); } while (0)
#define PG8_WAIT_V(n) asm volatile("s_waitcnt vmcnt(" #n ")" ::: "memory")
#define PG8_WAIT_L(n) asm volatile("s_waitcnt lgkmcnt(" #n ")" ::: "memory")
#define PG8_BAR __builtin_amdgcn_s_barrier()
#define PG8_SCHED __builtin_amdgcn_sched_barrier(0)
#define PG8_GATHER_OFFS(dst, u_) do { const int _e = (u_).be, _lt = (u_).pm - g.lm[208 + _e], _rb = _e * 16384 + _lt * BM, _rc = g.lm[192 + _e] - _lt * BM;     \
        int _ri[2][2];     \
        _Pragma("unroll") for (int _h = 0; _h < 2; ++_h) _Pragma("unroll") for (int _i = 0; _i < 2; ++_i) { const int _ix = _h * HALF + sR[_i]; _ri[_h][_i] = g.rowidx[_rb + (_ix < _rc ? _ix : 0)]; } \
        _Pragma("unroll") for (int _h = 0; _h < 2; ++_h) _Pragma("unroll") for (int _i = 0; _i < 2; ++_i) { const int _ix = _h * HALF + sR[_i]; \
            dst[_h][_i] = (unsigned)((_ix < _rc ? _ri[_h][_i] : 0) * g.lda + sC[_i]) * 2u; } \
        __builtin_amdgcn_s_waitcnt(0x0F70); _Pragma("unroll") for (int _h = 0; _h < 2; ++_h) _Pragma("unroll") for (int _i = 0; _i < 2; ++_i) asm volatile("" : "+v"(dst[_h][_i])); } while (0)
    Unit cur, nxt; int ui = 0;
    if (!S.next(0, cur)) return;
    f32x4 acc[2][2][4][2];
#pragma unroll
    for (int a = 0; a < 2; ++a)
#pragma unroll
        for (int b = 0; b < 2; ++b)
#pragma unroll
            for (int m = 0; m < 4; ++m)
#pragma unroll
                for (int n = 0; n < 2; ++n) acc[a][b][m][n] = (f32x4){0.f, 0.f, 0.f, 0.f};
    bf16x8 At[4][2], B0[2][2], B1[2][2]; v8i_t At8[4], B08[2], B18[2];
    const char* cA = (const char*)g.A + (GATHER ? (size_t)0 : (size_t)cur.pm * tstepA);
    const char* cB = (const char*)g.Bt + ((size_t)cur.be * g.bstride) * 2 + (size_t)cur.pn * tstepB;
    if constexpr (GATHER) PG8_GATHER_OFFS(voA, cur);
    PG8_STAGE(PG8_SB(0, 0), cB, voB); PG8_STAGE(PG8_SB(0, 1), cB + hstepB, voB); PG8_STAGE(PG8_SA(0, 0), cA, voA[0]); PG8_STAGE(PG8_SA(0, 1), cA, voA[1]);
    if (wr == 1) PG8_BAR;
    PG8_WAIT_V(2); PG8_BAR;
    PG8_STAGE(PG8_SB(1, 0), cB + kstep, voB); PG8_STAGE(PG8_SA(1, 0), cA + kstep, voA[0]); PG8_STAGE(PG8_SB(1, 1), cB + hstepB + kstep, voB);
    PG8_WAIT_V(6); PG8_BAR;
    for (;;) {
        const bool has_next = S.next(ui + 1, nxt);
        const char* nA = has_next ? (const char*)g.A + (GATHER ? (size_t)0 : (size_t)nxt.pm * tstepA) : cA;
        const char* nB = has_next ? (const char*)g.Bt + ((size_t)nxt.be * g.bstride) * 2 + (size_t)nxt.pn * tstepB : cB;
        if constexpr (GATHER) { if (has_next) PG8_GATHER_OFFS(voN, nxt); else {
#pragma unroll
            for (int h = 0; h < 2; ++h)
#pragma unroll
                for (int i = 0; i < 2; ++i) voN[h][i] = voA[h][i]; } }
        for (int t = 0; t < nt; t += 2) {
            const bool last = (t == nt - 2);
            if constexpr (MID) { if (t == (nt >> 1)) E.mid(acc, cur, wr, wc, fr, fq); }
            const char* a1 = cA + (size_t)(t + 1) * kstep;
            const char* a2 = last ? nA : cA + (size_t)(t + 2) * kstep; const char* b2 = last ? nB : cB + (size_t)(t + 2) * kstep;
            const char* a3 = a2 + kstep; const char* b3 = b2 + kstep;
            unsigned vo2[2][2];
#pragma unroll
            for (int h = 0; h < 2; ++h)
#pragma unroll
                for (int i = 0; i < 2; ++i) vo2[h][i] = (GATHER && last) ? voN[h][i] : voA[h][i];
            PG8_LDB(B0, 0, 0); PG8_LDB(B1, 0, 1); PG8_SCHED; PG8_LDA(At, 0, 0); PG8_STAGE(PG8_SA(1, 1), a1, voA[1]);
            PG8_WAIT_V(8); PG8_WAIT_L(0); PG8_BAR; PG8_MMA(0, 0, At, B0); PG8_MMA(0, 1, At, B1); PG8_BAR; PG8_SCHED;
            PG8_LDA(At, 0, 1); PG8_STAGE(PG8_SB(0, 0), b2, voB); PG8_STAGE(PG8_SB(0, 1), b2 + hstepB, voB); PG8_STAGE(PG8_SA(0, 0), a2, vo2[0]);
            PG8_WAIT_V(8); PG8_WAIT_L(0); PG8_BAR; PG8_MMA(1, 0, At, B0); PG8_MMA(1, 1, At, B1); PG8_BAR; PG8_SCHED;
            PG8_LDB(B0, 1, 0); PG8_LDB(B1, 1, 1); PG8_SCHED; PG8_LDA(At, 1, 0); PG8_STAGE(PG8_SA(0, 1), a2, vo2[1]);
            PG8_WAIT_V(8); PG8_WAIT_L(0); PG8_BAR; PG8_MMA(0, 0, At, B0); PG8_MMA(0, 1, At, B1); PG8_BAR; PG8_SCHED;
            PG8_LDA(At, 1, 1); PG8_STAGE(PG8_SB(1, 0), b3, voB); PG8_STAGE(PG8_SB(1, 1), b3 + hstepB, voB); PG8_STAGE(PG8_SA(1, 0), a3, vo2[0]);
            PG8_WAIT_V(8); PG8_WAIT_L(0); PG8_BAR; PG8_MMA(1, 0, At, B0); PG8_MMA(1, 1, At, B1); PG8_BAR; PG8_SCHED;
        }
        if (wr == 0) PG8_BAR;
        E(acc, cur, wr, wc, fr, fq);
        if (!has_next) break;
#pragma unroll
        for (int a = 0; a < 2; ++a)
#pragma unroll
            for (int b = 0; b < 2; ++b)
#pragma unroll
                for (int m = 0; m < 4; ++m)
#pragma unroll
                    for (int n = 0; n < 2; ++n) acc[a][b][m][n] = (f32x4){0.f, 0.f, 0.f, 0.f};
        cur = nxt; cA = nA; cB = nB; ++ui;
        if constexpr (GATHER) {
#pragma unroll
            for (int h = 0; h < 2; ++h)
#pragma unroll
                for (int i = 0; i < 2; ++i) voA[h][i] = voN[h][i]; }
        if (wr == 1) PG8_BAR;
    }
    PG8_WAIT_V(0);
    PG8_BAR;
#undef PG8_SA
#undef PG8_SB
#undef PG8_STAGE
#undef PG8_LDA
#undef PG8_LDB
#undef PG8_MMA
#undef PG8_WAIT_V
#undef PG8_WAIT_L
#undef PG8_BAR
#undef PG8_SCHED
#undef PG8_GATHER_OFFS
}
}

#define GAS __attribute__((address_space(1)))
#define LAS __attribute__((address_space(3)))
typedef unsigned v4u __attribute__((ext_vector_type(4)));
typedef unsigned v2u __attribute__((ext_vector_type(2)));
typedef float f32x4 __attribute__((ext_vector_type(4)));
typedef float f32x16 __attribute__((ext_vector_type(16)));
typedef short bf16x8 __attribute__((ext_vector_type(8)));
typedef short s16x4 __attribute__((ext_vector_type(4)));
typedef GAS unsigned gu32;
#define RLX_AGENT __ATOMIC_RELAXED, __HIP_MEMORY_SCOPE_AGENT
#define LDS_WAIT() asm volatile("s_waitcnt lgkmcnt(0)" ::: "memory")
#define VM_WAIT() asm volatile("s_waitcnt vmcnt(0)" ::: "memory")
constexpr int NWAVES = 8;
constexpr int STG_P1 = 0, STG_P3A = 0, STG_P3B = 0, STG_P4 = 0, STG_P7 = 0;
constexpr int RING_OFF = 0, RING_BYTES = 131072;
constexpr int LDSCTL_OFF = 139264;
constexpr int MISC_OFF = LDSCTL_OFF + 64;
constexpr int LMETA_OFF = LDSCTL_OFF + 256;
constexpr int LDS_BYTES = 147456;
constexpr int CW_AMAX = 131072, CW_ACNT = 180224;
constexpr int CW_RMAX = 65536, CW_RCNT = 98304;
constexpr int CW_TMO = 0, CW_BAR = 4096, CW_CNT = 8192;

#define XB_TMO      128
#define XB_XCNT(j)  (256  + 64 * (j))
#define XB_XSUB(j)  (1280 + 64 * (j))
#define XB_XGEN(j)  (2304 + 64 * (j))
#define XB_TOP      3328
#define XB_TOPGEN   3392
#define XCD_BAR_WORDS 3456
#define XB_SPIN_CAP (1u << 18)
__device__ __forceinline__ unsigned xb_ld(unsigned* p)              { return __hip_atomic_load(p, __ATOMIC_RELAXED, __HIP_MEMORY_SCOPE_AGENT); }
__device__ __forceinline__ unsigned xb_add(unsigned* p, unsigned v) { return __hip_atomic_fetch_add(p, v, __ATOMIC_RELAXED, __HIP_MEMORY_SCOPE_AGENT); }
__device__ __forceinline__ unsigned xb_xcc_id() { return (unsigned)__builtin_amdgcn_s_getreg((3 << 11) | 20) & 0xFu; }
#define XB_SPIN(cond, bar) do { unsigned _sp = 0; while (cond) { __builtin_amdgcn_s_sleep(1); \
    if ((++_sp & 255u) == 0u) { if (xb_ld(&(bar)[XB_TMO])) break; if (_sp > XB_SPIN_CAP) { atomicAdd(&(bar)[XB_TMO], 1u); break; } } } } while (0)
struct XcdBarrier { unsigned* bar; unsigned x; volatile LAS unsigned* st; };
__device__ __forceinline__ XcdBarrier xcd_barrier_post(unsigned* bar, volatile LAS unsigned* st) {
    XcdBarrier b; b.bar = bar; b.x = xb_xcc_id(); b.st = st;
    if (threadIdx.x == 0) (void)xb_add(&bar[XB_XCNT(b.x)], 1u);
    return b;
}
__device__ __forceinline__ void xcd_barrier_complete(unsigned* bar, unsigned x, unsigned& nloc, unsigned& nx) {
    const unsigned G = gridDim.x * gridDim.y * gridDim.z;
    unsigned sum, cnt, mine, sp = 0u;
    for (;;) {
        sum = 0u; cnt = 0u; mine = 0u;
#pragma unroll
        for (unsigned j = 0; j < 16; ++j) { const unsigned c = xb_ld(&bar[XB_XCNT(j)]); sum += c; cnt += (c > 0u) ? 1u : 0u; mine = (j == x) ? c : mine; }
        if (sum == G) break;
        __builtin_amdgcn_s_sleep(1);
        if ((++sp & 255u) == 0u) { if (xb_ld(&bar[XB_TMO])) break; if (sp > XB_SPIN_CAP) { atomicAdd(&bar[XB_TMO], 1u); break; } }
    }
    nloc = mine > 0u ? mine : 1u; nx = cnt > 0u ? cnt : 1u;
}
__device__ __forceinline__ void xcd_barrier(const XcdBarrier& b) {
    asm volatile("s_waitcnt vmcnt(0)" ::: "memory");
    __syncthreads();
    if (threadIdx.x == 0) {
        unsigned* bar = b.bar;
        __builtin_amdgcn_s_waitcnt(0);
        unsigned nloc = b.st[0], nx = b.st[1];
        if (nloc == 0u) { xcd_barrier_complete(bar, b.x, nloc, nx); b.st[0] = nloc; b.st[1] = nx; }
        const unsigned old = xb_add(&bar[XB_XSUB(b.x)], 1u);
        const unsigned gen = old / nloc;
        if (old + 1u == (gen + 1u) * nloc) {
            __builtin_amdgcn_fence(__ATOMIC_RELEASE, "agent");
            asm volatile("s_waitcnt vmcnt(0)" ::: "memory");
            const unsigned og = xb_add(&bar[XB_TOP], 1u);
            const unsigned tg = og / nx;
            if (og + 1u == (tg + 1u) * nx) xb_add(&bar[XB_TOPGEN], 1u);
            else XB_SPIN(xb_ld(&bar[XB_TOPGEN]) == tg, bar);
            __builtin_amdgcn_fence(__ATOMIC_ACQUIRE, "agent");
            xb_add(&bar[XB_XGEN(b.x)], 1u);
            asm volatile("s_waitcnt vmcnt(0)" ::: "memory");
        } else {
            XB_SPIN(xb_ld(&bar[XB_XGEN(b.x)]) == gen, bar);
            __builtin_amdgcn_fence(__ATOMIC_ACQUIRE, "agent");
            asm volatile("s_waitcnt vmcnt(0)" ::: "memory");
        }
    }
    __syncthreads();
}

struct Args { const float* in[21]; float* out; unsigned char* ws; int ph_lo, ph_hi; };
typedef const __attribute__((address_space(4))) Args* KArgs;
struct Frame {
    LAS unsigned char* lds; volatile LAS unsigned* MISC; LAS int* LM; gu32* ctl;
    int vcu, G;
    KArgs ka;
    __device__ __forceinline__ int tid() const { int t = threadIdx.x; asm volatile("" : "+v"(t)); return t; }
    __device__ __forceinline__ int lane() const { return tid() & 63; }
    __device__ __forceinline__ int wave() const { return __builtin_amdgcn_readfirstlane(tid() >> 6); }
    float* out; unsigned char* ws;
    __device__ __forceinline__ const float* x() const { return ka->in[0]; }
    __device__ __forceinline__ const float* c() const { return ka->in[1]; }
    __device__ __forceinline__ const float* w_ada() const { return ka->in[2]; }
    __device__ __forceinline__ const float* b_ada() const { return ka->in[3]; }
    __device__ __forceinline__ const float* g1() const { return ka->in[4]; }
    __device__ __forceinline__ const float* w_in() const { return ka->in[5]; }
    __device__ __forceinline__ const float* sinks() const { return ka->in[6]; }
    __device__ __forceinline__ const float* w_pool() const { return ka->in[7]; }
    __device__ __forceinline__ const float* pool_scale() const { return ka->in[8]; }
    __device__ __forceinline__ const float* w_ab() const { return ka->in[9]; }
    __device__ __forceinline__ const float* w_pb() const { return ka->in[10]; }
    __device__ __forceinline__ const float* w_out() const { return ka->in[11]; }
    __device__ __forceinline__ const float* g2() const { return ka->in[12]; }
    __device__ __forceinline__ const float* w_rg() const { return ka->in[13]; }
    __device__ __forceinline__ const float* b_rg() const { return ka->in[14]; }
    __device__ __forceinline__ const float* w_re() const { return ka->in[15]; }
    __device__ __forceinline__ const float* b_re() const { return ka->in[16]; }
    __device__ __forceinline__ const float* w_eg() const { return ka->in[17]; }
    __device__ __forceinline__ const float* w_eu() const { return ka->in[18]; }
    __device__ __forceinline__ const float* w_ed() const { return ka->in[19]; }
    __device__ __forceinline__ const float* fg() const { return ka->in[20]; }
};

__device__ __forceinline__ unsigned pk2(float lo, float hi) { return pg8::cvt_pk_bf16(lo, hi); }
struct P0Item { const float* W; bf16* WT; int N, dpitch, drow0, k0, n0, dk, f8; };
__device__ __forceinline__ void p0_item_load(const P0Item& I, f32x4 (&a)[8], f32x4 (&b)[8], int lane) {
    const int nq = lane & 15, kr = lane >> 4;
#pragma unroll
    for (int it = 0; it < 8; ++it) { const float* p = I.W + (size_t)(I.k0 + 8 * it + 2 * kr) * I.N + I.n0 + 4 * nq; a[it] = __builtin_nontemporal_load((const GAS f32x4*)p); b[it] = __builtin_nontemporal_load((const GAS f32x4*)(p + I.N)); }
}
__device__ __forceinline__ int q_i8(float v) { const int q = (int)rintf(v); return q < -127 ? -127 : (q > 127 ? 127 : q); }
__device__ __forceinline__ unsigned pk_i8(float lo, float hi) { return ((unsigned)q_i8(lo) & 255u) | (((unsigned)q_i8(hi) & 255u) << 8); }
__device__ __forceinline__ void p0_item_store_f8(const P0Item& I, const f32x4 (&a)[8], const f32x4 (&b)[8], LAS unsigned* scr, int lane) {
    LAS unsigned short* s16 = (LAS unsigned short*)scr; const int nq = lane & 15, kr = lane >> 4; constexpr float S = GATE_WSCALE;
#pragma unroll
    for (int it = 0; it < 8; ++it) { LAS unsigned short* d = s16 + (4 * it + kr) * 66 + 4 * nq;
        if (I.f8 >= 2) { const float si = I.f8 == 3 ? SW_DN : (I.f8 == 4 ? SW_BR : SW_IN); d[0] = (unsigned short)pk_i8(a[it].x * si, b[it].x * si); d[1] = (unsigned short)pk_i8(a[it].y * si, b[it].y * si); d[2] = (unsigned short)pk_i8(a[it].z * si, b[it].z * si); d[3] = (unsigned short)pk_i8(a[it].w * si, b[it].w * si); }
        else {
        d[0] = (unsigned short)__builtin_amdgcn_cvt_pk_fp8_f32(a[it].x * S, b[it].x * S, 0, false); d[1] = (unsigned short)__builtin_amdgcn_cvt_pk_fp8_f32(a[it].y * S, b[it].y * S, 0, false);
        d[2] = (unsigned short)__builtin_amdgcn_cvt_pk_fp8_f32(a[it].z * S, b[it].z * S, 0, false); d[3] = (unsigned short)__builtin_amdgcn_cvt_pk_fp8_f32(a[it].w * S, b[it].w * S, 0, false); } }
    LDS_WAIT(); asm volatile("" ::: "memory");
    const int c = lane & 3, nl = lane >> 2;
#pragma unroll
    for (int j = 0; j < 4; ++j) { const int n = nl + 16 * j; const LAS unsigned short* sp = s16 + (8 * c) * 66 + n;
        v4u o; o.x = (unsigned)sp[0] | ((unsigned)sp[66] << 16); o.y = (unsigned)sp[132] | ((unsigned)sp[198] << 16); o.z = (unsigned)sp[264] | ((unsigned)sp[330] << 16); o.w = (unsigned)sp[396] | ((unsigned)sp[462] << 16);
        *(GAS v4u*)((unsigned char*)I.WT + (size_t)(I.drow0 + n) * I.dpitch + I.k0 + I.dk + 16 * c) = o; }
    LDS_WAIT(); asm volatile("" ::: "memory");
}
__device__ __forceinline__ void p0_item_store(const P0Item& I, const f32x4 (&a)[8], const f32x4 (&b)[8], LAS unsigned* scr, int lane) {
    if (I.f8) { p0_item_store_f8(I, a, b, scr, lane); return; }
    const int nq = lane & 15, kr = lane >> 4;
#pragma unroll
    for (int it = 0; it < 8; ++it) { LAS unsigned* d = scr + (4 * it + kr) * 65 + 4 * nq;
        d[0] = pk2(a[it].x, b[it].x); d[1] = pk2(a[it].y, b[it].y); d[2] = pk2(a[it].z, b[it].z); d[3] = pk2(a[it].w, b[it].w); }
    LDS_WAIT(); asm volatile("" ::: "memory");
    const int c = lane & 7, nl = lane >> 3;
#pragma unroll
    for (int j = 0; j < 8; ++j) { const int n = nl + 8 * j; const LAS unsigned* sp = scr + (4 * c) * 65 + n;
        v4u o; o.x = sp[0]; o.y = sp[65]; o.z = sp[130]; o.w = sp[195];
        *(GAS v4u*)(I.WT + (size_t)(I.drow0 + n) * I.dpitch + I.k0 + I.dk + 8 * c) = o; }
    LDS_WAIT(); asm volatile("" ::: "memory");
}
namespace cv {
constexpr int I_IN = (D / 64) * (NPROJ / 64), I_BR = (1024 / 64) * (D / 64), I_OUT = (D / 64) * (D / 64), I_POOL = 0;
constexpr int I_GE = (D / 64) * (FF / 64), I_DN = (FF / 64) * (D / 64);
constexpr int G0 = I_IN + 2 * I_BR + I_OUT + I_POOL, U0 = G0 + NEXP * I_GE, DN0 = U0 + NEXP * I_GE, NITEMS = DN0 + NEXP * I_DN;
constexpr int E_LATE = 8;
constexpr int NP0 = G0 + (NEXP - E_LATE) * I_GE + (NEXP - E_LATE) * I_GE;
constexpr int NP1 = 2 * E_LATE * I_GE, NP6 = NEXP * I_DN;
__device__ __forceinline__ int map_p0(int j) { const int h = G0 + (NEXP - E_LATE) * I_GE; return j < h ? j : U0 + (j - h); }
__device__ __forceinline__ int map_p1(int j) { return j < E_LATE * I_GE ? G0 + (NEXP - E_LATE) * I_GE + j : U0 + (NEXP - E_LATE) * I_GE + (j - E_LATE * I_GE); }
__device__ __forceinline__ int map_p6(int j) { return DN0 + j; }
}
__device__ __forceinline__ P0Item p0_decode(Frame& F, int it) { using namespace cv; int r = it; P0Item I;
    bf16* WIN = (bf16*)(F.ws + WS_WIN); bf16* WPB = (bf16*)(F.ws + WS_WPB); bf16* WAB = (bf16*)(F.ws + WS_WTMP); bf16* WOUT = (bf16*)(F.ws + WS_WOUT);
    bf16* WPOOL = (bf16*)(F.ws + WS_WPOOL); bf16* WGU = (bf16*)(F.ws + WS_WGU); bf16* WDN = (bf16*)(F.ws + WS_WDN);
    if (r < I_IN) { const int nb = NPROJ / 64, n0 = 64 * (r % nb);
        I = {F.w_in(), WIN, NPROJ, 2048, n0, 64 * (r / nb), n0, 0, 2};
        return I; } r -= I_IN;
    if (r < I_BR) { const int nb = D / 64; I = {F.w_pb(), WAB, D, 1024, 64 * (r % nb), 64 * (r / nb), 64 * (r % nb), 0}; return I; } r -= I_BR;
    if (r < I_BR) { const int nb = D / 64; I = {F.w_ab(), WPB, D, 2048, 64 * (r % nb), 64 * (r / nb), 64 * (r % nb), 1024, 4}; return I; } r -= I_BR;
    if (r < I_OUT) { const int nb = D / 64; I = {F.w_out(), WOUT, D, 2048, 64 * (r % nb), 64 * (r / nb), 64 * (r % nb), 0, 2}; return I; } r -= I_OUT;
    if (r < I_POOL) { const int g = r / 16, q = r % 16; I = {F.w_pool() + (size_t)g * 65536, WPOOL + (size_t)g * 65536, 256, 256, 64 * (q % 4), 64 * (q / 4), 64 * (q % 4), 0}; return I; } r -= I_POOL;
    if (r < NEXP * I_GE) { const int e = r / I_GE, q = r % I_GE, nb = FF / 64, n0 = 64 * (q % nb); I = {F.w_eg() + (size_t)e * D * FF, (bf16*)((unsigned char*)WGU + (size_t)e * 1024 * 2048), FF, 2048, (n0 >> 7) * 256 + (n0 & 127), 64 * (q / nb), n0, 0, 2}; return I; } r -= NEXP * I_GE;
    if (r < NEXP * I_GE) { const int e = r / I_GE, q = r % I_GE, nb = FF / 64, n0 = 64 * (q % nb); I = {F.w_eu() + (size_t)e * D * FF, (bf16*)((unsigned char*)WGU + (size_t)e * 1024 * 2048), FF, 2048, (n0 >> 7) * 256 + 128 + (n0 & 127), 64 * (q / nb), n0, 0, 2}; return I; } r -= NEXP * I_GE;
    { const int e = r / I_DN, q = r % I_DN, nb = D / 64, n0 = 64 * (q % nb); I = {F.w_ed() + (size_t)e * FF * D, (bf16*)((unsigned char*)WDN + (size_t)e * D * FF), D, FF, n0, 64 * (q / nb), n0, 0, 3}; return I; } }
template <class ItemOf> __device__ __forceinline__ void p0_convert(Frame& F, ItemOf item_of) {
    LAS unsigned* scr = (LAS unsigned*)(F.lds + RING_OFF + F.wave() * 16384); const int lane = F.lane();
    int k = 0, it0 = item_of(0);
    if (it0 >= 0) { f32x4 a0[8], b0[8], a1[8], b1[8]; P0Item I0 = p0_decode(F, it0), I1 = I0; p0_item_load(I0, a0, b0, lane);
        for (;;) { int it1 = item_of(++k); if (it1 >= 0) { I1 = p0_decode(F, it1); p0_item_load(I1, a1, b1, lane); }
            p0_item_store(I0, a0, b0, scr, lane); if (it1 < 0) break;
            it0 = item_of(++k); if (it0 >= 0) { I0 = p0_decode(F, it0); p0_item_load(I0, a0, b0, lane); }
            p0_item_store(I1, a1, b1, scr, lane); if (it0 < 0) break; } }
}
template <class Map> __device__ __forceinline__ void p0_convert_tail(Frame& F, int w, int nw, int n, Map map) {
    p0_convert(F, [&](int k) -> int { const int j = w + k * nw; return j < n ? map(j) : -1; });
}
__device__ __forceinline__ void p0_prologue(Frame& F) {
    const int gw = F.vcu * NWAVES + F.wave(), NGW = F.G * NWAVES, lane = F.lane();
    float* ADAP = (float*)(F.ws + WS_ADAP);
    constexpr int P0_TW = 3, P0_R1 = 1;
    const bool tw = F.wave() < P0_TW;
    if (tw) for (int task = F.vcu * P0_TW + F.wave(); task < ADA_SL * 48; task += F.G * P0_TW) { const int ks = task / 48, j = (task % 48) * 256 + 4 * lane; constexpr int KS = D / ADA_SL;
        f32x4 a0 = {0.f, 0.f, 0.f, 0.f}, a1 = {0.f, 0.f, 0.f, 0.f};
#pragma unroll 32
        for (int k = ks * KS; k < ks * KS + KS; ++k) { const f32x4 w = __builtin_nontemporal_load((const GAS f32x4*)(F.w_ada() + (size_t)k * NADA + j)); a0 += w * F.c()[k]; a1 += w * F.c()[D + k]; }
        *(GAS f32x4*)(ADAP + ((size_t)ks * 2 + 0) * NADA + j) = a0; *(GAS f32x4*)(ADAP + ((size_t)ks * 2 + 1) * NADA + j) = a1; }
    { bf16* WRT = (bf16*)(F.ws + WS_WRT);
      for (int idx = gw * 64 + lane; idx < 32 * D; idx += NGW * 64) { const int n = idx >> 11, d = idx & (D - 1);
          const float w = n < 4 ? F.w_rg()[(size_t)d * 4 + n] : (n < 20 ? F.w_re()[(size_t)d * 16 + (n - 4)] : 0.f);
          const unsigned hi = f2bf(w); const unsigned lo = f2bf(w - bf2f(hi));
          const size_t fi = ((size_t)(d >> 4) * 2) * 512 + (size_t)(((d >> 3) & 1) * 32 + n) * 8 + (d & 7);
          WRT[fi] = (bf16)hi; WRT[fi + 512] = (bf16)lo; } }
    { bf16* WPS = (bf16*)(F.ws + WS_WPOOL);
      for (int idx = (gw * 64 + lane) * 4; idx < 4 * 65536; idx += NGW * 64 * 4) { const int g = idx >> 16, d = idx & 255;
          const f32x4 w = *(const GAS f32x4*)(F.w_pool() + idx), sc = *(const GAS f32x4*)(F.pool_scale() + 256 * g + d);
          v2u o; o.x = pk2(w.x * sc.x, w.y * sc.y); o.y = pk2(w.z * sc.z, w.w * sc.w); *(GAS v2u*)(WPS + idx) = o; } }
    { const int NTW = F.G * P0_TW, NCW = F.G * (NWAVES - P0_TW), HEAD = NTW * P0_R1 < cv::NP0 ? NTW * P0_R1 : 0;
      const int twi = F.vcu * P0_TW + F.wave(), cwi = F.vcu * (NWAVES - P0_TW) + (F.wave() - P0_TW);
      p0_convert(F, [&](int k) -> int { int j;
          if (tw) j = (HEAD && k < P0_R1) ? k * NTW + twi : cv::NP0; else j = HEAD + k * NCW + cwi;
          return j < cv::NP0 ? cv::map_p0(j) : -1; }); }
}
__device__ __forceinline__ void p0b_h1(Frame& F) {
    const float* ADAP = (const float*)(F.ws + WS_ADAP); float* ADA = (float*)(F.ws + WS_ADA); unsigned char* H1F8 = F.ws + WS_H1F8; float* HS = (float*)(F.ws + WS_HS);
    LAS float* gsL = (LAS float*)(F.lds + RING_OFF);
    LAS float* shL = gsL + 2 * D;
    const bool split = (F.G & 1) == 0; const int hg = F.G >> 1, b0 = split ? (F.vcu >= hg ? 1 : 0) : 0, nent = split ? D : 2 * D;
    for (int i = F.tid(); i < nent; i += NWAVES * 64) { const int b = b0 + i / D, d = i % D; float ps[ADA_SL], pc[ADA_SL];
#pragma unroll
        for (int ks = 0; ks < ADA_SL; ++ks) { ps[ks] = ADAP[((size_t)ks * 2 + b) * NADA + d]; pc[ks] = ADAP[((size_t)ks * 2 + b) * NADA + D + d]; }
        float sh = F.b_ada()[d], sc = F.b_ada()[D + d];
#pragma unroll
        for (int ks = 0; ks < ADA_SL; ++ks) { sh += ps[ks]; sc += pc[ks]; }
        gsL[b * D + d] = F.g1()[d] * (1.f + sc); shL[b * D + d] = sh; }
    { const int i = F.vcu * (NWAVES * 64) + F.tid(); if (i < 2 * NADA) { const int b = i / NADA, j = i % NADA; float pp[ADA_SL];
#pragma unroll
        for (int ks = 0; ks < ADA_SL; ++ks) pp[ks] = ADAP[((size_t)ks * 2 + b) * NADA + j];
        float s = F.b_ada()[j];
#pragma unroll
        for (int ks = 0; ks < ADA_SL; ++ks) s += pp[ks];
        ADA[i] = s; } }
    LDS_WAIT(); __syncthreads();
    const int lane = F.lane();
    const int gw = split ? (F.vcu - b0 * hg) * NWAVES + F.wave() : F.vcu * NWAVES + F.wave(), NGW = split ? hg * NWAVES : F.G * NWAVES;
    const int rbase = split ? b0 * SEQ : 0, rend = split ? rbase + SEQ : T;
    auto ld = [&](int row, f32x4 (&v)[8]) { int r = row; asm volatile("" : "+s"(r)); const GAS f32x4* xr = (const GAS f32x4*)(F.x() + (size_t)r * D) + lane;
#pragma unroll
        for (int j = 0; j < 8; ++j) v[j] = __builtin_nontemporal_load(xr + 64 * j); };
    auto fin = [&](int row, const f32x4 (&v)[8]) { const int b = row / SEQ; float ss = 0.f;
#pragma unroll
        for (int j = 0; j < 8; ++j) ss += (v[j].x * v[j].x + v[j].y * v[j].y) + (v[j].z * v[j].z + v[j].w * v[j].w);
        const float rstd = rsqrtf(wave_sum(ss) * (1.0f / D) + EPS);
        f32x4 o[8]; float am = 0.f;
#pragma unroll
        for (int j = 0; j < 8; ++j) { const int d = 4 * lane + 256 * j; const f32x4 gs = *(const LAS f32x4*)(gsL + b * D + d), sh = *(const LAS f32x4*)(shL + b * D + d);
            o[j] = v[j] * rstd * gs + sh; am = fmaxf(fmaxf(am, fmaxf(fabsf(o[j].x), fabsf(o[j].y))), fmaxf(fabsf(o[j].z), fabsf(o[j].w))); }
#pragma unroll
        for (int off = 32; off > 0; off >>= 1) am = fmaxf(am, __shfl_xor(am, off));
        am = fmaxf(am, 1e-20f); const float inv = 127.0f / am;
#pragma unroll
        for (int j = 0; j < 8; ++j) { const int d = 4 * lane + 256 * j;
            const unsigned w8 = ((unsigned)(int)rintf(o[j].x * inv) & 255u) | (((unsigned)(int)rintf(o[j].y * inv) & 255u) << 8) | (((unsigned)(int)rintf(o[j].z * inv) & 255u) << 16) | ((unsigned)(int)rintf(o[j].w * inv) << 24);
            *(GAS unsigned*)(H1F8 + (size_t)row * D + d) = w8; }
        if (lane == 0) HS[row] = am * (1.0f / 127.0f); };
    { f32x4 va[8], vb[8]; int row = rbase + gw;
      if (row < rend) { ld(row, va);
#pragma unroll 1
          for (;;) { const int r1 = row + NGW; if (r1 < rend) ld(r1, vb);
              fin(row, va); if (r1 >= rend) break;
              const int r2 = r1 + NGW; if (r2 < rend) ld(r2, va);
              fin(r1, vb); if (r2 >= rend) break; row = r2; } } }
    __syncthreads();
}

constexpr int AT_BUF = 49152, AT_K = 0, AT_V = 24576, AT_WS = 2 * AT_BUF, AT_OST = AT_WS + 2048, AT_BYTES = AT_OST + 32768;
static_assert(AT_BYTES <= LDSCTL_OFF, "attention LDS map");
__device__ __forceinline__ int crow(int r, int hi) { return (r & 3) + 8 * (r >> 2) + 4 * hi; }
__device__ __forceinline__ unsigned cvtpk_s(float lo, float hi) { typedef float f32x2_t __attribute__((ext_vector_type(2))); typedef __bf16 bf16x2_t __attribute__((ext_vector_type(2)));
    f32x2_t v = {lo, hi}; bf16x2_t b = __builtin_convertvector(v, bf16x2_t); return __builtin_bit_cast(unsigned, b); }
typedef short v4i16_t __attribute__((ext_vector_type(4)));
__device__ __forceinline__ s16x4 vtr(LAS const unsigned char* p) { return __builtin_bit_cast(s16x4, __builtin_amdgcn_ds_read_tr16_b64_v4i16((LAS v4i16_t*)p)); }
struct AttnU { int b, kvh, q0; };
__device__ __forceinline__ AttnU attn_decode(int unit) { AttnU u; u.q0 = (unit & 127) * 64; u.kvh = (unit >> 7) & 3; u.b = unit >> 9; return u; }
__device__ __forceinline__ void attn_dma(Frame& F, const AttnU u, int buf, int wid, int lane) {
    const bf16* P = (const bf16*)(F.ws + WS_PROJ); LAS unsigned char* L = F.lds + RING_OFF + buf * AT_BUF;
#pragma unroll
    for (int t = 0; t < 3; ++t) {
        int kk = u.q0 - 128 + 64 * t + lane; if (kk < 0) kk = 0;
        int kv = u.q0 - 128 + 64 * t + 16 * (wid & 3) + (lane >> 2); if (kv < 0) kv = 0;
        const bf16* ks = P + ((size_t)u.b * SEQ + kk) * NPROJ + C_K + u.kvh * 64 + wid * 8;
        const bf16* vs = P + ((size_t)u.b * SEQ + kv) * NPROJ + C_V + u.kvh * 64 + (wid >> 2) * 32 + (lane & 3) * 8;
        __builtin_amdgcn_global_load_lds((const unsigned*)ks, (LAS unsigned*)(L + AT_K + t * 8192 + wid * 1024), 16, 0, 0);
        __builtin_amdgcn_global_load_lds((const unsigned*)vs, (LAS unsigned*)(L + AT_V + t * 8192 + wid * 1024), 16, 0, 0); }
}
__device__ __forceinline__ void attn_q(Frame& F, const AttnU u, bf16x8 (&qr)[4], int wid, int lane) {
    const bf16* P = (const bf16*)(F.ws + WS_PROJ); const int hq = u.kvh * 4 + (wid & 3), rh = wid >> 2, r32 = lane & 31, hi = lane >> 5;
    const size_t qrow = (size_t)u.b * SEQ + u.q0 + 32 * rh + r32;
#pragma unroll
    for (int d0 = 0; d0 < 4; ++d0) qr[d0] = __builtin_nontemporal_load((const GAS bf16x8*)(P + qrow * NPROJ + C_Q + hq * 64 + d0 * 16 + hi * 8));
}
__device__ __forceinline__ void attn_compute(Frame& F, const AttnU u, int buf, const bf16x8 (&qr)[4], int wid, int lane, float sink2) {
    bf16* AP = (bf16*)(F.ws + WS_B);
    const int r32 = lane & 31, hi = lane >> 5, q0 = u.q0, hq = u.kvh * 4 + (wid & 3), rh = wid >> 2;
    LAS unsigned char* L = F.lds + RING_OFF + buf * AT_BUF; LAS unsigned char* L0 = F.lds + RING_OFF;
    f32x16 p[5];
#pragma unroll
    for (int s = 0; s < 5; ++s) { const int j = rh + s; f32x16 a;
        if (q0 - 128 + 32 * j >= 0) { a = f32x16{};
            const int ko = AT_K + (j >> 1) * 8192 + (j & 1) * 512;
#pragma unroll
            for (int d0 = 0; d0 < 4; ++d0) { const bf16x8 kf = *(const LAS bf16x8*)(L + ko + (2 * d0 + hi) * 1024 + r32 * 16);
                a = __builtin_amdgcn_mfma_f32_32x32x16_bf16(kf, qr[d0], a, 0, 0, 0); } }
        else {
#pragma unroll
            for (int r = 0; r < 16; ++r) a[r] = -1e30f; }
        p[s] = a; }
    const float xf = (float)(r32 - 4 * hi);
#pragma unroll
    for (int r = 0; r < 16; ++r) { const float dlt = xf - (float)((r & 3) + 8 * (r >> 2));
        p[0][r] = __builtin_fmaf(fmaxf(dlt + 1.0f, 0.0f), -1e30f, p[0][r]);
        p[4][r] = __builtin_fmaf(fmaxf(-dlt, 0.0f), -1e30f, p[4][r]); }
    float mx = sink2;
#pragma unroll
    for (int s = 0; s < 5; ++s)
#pragma unroll
        for (int r = 0; r < 16; ++r) mx = fmaxf(mx, p[s][r]);
    mx = fmaxf(mx, __shfl_xor(mx, 32));
    float lsum = 0.f;
#pragma unroll
    for (int s = 0; s < 5; ++s)
#pragma unroll
        for (int r = 0; r < 16; ++r) { const float e = __builtin_amdgcn_exp2f(p[s][r] - mx); p[s][r] = e; lsum += e; }
    lsum += __shfl_xor(lsum, 32);
    lsum += __builtin_amdgcn_exp2f(sink2 - mx);
    f32x16 o[2]; o[0] = f32x16{}; o[1] = f32x16{};
    const int vb = AT_V + ((lane >> 4) & 1) * 32 + (lane & 3) * 8 + (4 * hi + ((lane & 15) >> 2)) * 64;
#pragma unroll
    for (int s = 0; s < 5; ++s) { const int j = rh + s; const int vo = vb + (j >> 1) * 8192 + (j & 1) * 2048;
        v4u pw[2];
#pragma unroll
        for (int kk = 0; kk < 2; ++kk) { const int rb = kk * 8;
            pw[kk].x = cvtpk_s(p[s][rb + 0], p[s][rb + 1]); pw[kk].y = cvtpk_s(p[s][rb + 2], p[s][rb + 3]);
            pw[kk].z = cvtpk_s(p[s][rb + 4], p[s][rb + 5]); pw[kk].w = cvtpk_s(p[s][rb + 6], p[s][rb + 7]); }
#pragma unroll
        for (int d0 = 0; d0 < 2; ++d0)
#pragma unroll
            for (int kk = 0; kk < 2; ++kk) { const s16x4 lo = vtr(L + vo + d0 * 4096 + kk * 1024), hh = vtr(L + vo + d0 * 4096 + kk * 1024 + 512);
                const bf16x8 vf = {lo[0], lo[1], lo[2], lo[3], hh[0], hh[1], hh[2], hh[3]};
                o[d0] = __builtin_amdgcn_mfma_f32_32x32x16_bf16(__builtin_bit_cast(bf16x8, pw[kk]), vf, o[d0], 0, 0, 0); }
        __builtin_amdgcn_sched_barrier(0); }
    LAS float* wsf = (LAS float*)(L0 + AT_WS) + wid * 64;
    if (hi == 0) wsf[r32] = lsum;
    LDS_WAIT();
    LAS bf16* stg = (LAS bf16*)(L0 + AT_OST) + wid * 2048;
#pragma unroll
    for (int r = 0; r < 16; ++r) { const int orow = crow(r, hi); const float rl = __builtin_amdgcn_rcpf(wsf[orow]);
#pragma unroll
        for (int d0 = 0; d0 < 2; ++d0) stg[orow * 64 + d0 * 32 + r32] = (bf16)f2bf(o[d0][r] * rl); }
    LDS_WAIT();
    bf16* Ow = AP + ((size_t)u.b * SEQ + q0 + 32 * rh) * D + 1024 + hq * 64;
#pragma unroll
    for (int i = 0; i < 4; ++i) { const int row = i * 8 + (lane >> 3), ch = lane & 7; const v4u v = *(const LAS v4u*)(stg + row * 64 + ch * 8); *(GAS v4u*)(Ow + (size_t)row * D + ch * 8) = v; }
}
__device__ __forceinline__ void attn_phase(Frame& F, bool own) {
    constexpr int NU = BATCH * 4 * (SEQ / 64);
    const int wid = F.wave(), lane = F.lane();
    auto unit_of = [&](int k) -> int { if (own) return k < 4 ? (F.vcu >> 7) * 512 + k * 128 + (F.vcu & 127) : -1; const int uu = F.vcu + k * F.G; return uu < NU ? uu : -1; };
    int kk = 0; int unit = unit_of(0); if (unit < 0) return;
    bf16x8 qc[4], qn[4];
    float sk[4];
#pragma unroll
    for (int k = 0; k < 4; ++k) sk[k] = F.sinks()[k * 4 + (wid & 3)] * LOG2E;
    attn_dma(F, attn_decode(unit), 0, wid, lane); attn_q(F, attn_decode(unit), qc, wid, lane);
    VM_WAIT(); __syncthreads();
    int buf = 0;
#pragma unroll 1
    for (;; buf ^= 1) {
        const int nu = unit_of(++kk); const bool more = nu >= 0;
        if (more) { attn_dma(F, attn_decode(nu), buf ^ 1, wid, lane); attn_q(F, attn_decode(nu), qn, wid, lane); }
        { const AttnU cu = attn_decode(unit); const float sk2 = cu.kvh == 0 ? sk[0] : cu.kvh == 1 ? sk[1] : cu.kvh == 2 ? sk[2] : sk[3];
          attn_compute(F, cu, buf, qc, wid, lane, sk2); }
        asm volatile("s_waitcnt vmcnt(4)" ::: "memory"); LDS_WAIT(); __builtin_amdgcn_s_barrier(); asm volatile("" ::: "memory");
        if (!more) break;
        unit = nu;
#pragma unroll
        for (int d0 = 0; d0 < 4; ++d0) qc[d0] = qn[d0];
    }
}
template <int W> __device__ __forceinline__ void pooled_rows(const bf16* up, bf16* po, int r0, int t0) {
    constexpr int H = W - 1;
    v2u v[32 + H];
#pragma unroll
    for (int k = 0; k < 32 + H; ++k) { v[k].x = 0u; v[k].y = 0u; if (t0 + k - H >= 0) v[k] = __builtin_nontemporal_load((const GAS v2u*)(up + (size_t)(r0 + k - H) * NPROJ)); }
    float s0 = 0.f, s1 = 0.f, s2 = 0.f, s3 = 0.f;
#pragma unroll
    for (int k = 0; k < H; ++k) { s0 += bflo(v[k].x); s1 += bfhi(v[k].x); s2 += bflo(v[k].y); s3 += bfhi(v[k].y); }
#pragma unroll
    for (int i = 0; i < 32; ++i) { const float x0 = bflo(v[i + H].x), x1 = bfhi(v[i + H].x), x2 = bflo(v[i + H].y), x3 = bfhi(v[i + H].y);
        s0 += x0; s1 += x1; s2 += x2; s3 += x3;
        const int t = t0 + i; const float rc = (t + 1) < W ? 1.0f / (float)(t + 1) : 1.0f / (float)W;
        v2u o; o.x = pk2(s0 * rc - x0, s1 * rc - x1); o.y = pk2(s2 * rc - x2, s3 * rc - x3);
        *(GAS v2u*)(po + (size_t)(r0 + i) * D) = o;
        s0 -= bflo(v[i].x); s1 -= bfhi(v[i].x); s2 -= bflo(v[i].y); s3 -= bfhi(v[i].y); }
}
__device__ __forceinline__ void pooled_unit(Frame& F, int pm, int g) {
    const bf16* P = (const bf16*)(F.ws + WS_PROJ); bf16* PO = (bf16*)(F.ws + WS_B);
    const int tid = F.tid(), c4 = tid & 63, seg = tid >> 6;
    const int r0 = pm * 256 + seg * 32, t0 = r0 % SEQ;
    const bf16* up = P + C_U + 256 * g + 4 * c4; bf16* po = PO + 256 * g + 4 * c4;
    if (g == 0) pooled_rows<2>(up, po, r0, t0); else if (g == 1) pooled_rows<4>(up, po, r0, t0); else if (g == 2) pooled_rows<8>(up, po, r0, t0); else pooled_rows<16>(up, po, r0, t0);
}

__device__ __forceinline__ void pooled_own(Frame& F) {
    const bf16* P = (const bf16*)(F.ws + WS_PROJ); bf16* PO = (bf16*)(F.ws + WS_B);
    const int wid = F.wave(), c4 = F.lane(), g = wid >> 1;
    const int r0 = 64 * F.vcu + 32 * (wid & 1), t0 = r0 % SEQ;
    const bf16* up = P + C_U + 256 * g + 4 * c4; bf16* po = PO + 256 * g + 4 * c4;
    if (g == 0) pooled_rows<2>(up, po, r0, t0); else if (g == 1) pooled_rows<4>(up, po, r0, t0); else if (g == 2) pooled_rows<8>(up, po, r0, t0); else pooled_rows<16>(up, po, r0, t0);
}
__device__ __forceinline__ int p5_row(int blk, int j) { return (blk >> 7) * SEQ + 128 * j + (blk & 127); }
__device__ __forceinline__ void p5b_fill(Frame& F) {
    unsigned char* rt = F.ws + WS_RT;
    const int* TOKE = (const int*)(rt + RT_TOKE); const float* TOKW = (const float*)(rt + RT_TOKW); const int* LRANK = (const int*)(rt + RT_LRANK); int* TOKSLOT = (int*)(rt + RT_TOKSLOT);
    const int* BLKCNT = (const int*)(rt + RT_BLKCNT); int* SLOTTOK = (int*)(rt + RT_SLOTTOK); float* SLOTW = (float*)(rt + RT_SLOTW); int* META = (int*)(rt + RT_META);
    LAS int* cntL = (LAS int*)(F.lds + RING_OFF);
    LAS int* totL = cntL + 4096;
    for (int i = F.tid(); i < 4096; i += NWAVES * 64) cntL[i] = BLKCNT[i];
    LDS_WAIT(); __syncthreads();
    for (int blk = F.vcu; blk < 256; blk += F.G) {
        { const int e = F.tid() >> 5, s = F.tid() & 31; int pt = 0, pb = 0;
            for (int bb = 8 * s; bb < 8 * s + 8; ++bb) { const int c = cntL[bb * 16 + e]; pt += c; pb += (bb < blk) ? c : 0; }
#pragma unroll
            for (int o = 1; o < 32; o <<= 1) { pt += __shfl_xor(pt, o); pb += __shfl_xor(pb, o); }
            if (s == 0) { totL[e] = pt; totL[16 + e] = pb; } }
        LDS_WAIT(); __syncthreads();
        if (F.tid() == 0) { int o = 0, nt = 0; for (int e = 0; e < 16; ++e) { totL[32 + e] = o; const int tl = (totL[e] + 255) >> 8;
                if (F.vcu == 0 && blk == 0) { META[e] = o; for (int i = 0; i < tl; ++i) META[32 + nt + i] = e; } nt += tl; o += tl * 256; }
            totL[48] = o; if (F.vcu == 0 && blk == 0) { META[16] = o; META[17] = o; META[18] = nt; } }
        LDS_WAIT(); __syncthreads();
        if (F.tid() < 128) { const int t = F.tid(), i = p5_row(blk, t >> 1) * 2 + (t & 1), e = TOKE[i]; const int slot = totL[32 + e] + totL[16 + e] + LRANK[i];
            SLOTTOK[slot] = i >> 1; SLOTW[slot] = TOKW[i]; TOKSLOT[i] = slot; }
        if (blk < 16) { const int e = blk; for (int s = totL[32 + e] + totL[e] + F.tid(); s < totL[32 + e + 1]; s += NWAVES * 64) { SLOTTOK[s] = 0; SLOTW[s] = 0.f; } }
        __syncthreads();
    }
}

__device__ __forceinline__ float swap32_add(float a, float b) { const auto r = __builtin_amdgcn_permlane32_swap(__float_as_uint(a), __float_as_uint(b), false, false); return __uint_as_float(r[0]) + __uint_as_float(r[1]); }
__device__ __forceinline__ float swap16_add(float a, float b) { const auto r = __builtin_amdgcn_permlane16_swap(__float_as_uint(a), __float_as_uint(b), false, false); return __uint_as_float(r[0]) + __uint_as_float(r[1]); }
template <int CTRL> __device__ __forceinline__ float dpp_add(float v) { return v + __uint_as_float((unsigned)__builtin_amdgcn_update_dpp(0, (int)__float_as_uint(v), CTRL, 0xf, 0xf, false)); }
__device__ __forceinline__ float row16_sum(float v) { v = dpp_add<0x128>(v); v = dpp_add<0x124>(v); v = dpp_add<0x122>(v); v = dpp_add<0x121>(v); return v; }
#define P5_BAR() do { LDS_WAIT(); __builtin_amdgcn_s_barrier(); asm volatile("" ::: "memory"); } while (0)
constexpr int P5_AP = 528, P5_HI = 4096, P5_LO = P5_HI + 64 * P5_AP, P5_PART = 73728;
__device__ __forceinline__ void p5a_block(Frame& F, int blk, LAS int* eL) {
    typedef float f4 __attribute__((ext_vector_type(4)));
    const bf16* X1 = (const bf16*)(F.ws + WS_B); const float* SSQ = (const float*)(F.ws + WS_SSQ); const float* ada = (const float*)(F.ws + WS_ADA); bf16* H2 = (bf16*)(F.ws + WS_C);
    const bf16* WRT = (const bf16*)(F.ws + WS_WRT);
    unsigned char* rt = F.ws + WS_RT;
    LAS unsigned char* L = F.lds + RING_OFF;
    LAS float* partL = (LAS float*)(L + P5_PART);
    const int lane = F.lane(), wid = F.wave(), r32 = lane & 31, hl = lane >> 5;
    const int b = blk >> 7, rowb = p5_row(blk, 0);
    const float* sh = ada + (size_t)b * NADA + 3 * D; const float* sc = ada + (size_t)b * NADA + 4 * D;
    LAS float* gsL = (LAS float*)(L + 110592); LAS float* hL = (LAS float*)(L + 118784);
    LAS float* hsL = (LAS float*)(L + 126976);
    LAS float* mxP = (LAS float*)(L + 127488); LAS float* mxL = mxP + 16;
    { const int d0 = 4 * F.tid(); const f4 g = *(const GAS f4*)(F.g2() + d0), s = *(const GAS f4*)(sc + d0), h = *(const GAS f4*)(sh + d0);
      const f4 gsv = g * (1.f + s); *(LAS f4*)(gsL + d0) = gsv; *(LAS f4*)(hL + d0) = h;
      float mg = fmaxf(fmaxf(fabsf(gsv.x), fabsf(gsv.y)), fmaxf(fabsf(gsv.z), fabsf(gsv.w))), mh = fmaxf(fmaxf(fabsf(h.x), fabsf(h.y)), fmaxf(fabsf(h.z), fabsf(h.w)));
#pragma unroll
      for (int off = 32; off > 0; off >>= 1) { mg = fmaxf(mg, __shfl_xor(mg, off)); mh = fmaxf(mh, __shfl_xor(mh, off)); }
      if (lane == 0) { mxP[2 * wid] = mg; mxP[2 * wid + 1] = mh; } }
    LDS_WAIT(); __syncthreads();
    if (F.tid() == 0) { float a = 0.f, b2 = 0.f; for (int w = 0; w < 8; ++w) { a = fmaxf(a, mxP[2 * w]); b2 = fmaxf(b2, mxP[2 * w + 1]); } mxL[0] = a; mxL[1] = b2; }
    LDS_WAIT(); __syncthreads();
    const int rot = blk & 7, rb = wid & 1, kq = wid >> 1;
    auto wload = [&](int j, bf16x8 (&bh)[4], bf16x8 (&bl)[4]) { int jq = (j + rot) & 7; asm volatile("" : "+s"(jq));
#pragma unroll
        for (int s4 = 0; s4 < 4; ++s4) { const bf16* wp = WRT + ((size_t)((jq * 4 + kq) * 4 + s4) * 2) * 512 + lane * 8; bh[s4] = *(const GAS bf16x8*)wp; bl[s4] = *(const GAS bf16x8*)(wp + 512); } };
    bf16x8 wah[4], wal[4], wbh[4], wbl[4];
    wload(0, wah, wal);
    float rs[8];
#pragma unroll
    for (int i = 0; i < 8; ++i) rs[i] = SSQ[(size_t)(rowb + 128 * (wid * 8 + i)) * 32 + (lane & 31)];
    v2u xv[8][8];
#pragma unroll
    for (int j = 0; j < 8; ++j)
#pragma unroll
        for (int i = 0; i < 8; ++i) xv[j][i] = __builtin_nontemporal_load((const GAS v2u*)(X1 + (size_t)(rowb + 128 * (wid * 8 + i)) * D + 4 * lane + 256 * ((j + rot) & 7)));
#pragma unroll
    for (int i = 0; i < 8; ++i) rs[i] = rsqrtf(wave_sum(lane < 32 ? rs[i] : 0.f) * (1.0f / D) + EPS);
    f32x16 acc = {};
    P5_BAR();
    const float amaxb = 5.5f * mxL[0] + mxL[1], qinvb = 127.0f / amaxb;
    if (F.tid() < 64) hsL[F.tid()] = amaxb * (1.0f / 127.0f);
    auto step = [&](int j, const v2u (&xn)[8], const bf16x8 (&bh)[4], const bf16x8 (&bl)[4], bf16x8 (&nh)[4], bf16x8 (&nl)[4]) { int d = 4 * lane + 256 * ((j + rot) & 7); asm volatile("" : "+v"(d));
        if (j < 7) wload(j + 1, nh, nl);
        const f4 gs = *(const LAS f4*)(gsL + d), h = *(const LAS f4*)(hL + d);
#pragma unroll
        for (int i = 0; i < 8; ++i) { const int rl = wid * 8 + i; const f4 xf = {bflo(xn[i].x), bfhi(xn[i].x), bflo(xn[i].y), bfhi(xn[i].y)}; const f4 hv = xf * rs[i] * gs + h;
            v2u whi; whi.x = pk2(hv.x, hv.y); whi.y = pk2(hv.z, hv.w);
            v2u wlo; wlo.x = pk2(hv.x - bflo(whi.x), hv.y - bfhi(whi.x)); wlo.y = pk2(hv.z - bflo(whi.y), hv.w - bfhi(whi.y));
            *(LAS v2u*)(L + P5_HI + rl * P5_AP + 8 * lane) = whi; *(LAS v2u*)(L + P5_LO + rl * P5_AP + 8 * lane) = wlo;
            const float qi = qinvb; const f4 hc = {fminf(fmaxf(hv.x * qi, -127.f), 127.f), fminf(fmaxf(hv.y * qi, -127.f), 127.f), fminf(fmaxf(hv.z * qi, -127.f), 127.f), fminf(fmaxf(hv.w * qi, -127.f), 127.f)};
            const unsigned w8 = ((unsigned)(int)rintf(hc.x) & 255u) | (((unsigned)(int)rintf(hc.y) & 255u) << 8) | (((unsigned)(int)rintf(hc.z) & 255u) << 16) | ((unsigned)(int)rintf(hc.w) << 24);
            *(GAS unsigned*)((unsigned char*)H2 + (size_t)(rowb + 128 * rl) * D + d) = w8; }
        P5_BAR();
#pragma unroll
        for (int s4 = 0; s4 < 4; ++s4) { const int ao = (32 * rb + r32) * P5_AP + (64 * kq + 16 * s4 + 8 * hl) * 2;
            const bf16x8 ah = *(const LAS bf16x8*)(L + P5_HI + ao), al = *(const LAS bf16x8*)(L + P5_LO + ao);
            acc = __builtin_amdgcn_mfma_f32_32x32x16_bf16(ah, bh[s4], acc, 0, 0, 0);
            acc = __builtin_amdgcn_mfma_f32_32x32x16_bf16(ah, bl[s4], acc, 0, 0, 0);
            acc = __builtin_amdgcn_mfma_f32_32x32x16_bf16(al, bh[s4], acc, 0, 0, 0); }
        P5_BAR(); };
    step(0, xv[0], wah, wal, wbh, wbl); step(1, xv[1], wbh, wbl, wah, wal); step(2, xv[2], wah, wal, wbh, wbl); step(3, xv[3], wbh, wbl, wah, wal);
    step(4, xv[4], wah, wal, wbh, wbl); step(5, xv[5], wbh, wbl, wah, wal); step(6, xv[6], wah, wal, wbh, wbl); step(7, xv[7], wbh, wbl, wah, wal);
#pragma unroll
    for (int r = 0; r < 16; ++r) partL[wid * 1056 + ((r & 3) + 8 * (r >> 2) + 4 * hl) * 33 + r32] = acc[r];
    P5_BAR();
    if (wid == 4) {
        float lg[20]; const int prb = lane >> 5, prow = lane & 31;
#pragma unroll
        for (int o = 0; o < 20; ++o) { float v = 0.f;
#pragma unroll
            for (int q = 0; q < 4; ++q) v += partL[(2 * q + prb) * 1056 + prow * 33 + o];
            lg[o] = v; }
        float gl[4]; int gi = 0;
#pragma unroll
        for (int o = 0; o < 4; ++o) gl[o] = lg[o] + F.b_rg()[o];
#pragma unroll
        for (int o = 1; o < 4; ++o) if (gl[o] > gl[gi]) gi = o;
        float gsum = 0.f;
#pragma unroll
        for (int o = 0; o < 4; ++o) gsum += __expf(gl[o] - gl[gi]);
        const float gp = 1.0f / gsum;
        float el[4];
#pragma unroll
        for (int o = 0; o < 4; ++o) { float v = 0.f;
#pragma unroll
            for (int g = 0; g < 4; ++g) v = (g == gi) ? lg[4 + 4 * g + o] + F.b_re()[4 * g + o] : v;
            el[o] = v; }
        int i1 = 0;
#pragma unroll
        for (int o = 1; o < 4; ++o) if (el[o] > el[i1]) i1 = o;
        int i2 = (i1 == 0) ? 1 : 0;
#pragma unroll
        for (int o = 0; o < 4; ++o) if (o != i1 && el[o] > el[i2]) i2 = o;
        const float rr = __expf(el[i2] - el[i1]);
        const float w1 = gp / (1.0f + rr), w2 = gp * rr / (1.0f + rr);
        const int row = rowb + 128 * lane, e1 = gi * 4 + i1, e2 = gi * 4 + i2;
        const unsigned long long lt = (1ull << lane) - 1ull; int r1 = 0, r2 = 0, mycnt = 0;
        for (int e = 0; e < NEXP; ++e) { const unsigned long long m1 = __ballot(e1 == e), m2 = __ballot(e2 == e);
            if (e1 == e) r1 = __popcll(m1 & lt); if (e2 == e) r2 = __popcll(m1) + __popcll(m2 & lt);
            if (lane == e) mycnt = __popcll(m1) + __popcll(m2); }
        int base = 0; if (lane < NEXP) base = (int)__hip_atomic_fetch_add((unsigned*)(F.ctl + CW_CNT) + lane, (unsigned)mycnt, __ATOMIC_RELAXED, __HIP_MEMORY_SCOPE_AGENT);
        const int p1 = e1 * T + __shfl(base, e1) + r1, p2 = e2 * T + __shfl(base, e2) + r2;
        int* LTOK = (int*)(F.ws + WS_LTOK); float* LW = (float*)(F.ws + WS_LW);
        LTOK[p1] = row; LW[p1] = w1; LTOK[p2] = row; LW[p2] = w2;
        { float* LS = (float*)(F.ws + WS_LS); const float hsr = hsL[lane]; LS[p1] = hsr; LS[p2] = hsr; }
        ((int*)(rt + RT_TOKSLOT))[row * 2] = p1; ((int*)(rt + RT_TOKSLOT))[row * 2 + 1] = p2;
    }
}

__device__ __forceinline__ void final_phase(Frame& F) {
    typedef float f4 __attribute__((ext_vector_type(4)));
    const bf16* X1 = (const bf16*)(F.ws + WS_B); const bf16* Y = (const bf16*)(F.ws + WS_Y); const int* tokpos = (const int*)(F.ws + WS_RT + RT_TOKSLOT); const float* ada = (const float*)(F.ws + WS_ADA);
    LAS float* g2L = (LAS float*)(F.lds + RING_OFF); LAS float* fgL = g2L + 2 * D;
    { const int t4 = 4 * F.tid();
      *(LAS f4*)(g2L + t4) = *(const GAS f4*)(ada + 5 * D + t4); *(LAS f4*)(g2L + D + t4) = *(const GAS f4*)(ada + NADA + 5 * D + t4); *(LAS f4*)(fgL + t4) = *(const GAS f4*)(F.fg() + t4); }
    const int gw = F.vcu * NWAVES + F.wave(), NGW = F.G * NWAVES, lane = F.lane();
    int sl = 0;
    { const int r = gw + NGW * (lane >> 1); if (lane < 16 && r < T) { const int tp = tokpos[r * 2 + (lane & 1)]; sl = F.LM[tp >> 14] + (tp & 16383); } }
    LDS_WAIT(); __syncthreads();
    auto ld = [&](int i, v2u (&xb)[8], v2u (&ya)[8], v2u (&yc)[8]) { const int row = gw + NGW * i; const int s1 = __shfl(sl, 2 * i), s2 = __shfl(sl, 2 * i + 1);
        const bf16* xp = X1 + (size_t)row * D + 4 * lane; const bf16* ap = Y + (size_t)s1 * D + 4 * lane; const bf16* cp = Y + (size_t)s2 * D + 4 * lane;
#pragma unroll
        for (int j = 0; j < 8; ++j) { xb[j] = __builtin_nontemporal_load((const GAS v2u*)(xp + 256 * j)); ya[j] = __builtin_nontemporal_load((const GAS v2u*)(ap + 256 * j)); yc[j] = __builtin_nontemporal_load((const GAS v2u*)(cp + 256 * j)); } };
    auto fin = [&](int i, const v2u (&xb)[8], const v2u (&ya)[8], const v2u (&yc)[8]) { const int row = gw + NGW * i; const LAS float* g2 = g2L + (row / SEQ) * D;
        f4 v[8]; float ss = 0.f;
#pragma unroll
        for (int j = 0; j < 8; ++j) { const f4 g = *(const LAS f4*)(g2 + 4 * lane + 256 * j);
            v[j].x = bflo(xb[j].x) + g.x * (bflo(ya[j].x) + bflo(yc[j].x)); v[j].y = bfhi(xb[j].x) + g.y * (bfhi(ya[j].x) + bfhi(yc[j].x));
            v[j].z = bflo(xb[j].y) + g.z * (bflo(ya[j].y) + bflo(yc[j].y)); v[j].w = bfhi(xb[j].y) + g.w * (bfhi(ya[j].y) + bfhi(yc[j].y));
            ss += (v[j].x * v[j].x + v[j].y * v[j].y) + (v[j].z * v[j].z + v[j].w * v[j].w); }
        const float rstd = rsqrtf(wave_sum(ss) * (1.0f / D) + EPS);
#pragma unroll
        for (int j = 0; j < 8; ++j) { const f4 g = *(const LAS f4*)(fgL + 4 * lane + 256 * j); const f4 ov = v[j] * rstd * g;
            __builtin_nontemporal_store(ov, (GAS f4*)(F.out + (size_t)row * D + 4 * lane + 256 * j)); } };
    const int nr = gw < T ? (T - 1 - gw) / NGW + 1 : 0;
    if (nr > 0) { v2u xa[8], aa[8], ca[8], xb[8], ab[8], cb[8]; ld(0, xa, aa, ca);
#pragma unroll 1
        for (int i = 0;;) { if (i + 1 < nr) ld(i + 1, xb, ab, cb);
            fin(i, xa, aa, ca); if (++i >= nr) break;
            if (i + 1 < nr) ld(i + 1, xa, aa, ca);
            fin(i, xb, ab, cb); if (++i >= nr) break; } }
}

__device__ __forceinline__ void ap_quant(Frame& F, bool own) {
    const bf16* AP = (const bf16*)(F.ws + WS_B); unsigned char* AP8 = F.ws + WS_AP8; float* AS = (float*)(F.ws + WS_AS);
    const int lane = F.lane(); const int gw = own ? 64 * F.vcu + 8 * F.wave() : F.vcu * NWAVES + F.wave(), NGW = own ? 1 : F.G * NWAVES; const int rend = own ? gw + 8 : T;
#pragma unroll 1
    for (int r0 = gw; r0 < rend; r0 += 8 * NGW) { v4u v[8][4];
#pragma unroll
        for (int i = 0; i < 8; ++i) { const int row = r0 + i * NGW;
#pragma unroll
            for (int j = 0; j < 4; ++j) { v[i][j] = v4u{0u, 0u, 0u, 0u}; if (row < rend) v[i][j] = __builtin_nontemporal_load((const GAS v4u*)(AP + (size_t)row * D + 8 * lane + 512 * j)); } }
#pragma unroll
        for (int i = 0; i < 8; ++i) { const int row = r0 + i * NGW; if (row >= rend) break; float am = 0.f;
#pragma unroll
            for (int j = 0; j < 4; ++j) { const unsigned w[4] = {v[i][j].x, v[i][j].y, v[i][j].z, v[i][j].w};
#pragma unroll
                for (int q = 0; q < 4; ++q) am = fmaxf(am, fmaxf(fabsf(bflo(w[q])), fabsf(bfhi(w[q])))); }
#pragma unroll
            for (int off = 32; off > 0; off >>= 1) am = fmaxf(am, __shfl_xor(am, off));
            am = fmaxf(am, 1e-20f); const float inv = 127.0f / am;
#pragma unroll
            for (int j = 0; j < 4; ++j) { const unsigned w[4] = {v[i][j].x, v[i][j].y, v[i][j].z, v[i][j].w}; v2u o;
                o.x = ((unsigned)(int)rintf(bflo(w[0]) * inv) & 255u) | (((unsigned)(int)rintf(bfhi(w[0]) * inv) & 255u) << 8) | (((unsigned)(int)rintf(bflo(w[1]) * inv) & 255u) << 16) | ((unsigned)(int)rintf(bfhi(w[1]) * inv) << 24);
                o.y = ((unsigned)(int)rintf(bflo(w[2]) * inv) & 255u) | (((unsigned)(int)rintf(bfhi(w[2]) * inv) & 255u) << 8) | (((unsigned)(int)rintf(bflo(w[3]) * inv) & 255u) << 16) | ((unsigned)(int)rintf(bfhi(w[3]) * inv) << 24);
                *(GAS v2u*)(AP8 + (size_t)row * D + 8 * lane + 512 * j) = o; }
            if (lane == 0) AS[row] = am * (1.0f / 127.0f); } }
}

__global__ void __launch_bounds__(NWAVES * 64, 2) mk_fwd(Args args) {
    extern __shared__ __attribute__((aligned(16))) unsigned char lds[];
    Frame F;
    F.lds = (LAS unsigned char*)lds; F.MISC = (volatile LAS unsigned*)(F.lds + MISC_OFF); F.LM = (LAS int*)(F.lds + LMETA_OFF);
    F.G = gridDim.x; { const int bx = blockIdx.x; F.vcu = (F.G % 8 == 0) ? (bx % 8) * (F.G / 8) + bx / 8 : bx; }
    F.ws = args.ws; F.out = args.out; F.ctl = (gu32*)(args.ws + WS_CTL);
    F.ka = (KArgs)__builtin_amdgcn_kernarg_segment_ptr();
    { int zt = F.tid(); asm volatile("" : "+v"(zt));
      for (int u = zt; u < (LDS_BYTES - LDSCTL_OFF) / 4; u += NWAVES * 64) ((LAS unsigned*)(F.lds + LDSCTL_OFF))[u] = 0u; }
    __syncthreads();
    const int lo = args.ph_lo, hi = args.ph_hi;
    XcdBarrier bar; bar.bar = (unsigned*)(F.ctl + CW_BAR); bar.x = 0; bar.st = nullptr;
    if (hi - lo > 1) bar = xcd_barrier_post((unsigned*)(F.ctl + CW_BAR), F.MISC);
#ifndef ENMASK
#define ENMASK 0x7FF
#endif
#define IN(k) (((ENMASK >> (k)) & 1) && lo <= (k) && (k) < hi)
#define SEAM(k) do { if (IN(k) && IN((k) + 1)) xcd_barrier(bar); } while (0)
#ifndef REPMASK
#define REPMASK 0
#endif
#define REP(k) _Pragma("unroll 1") for (int rep_ = 0; rep_ < 1 + ((REPMASK >> (k)) & 1); ++rep_)
    unsigned char* ws = args.ws; float* ADA = (float*)(ws + WS_ADA);
    bf16* PROJ = (bf16*)(ws + WS_PROJ); bf16* BUFB = (bf16*)(ws + WS_B); bf16* BUFC = (bf16*)(ws + WS_C);
    unsigned char* rt = ws + WS_RT;

    if (IN(0)) REP(0) { p0_prologue(F); } SEAM(0);
    if (IN(1)) REP(1) { p0b_h1(F); } SEAM(1);
    if (IN(2)) REP(2) {
        pg8::Gemm g{(const bf16*)(ws + WS_H1F8), (const bf16*)(ws + WS_WIN), D / 2, D / 2, D / 2, 0, nullptr, nullptr}; pg8::StaticOrder S; S.init(T, NPROJ, F.G, (int)blockIdx.x);
        { const int nwg = (T / 256) * (NPROJ / 256), rem = nwg % F.G, c = (int)blockIdx.x;
          const int nidle = rem ? F.G - rem : F.G, first = rem ? rem : 0;
          if (c >= first) {
              for (int j = c - first; j < 32; j += nidle) { const int gq = j >> 3;
                  pg8::Gemm gf{(const bf16*)(ws + WS_WTMP) + 256 * gq, (const bf16*)(ws + WS_WPOOL), 1024, 256, 256, 65536, nullptr, nullptr};
                  pg8::OneUnit SF{{j & 7, 0, gq}};
                  pg8::gemm_phase<pg8::EpFold, pg8::OneUnit, false>(F.lds + RING_OFF, gf, SF, pg8::EpFold{ws + WS_WPB}); }
              { const int nfold = nidle > 64 ? 32 : 0, ci = c - first;
                if (ci >= nfold) p0_convert_tail(F, (ci - nfold) * NWAVES + F.wave(), (nidle - nfold) * NWAVES, cv::NP1, [](int j) { return cv::map_p1(j); }); } }
          __syncthreads(); }
        pg8::gemm_phase<pg8::EpProjI, pg8::StaticOrder, false, false, false, true>(F.lds + RING_OFF, g, S, pg8::EpProjI{PROJ, (unsigned char*)F.out + 64 * MiB, (const float*)(ws + WS_HS)});
    } SEAM(2);
    if (IN(3)) REP(3) {
        const bool own = F.G == 256;
        attn_phase(F, own);
        if (own) { pooled_own(F); VM_WAIT(); __syncthreads(); ap_quant(F, true); }
        else for (int u = F.vcu; u < 256; u += F.G) pooled_unit(F, u >> 2, u & 3);
    } SEAM(3);
    if (IN(4)) REP(4) {
        if (F.G != 256) { ap_quant(F, false); if (hi - lo > 1) xcd_barrier(bar); else __syncthreads(); }
        pg8::Gemm g{(const bf16*)(ws + WS_AP8), (const bf16*)(ws + WS_WPB), D / 2, D / 2, D / 2, 0, nullptr, nullptr}; pg8::RowTileOrder S{(T / 256) * (D / 256), F.G, F.vcu};
        pg8::gemm_phase<pg8::EpMergedR, pg8::RowTileOrder, false, true, false, true>(F.lds + RING_OFF, g, S, pg8::EpMergedR{BUFC, (const unsigned char*)F.out + 64 * MiB, (unsigned*)(F.ctl + CW_RMAX), (unsigned*)(F.ctl + CW_RCNT), (const float*)(ws + WS_AS)});
    } SEAM(4);
    if (IN(5)) REP(5) {
        pg8::Gemm g{BUFC, (const bf16*)(ws + WS_WOUT), D / 2, D / 2, D / 2, 0, nullptr, nullptr}; pg8::StaticOrder S; S.init(T, D, F.G, (int)blockIdx.x);
        pg8::gemm_phase<pg8::EpX1, pg8::StaticOrder, false, false, false, true>(F.lds + RING_OFF, g, S, pg8::EpX1{F.x(), BUFB, ADA, (float*)(ws + WS_SSQ), (const unsigned*)(F.ctl + CW_RMAX)}, STG_P4);
    } SEAM(5);
    if (IN(6)) REP(6) {
        LAS int* eL = (LAS int*)(F.lds + RING_OFF);
        for (int blk = F.vcu; blk < 256; blk += F.G) { p5a_block(F, blk, eL); LDS_WAIT(); __syncthreads(); }
    } SEAM(6);
    if (IN(8) || IN(9) || IN(10)) {
        if (F.wave() == 0) { const int l = F.lane(); int c = 0;
            if (l < NEXP) c = (int)__hip_atomic_load((unsigned*)(F.ctl + CW_CNT) + l, __ATOMIC_RELAXED, __HIP_MEMORY_SCOPE_AGENT);
            const int tl = (c + 255) >> 8; int incl = tl;
#pragma unroll
            for (int d = 1; d < NEXP; d <<= 1) { const int v = __shfl_up(incl, d); if (l >= d) incl += v; }
            const int nt0 = incl - tl, total = __shfl(incl, NEXP - 1);
            if (l < NEXP) { F.LM[l] = nt0 * 256; F.LM[192 + l] = c; F.LM[208 + l] = nt0; for (int i = 0; i < tl; ++i) F.LM[32 + nt0 + i] = l; }
            if (l == 0) { F.LM[16] = total * 256; F.LM[18] = total; } }
        LDS_WAIT(); __syncthreads();
    }
    if (IN(8)) REP(8) {
        pg8::Gemm g{BUFC, (const bf16*)(ws + WS_WGU), D / 2, D / 2, D / 2, (size_t)1024 * (D / 2), (const int*)(ws + WS_LTOK), F.LM};
        pg8::DynOrder S{F.LM[18] * 4, 4, F.G, F.vcu, F.LM + 32};
        { const int nun = F.LM[18] * 4, rem = nun % F.G, c = F.vcu;
          const int nidle = rem ? F.G - rem : F.G, first = rem ? rem : 0;
          if (c >= first) p0_convert_tail(F, (c - first) * NWAVES + F.wave(), nidle * NWAVES, cv::NP6, [](int j) { return cv::map_p6(j); });
          __syncthreads(); }
        pg8::gemm_phase<pg8::EpAct, pg8::DynOrder, true, false, false, true>(F.lds + RING_OFF, g, S, pg8::EpAct{ws + WS_ACT, (const float*)(ws + WS_LW), F.LM, (const float*)(ws + WS_LS), (unsigned*)(F.ctl + CW_AMAX), (unsigned*)(F.ctl + CW_ACNT)});
    } SEAM(8);
    if (IN(9)) REP(9) {
        pg8::Gemm g{(const bf16*)(ws + WS_ACT), (const bf16*)(ws + WS_WDN), FF / 2, FF / 2, FF / 2, (size_t)D * (FF / 2), nullptr, nullptr};
        pg8::DynOrder S{F.LM[18] * 8, 8, F.G, F.vcu, F.LM + 32};
        pg8::gemm_phase<pg8::EpY, pg8::DynOrder, false, false, false, true>(F.lds + RING_OFF, g, S, pg8::EpY{(bf16*)(ws + WS_Y), (const unsigned*)(F.ctl + CW_AMAX)}, STG_P7);
    } SEAM(9);
    if (IN(10)) {
        if (F.G * NWAVES * 8 >= T) final_phase(F);
        else { const int gw = F.vcu * NWAVES + F.wave(), NGW = F.G * NWAVES;
            for (int row = gw; row < T; row += NGW) final_row_pos(BUFB, F.out, (const bf16*)(ws + WS_Y), (const int*)(rt + RT_TOKSLOT), F.LM, ADA, F.fg(), row, F.lane()); }
    }
#undef IN
#undef SEAM
}

#ifndef FASTMASK
#define FASTMASK 0x7FF
#endif
#ifndef ONE_LAUNCH
#define ONE_LAUNCH 1
#endif
constexpr int NPHASE = 11;
extern "C" void kernel_launch(void* const* d_in, const int* in_sizes, int n_in, void* d_out, int out_size, void* d_ws, size_t ws_size, hipStream_t stream) {
    if (n_in != 21 || out_size != T * D || ws_size < WS_END) { fprintf(stderr, "kernel_launch: unexpected shapes (n_in %d out %d ws %zu)\n", n_in, out_size, ws_size); return; }
    static int grid = 0;
    if (grid == 0) {
        int dev = 0, cus = 0, per_cu = 0;
        if (hipGetDevice(&dev) != hipSuccess || hipDeviceGetAttribute(&cus, hipDeviceAttributeMultiprocessorCount, dev) != hipSuccess) { fprintf(stderr, "kernel_launch: device query failed\n"); grid = -1; return; }
        if (hipFuncSetAttribute((const void*)mk_fwd, hipFuncAttributeMaxDynamicSharedMemorySize, LDS_BYTES) != hipSuccess) { fprintf(stderr, "kernel_launch: hipFuncSetAttribute failed\n"); grid = -1; return; }
        if (hipOccupancyMaxActiveBlocksPerMultiprocessor(&per_cu, (const void*)mk_fwd, NWAVES * 64, LDS_BYTES) != hipSuccess || per_cu < 1) { fprintf(stderr, "kernel_launch: occupancy query says %d\n", per_cu); }
        (void)hipGetLastError();
        grid = cus;
    }
    if (grid < 0) return;
    const float* x = (const float*)d_in[0]; const float* c = (const float*)d_in[1]; const float* w_ada = (const float*)d_in[2]; const float* b_ada = (const float*)d_in[3];
    const float* norm1_g = (const float*)d_in[4]; const float* w_in = (const float*)d_in[5]; const float* sinks = (const float*)d_in[6]; const float* w_pool = (const float*)d_in[7];
    const float* pool_scale = (const float*)d_in[8]; const float* w_ab = (const float*)d_in[9]; const float* w_pb = (const float*)d_in[10]; const float* w_out = (const float*)d_in[11];
    const float* norm2_g = (const float*)d_in[12]; const float* w_rg = (const float*)d_in[13]; const float* b_rg = (const float*)d_in[14]; const float* w_re = (const float*)d_in[15];
    const float* b_re = (const float*)d_in[16]; const float* w_eg = (const float*)d_in[17]; const float* w_eu = (const float*)d_in[18]; const float* w_ed = (const float*)d_in[19];
    const float* final_g = (const float*)d_in[20];
    unsigned char* ws = (unsigned char*)d_ws; float* out = (float*)d_out;
    float* ADA = (float*)(ws + WS_ADA); float* ADAP = (float*)(ws + WS_ADAP); float* SSQ = (float*)(ws + WS_SSQ);
    bf16* PROJ = (bf16*)(ws + WS_PROJ); bf16* ACT = (bf16*)(ws + WS_ACT); bf16* Y = (bf16*)(ws + WS_Y);
    bf16* BUFB = (bf16*)(ws + WS_B); bf16* BUFC = (bf16*)(ws + WS_C);
    unsigned char* rt = ws + WS_RT;
    int* TOKE = (int*)(rt + RT_TOKE); float* TOKW = (float*)(rt + RT_TOKW); int* LRANK = (int*)(rt + RT_LRANK); int* TOKSLOT = (int*)(rt + RT_TOKSLOT);
    int* BLKCNT = (int*)(rt + RT_BLKCNT); int* BLKBASE = (int*)(rt + RT_BLKBASE); int* SLOTTOK = (int*)(rt + RT_SLOTTOK); float* SLOTW = (float*)(rt + RT_SLOTW); int* META = (int*)(rt + RT_META);

    (void)hipMemsetAsync(ws + WS_CTL, 0, 1 * MiB, stream);
    Args a{}; for (int i = 0; i < 21; ++i) a.in[i] = (const float*)d_in[i]; a.out = out; a.ws = ws;
    if (ONE_LAUNCH && FASTMASK == 0x7FF) { a.ph_lo = 0; a.ph_hi = NPHASE; hipLaunchKernelGGL(mk_fwd, dim3(grid), dim3(NWAVES * 64), LDS_BYTES, stream, a);
#ifdef EXTRA_PHASE
        a.ph_lo = EXTRA_PHASE; a.ph_hi = EXTRA_PHASE + 1; hipLaunchKernelGGL(mk_fwd, dim3(grid), dim3(NWAVES * 64), LDS_BYTES, stream, a);
#endif
        return; }
    for (int ph = 0; ph < NPHASE; ++ph) {
        const bool fast = (FASTMASK >> ph) & 1;
        if (fast || (ph == 0 && (FASTMASK & 0x33C))) { a.ph_lo = ph; a.ph_hi = ph + 1; hipLaunchKernelGGL(mk_fwd, dim3(grid), dim3(NWAVES * 64), LDS_BYTES, stream, a); if (fast) continue; }
        switch (ph) {
        case 0: nv::ada_part<<<dim3(NADA / 256, ADA_SL), 256, 0, stream>>>(c, w_ada, ADAP); break;
        case 1: nv::ada_sum<<<2 * NADA / 256, 256, 0, stream>>>(ADAP, b_ada, ADA); nv::h1<<<T / 4, 256, 0, stream>>>(x, norm1_g, ADA, BUFB); break;
        case 2: nv::gemm<false><<<dim3(NPROJ / 64, T / 64), 256, 0, stream>>>(nv::ABf16{BUFB, D, 0}, nv::WPlain{w_in, NPROJ}, nv::WPlain{w_in, NPROJ}, nv::EpProj{PROJ}, D); break;
        case 3: nv::attn<<<dim3(SEQ / 16, 16, BATCH), 256, 0, stream>>>(PROJ, sinks, BUFB);
                nv::pooled<<<(unsigned)((size_t)T * 1024 / 256), 256, 0, stream>>>(PROJ, BUFC);
                for (int g = 0; g < 4; ++g) nv::gemm<false><<<dim3(256 / 64, T / 64), 256, 0, stream>>>(nv::ABf16{BUFC, 1024, g * 256}, nv::WPlain{w_pool + (size_t)g * 256 * 256, 256}, nv::WPlain{w_pool, 256}, nv::EpPool{BUFB, pool_scale, g}, 256);
                break;
        case 4: nv::gemm<false><<<dim3(D / 64, T / 64), 256, 0, stream>>>(nv::ABf16{BUFB, D, 0}, nv::WPlain{w_pb, D}, nv::WPlain{w_pb, D}, nv::EpT1{BUFC, PROJ}, 1024);
                nv::gemm<false><<<dim3(D / 64, T / 64), 256, 0, stream>>>(nv::ABf16{BUFB, D, 1024}, nv::WPlain{w_ab, D}, nv::WPlain{w_ab, D}, nv::EpMerged{BUFC, PROJ}, 1024); break;
        case 5: nv::gemm<false><<<dim3(D / 64, T / 64), 256, 0, stream>>>(nv::ABf16{BUFC, D, 0}, nv::WPlain{w_out, D}, nv::WPlain{w_out, D}, nv::EpX1{out, x, ADA}, D);
                nv::ssq<<<T / 4, 256, 0, stream>>>(out, SSQ); break;
        case 6: nv::route<<<T / 4, 256, 0, stream>>>(out, SSQ, norm2_g, ADA, w_rg, b_rg, w_re, b_re, BUFB, TOKE, TOKW); nv::hist<<<256, 64, 0, stream>>>(TOKE, BLKCNT, LRANK); break;
        case 7: nv::scan<<<1, 256, 0, stream>>>(BLKCNT, BLKBASE, META, SLOTTOK, SLOTW); nv::fill<<<2 * T / 256, 256, 0, stream>>>(TOKE, TOKW, LRANK, BLKBASE, META, SLOTTOK, SLOTW, TOKSLOT); break;
        case 8: nv::gemm<true><<<dim3(FF / 64, MAXSLOT / 64), 256, 0, stream>>>(nv::AGather{BUFB, D, SLOTTOK, META}, nv::WExpert{w_eg, FF, (size_t)D * FF, META}, nv::WExpert{w_eu, FF, (size_t)D * FF, META}, nv::EpAct{ACT, SLOTW}, D); break;
        case 9: nv::gemm<false><<<dim3(D / 64, MAXSLOT / 64), 256, 0, stream>>>(nv::ASlot{ACT, FF, META}, nv::WExpert{w_ed, D, (size_t)FF * D, META}, nv::WExpert{w_ed, D, (size_t)FF * D, META}, nv::EpY{Y}, FF); break;
        case 10: nv::final_<<<T / 4, 256, 0, stream>>>(out, Y, TOKSLOT, ADA, final_g); break;
        }
    }
}
```
